# Optimizing an MI355X kernel written in HIP

```python
import math
import jax, jax.numpy as jnp
from jax import lax
import numpy as np

D_MODEL = 1024
BATCH = 2
SEQ = 8192
DEPTH = 4
DEC_BATCH = 32
DEC_SEQ = 4
PAST_LEN = 8192
PAGE_SIZE = 128

N_MIXERS = 2
N_REC = (DEPTH + 1) // 2
N_ATT = DEPTH // 2
D_FF = 2816
D_RNN = D_MODEL
N_LRU_BLOCKS = 8
LRU_BLOCK = D_RNN // N_LRU_BLOCKS
CONV_W = 4
LRU_C = 8.0
N_HEADS = 16
HEAD_DIM = D_MODEL // N_HEADS
WINDOWS = (128, 512, 2048)
DILATIONS = (1, 4, 16)
N_GROUPS = 3
BAND_BLOCK = 128
ROPE_THETA = 10000.0
EPS = 1e-6

kernel_name = "hawk_longnet_macaron_step"


def rms_norm(x, g):
    xf = x.astype(jnp.float32)
    y = xf * lax.rsqrt(jnp.mean(xf * xf, axis=-1, keepdims=True) + EPS)
    return (y * g.astype(jnp.float32)).astype(x.dtype)


def half_swiglu(x, g, w_up, w_down):
    gate, up = jnp.split(rms_norm(x, g) @ w_up, 2, axis=-1)
    return x + 0.5 * ((jax.nn.silu(gate) * up) @ w_down)


def rope(x, pos):
    half = HEAD_DIM // 2
    inv = jnp.power(ROPE_THETA, -jnp.arange(half, dtype=jnp.float32) / half)
    ang = pos.astype(jnp.float32)[:, None] * inv[None, :]
    cos, sin = jnp.cos(ang)[:, None, :], jnp.sin(ang)[:, None, :]
    xf = x.astype(jnp.float32)
    x1, x2 = xf[..., :half], xf[..., half:]
    return jnp.concatenate([x1 * cos - x2 * sin, x2 * cos + x1 * sin], axis=-1).astype(x.dtype)


def causal_conv(xb, conv_state, w, b):
    T = xb.shape[1]
    xp = jnp.concatenate([conv_state.astype(xb.dtype), xb], axis=1)
    y = b + xp[:, 0:T] * w[0]
    for k in range(1, CONV_W):
        y = y + xp[:, k:k + T] * w[k]
    return y, xp[:, -(CONV_W - 1):]


def rg_lru(x, h0, w_a, b_a, w_x, b_x, lam):
    N, T, _ = x.shape
    xf = x.astype(jnp.float32)
    xb = xf.reshape(N, T, N_LRU_BLOCKS, LRU_BLOCK)
    gate_a = jax.nn.sigmoid(jnp.einsum("ntbi,bij->ntbj", xb, w_a.astype(jnp.float32)).reshape(N, T, D_RNN) + b_a.astype(jnp.float32))
    gate_x = jax.nn.sigmoid(jnp.einsum("ntbi,bij->ntbj", xb, w_x.astype(jnp.float32)).reshape(N, T, D_RNN) + b_x.astype(jnp.float32))
    log_a = -LRU_C * gate_a * jax.nn.softplus(-lam.astype(jnp.float32))
    a = jnp.exp(log_a)
    bterm = jnp.sqrt(-jnp.expm1(2.0 * log_a)) * gate_x * xf
    bterm = bterm.at[:, 0].add(a[:, 0] * h0.astype(jnp.float32))

    def comb(l, r):
        return l[0] * r[0], r[0] * l[1] + r[1]

    _, h = lax.associative_scan(comb, (a, bterm), axis=1)
    return h, h[:, -1]


def recurrent_mixer(x, h0, conv0, w_in, b_in, w_conv, b_conv, w_a, b_a, w_x, b_x, lam, w_out, b_out):
    y_branch, x_branch = jnp.split(x @ w_in + b_in, 2, axis=-1)
    y_branch = jax.nn.gelu(y_branch, approximate=True)
    xc, conv_new = causal_conv(x_branch, conv0, w_conv, b_conv)
    h, h_last = rg_lru(xc, h0, w_a, b_a, w_x, b_x, lam)
    out = (h.astype(x.dtype) * y_branch) @ w_out + b_out
    return out, h_last, conv_new


def qkv_groups(x, w_qkv, pos):
    N, T, _ = x.shape
    qkv = (x @ w_qkv).reshape(N, T, N_GROUPS, 3, N_HEADS, HEAD_DIM)
    return [(rope(qkv[:, :, g, 0], pos), rope(qkv[:, :, g, 1], pos), qkv[:, :, g, 2]) for g in range(N_GROUPS)]


def banded_attn(q, k, v, n_back):
    N, L, H, hd = q.shape
    nb = -(-L // BAND_BLOCK)
    pad = nb * BAND_BLOCK - L
    padf = lambda t: jnp.pad(t, ((0, 0), (0, pad), (0, 0), (0, 0))).reshape(N, nb, BAND_BLOCK, H, hd)
    qb, kb, vb = padf(q), padf(k), padf(v)
    with_prev = lambda t: jnp.concatenate([jnp.pad(t[:, :-1], ((0, 0), (1, 0), (0, 0), (0, 0), (0, 0))), t], axis=2)
    kk, vv = with_prev(kb), with_prev(vb)
    s = jnp.einsum("nbqhd,nbkhd->nbhqk", qb.astype(jnp.float32), kk.astype(jnp.float32)) * (hd ** -0.5)
    iq = jnp.arange(BAND_BLOCK)
    ik = jnp.arange(2 * BAND_BLOCK)
    dist = (BAND_BLOCK + iq)[:, None] - ik[None, :]
    band = (dist >= 0) & (dist <= n_back)
    kpos_ok = (jnp.arange(nb)[:, None] * BAND_BLOCK - BAND_BLOCK + ik[None, :]) >= 0
    mask = band[None, :, :] & kpos_ok[:, None, :]
    s = jnp.where(mask[None, :, None], s, -jnp.inf)
    lse = jax.nn.logsumexp(s, axis=-1)
    p = jnp.exp(s - lse[..., None])
    o = jnp.einsum("nbhqk,nbkhd->nbqhd", p, vv.astype(jnp.float32)).reshape(N, nb * BAND_BLOCK, H, hd)[:, :L]
    lse = lse.transpose(0, 1, 3, 2).reshape(N, nb * BAND_BLOCK, H)[:, :L]
    return o, lse


def dilated_prompt_attn(q, k, v, window, dil):
    B, S, H, hd = q.shape
    L = S // dil
    to_streams = lambda t: t.reshape(B, L, dil, H, hd).transpose(0, 2, 1, 3, 4).reshape(B * dil, L, H, hd)
    o, lse = banded_attn(to_streams(q), to_streams(k), to_streams(v), window // dil)
    o = o.reshape(B, dil, L, H, hd).transpose(0, 2, 1, 3, 4).reshape(B, S, H, hd)
    lse = lse.reshape(B, dil, L, H).transpose(0, 2, 1, 3).reshape(B, S, H)
    return o, lse


def dilated_sample_attn(q, k, v, cache, window, dil):
    Nd, T, H, hd = q.shape
    C = cache.shape[1]
    k_all = jnp.concatenate([cache[:, :, 0].astype(k.dtype), k], axis=1)
    v_all = jnp.concatenate([cache[:, :, 1].astype(v.dtype), v], axis=1)
    n_keys = window // dil + 1
    idx = C + jnp.arange(T)[:, None] - dil * jnp.arange(n_keys)[None, :]
    valid = idx >= 0
    idx = jnp.maximum(idx, 0)
    kg = k_all[:, idx].astype(jnp.float32)
    vg = v_all[:, idx].astype(jnp.float32)
    s = jnp.einsum("bthd,btkhd->bthk", q.astype(jnp.float32), kg) * (hd ** -0.5)
    s = jnp.where(valid[None, :, None, :], s, -jnp.inf)
    lse = jax.nn.logsumexp(s, axis=-1)
    p = jnp.exp(s - lse[..., None])
    return jnp.einsum("bthk,btkhd->bthd", p, vg), lse


def merge_groups(outs, lses, w_o, dtype):
    alpha = jax.nn.softmax(jnp.stack(lses, 0), axis=0)
    o = jnp.einsum("gnth,gnthd->nthd", alpha, jnp.stack(outs, 0))
    N, T = o.shape[:2]
    return o.reshape(N, T, N_HEADS * HEAD_DIM).astype(dtype) @ w_o


def attn_prompt(x, w_qkv, w_o):
    B, S, _ = x.shape
    groups = qkv_groups(x, w_qkv, jnp.arange(S))
    outs, lses, rows = [], [], []
    for g, (q, k, v) in enumerate(groups):
        o, lse = dilated_prompt_attn(q, k, v, WINDOWS[g], DILATIONS[g])
        outs.append(o)
        lses.append(lse)
        c = min(WINDOWS[g], S)
        rows.append(jnp.stack([k[:, S - c:], v[:, S - c:]], axis=2))
    return merge_groups(outs, lses, w_o, x.dtype), rows


def attn_sample(x, caches, w_qkv, w_o):
    Nd, T, _ = x.shape
    groups = qkv_groups(x, w_qkv, PAST_LEN + jnp.arange(T))
    outs, lses, rows = [], [], []
    for g, (q, k, v) in enumerate(groups):
        o, lse = dilated_sample_attn(q, k, v, caches[g], WINDOWS[g], DILATIONS[g])
        outs.append(o)
        lses.append(lse)
        rows.append(jnp.stack([k, v], axis=2))
    return merge_groups(outs, lses, w_o, x.dtype), rows


def setup_inputs(seed: int = 0) -> dict:
    key = jax.random.key(seed)
    ks = iter(jax.random.split(key, 40))
    nrm = lambda shape, scale: scale * jax.random.normal(next(ks), shape, jnp.float32)
    gain = lambda shape: 1.0 + 0.02 * jax.random.normal(next(ks), shape, jnp.float32)
    u = jax.random.uniform(next(ks), (N_REC, D_RNN), jnp.float32, minval=0.9, maxval=0.999)
    s = u ** (1.0 / LRU_C)
    lru_lambda = jnp.log(s) - jnp.log1p(-s)
    inp = {
        "x_prompt": nrm((BATCH, SEQ, D_MODEL), 1.0),
        "x_sample": nrm((DEC_BATCH, DEC_SEQ, D_MODEL), 1.0),
        "state_h": nrm((N_REC, DEC_BATCH, D_RNN), 1.0),
        "state_conv": nrm((N_REC, DEC_BATCH, CONV_W - 1, D_RNN), 1.0),
    }
    for w in WINDOWS:
        inp["cache_kv_w%d" % w] = nrm((N_ATT, DEC_BATCH, min(w, PAST_LEN), 2, N_HEADS, HEAD_DIM), 1.0)
    inp.update({
        "norm_ffn1": gain((DEPTH, D_MODEL)),
        "norm_mix": gain((DEPTH, D_MODEL)),
        "norm_ffn2": gain((DEPTH, D_MODEL)),
        "w_ffn1_up": nrm((DEPTH, D_MODEL, 2 * D_FF), D_MODEL ** -0.5),
        "w_ffn1_down": nrm((DEPTH, D_FF, D_MODEL), D_FF ** -0.5),
        "w_ffn2_up": nrm((DEPTH, D_MODEL, 2 * D_FF), D_MODEL ** -0.5),
        "w_ffn2_down": nrm((DEPTH, D_FF, D_MODEL), D_FF ** -0.5),
        "w_rec_in": nrm((N_REC, D_MODEL, 2 * D_RNN), D_MODEL ** -0.5),
        "b_rec_in": nrm((N_REC, 2 * D_RNN), 0.02),
        "w_conv": nrm((N_REC, CONV_W, D_RNN), CONV_W ** -0.5),
        "b_conv": nrm((N_REC, D_RNN), 0.02),
        "w_gate_a": nrm((N_REC, N_LRU_BLOCKS, LRU_BLOCK, LRU_BLOCK), LRU_BLOCK ** -0.5),
        "b_gate_a": nrm((N_REC, D_RNN), 0.02),
        "w_gate_x": nrm((N_REC, N_LRU_BLOCKS, LRU_BLOCK, LRU_BLOCK), LRU_BLOCK ** -0.5),
        "b_gate_x": nrm((N_REC, D_RNN), 0.02),
        "lru_lambda": lru_lambda,
        "w_rec_out": nrm((N_REC, D_RNN, D_MODEL), D_RNN ** -0.5),
        "b_rec_out": nrm((N_REC, D_MODEL), 0.02),
        "w_qkv": nrm((N_ATT, D_MODEL, N_GROUPS * 3 * N_HEADS * HEAD_DIM), D_MODEL ** -0.5),
        "w_attn_out": nrm((N_ATT, N_HEADS * HEAD_DIM, D_MODEL), (N_HEADS * HEAD_DIM) ** -0.5),
        "norm_final": gain((D_MODEL,)),
    })
    return inp


def reference(x_prompt, x_sample, state_h, state_conv, cache_kv_w128, cache_kv_w512, cache_kv_w2048,
              norm_ffn1, norm_mix, norm_ffn2, w_ffn1_up, w_ffn1_down, w_ffn2_up, w_ffn2_down,
              w_rec_in, b_rec_in, w_conv, b_conv, w_gate_a, b_gate_a, w_gate_x, b_gate_x, lru_lambda,
              w_rec_out, b_rec_out, w_qkv, w_attn_out, norm_final):
    caches = (cache_kv_w128, cache_kv_w512, cache_kv_w2048)
    xp, xs = x_prompt, x_sample
    B = xp.shape[0]
    h_p, h_s, conv_p, conv_s = [], [], [], []
    kv_p = [[] for _ in range(N_GROUPS)]
    kv_s = [[] for _ in range(N_GROUPS)]
    for i in range(DEPTH):
        xp = half_swiglu(xp, norm_ffn1[i], w_ffn1_up[i], w_ffn1_down[i])
        xs = half_swiglu(xs, norm_ffn1[i], w_ffn1_up[i], w_ffn1_down[i])
        hp, hs = rms_norm(xp, norm_mix[i]), rms_norm(xs, norm_mix[i])
        j = i // N_MIXERS
        if i % N_MIXERS == 0:
            prm = (w_rec_in[j], b_rec_in[j], w_conv[j], b_conv[j], w_gate_a[j], b_gate_a[j],
                   w_gate_x[j], b_gate_x[j], lru_lambda[j], w_rec_out[j], b_rec_out[j])
            yp, hl_p, cv_p = recurrent_mixer(hp, jnp.zeros((B, D_RNN), jnp.float32),
                                             jnp.zeros((B, CONV_W - 1, D_RNN), hp.dtype), *prm)
            ys, hl_s, cv_s = recurrent_mixer(hs, state_h[j], state_conv[j], *prm)
            h_p.append(hl_p)
            h_s.append(hl_s)
            conv_p.append(cv_p)
            conv_s.append(cv_s)
        else:
            yp, rows_p = attn_prompt(hp, w_qkv[j], w_attn_out[j])
            ys, rows_s = attn_sample(hs, tuple(c[j] for c in caches), w_qkv[j], w_attn_out[j])
            for g in range(N_GROUPS):
                kv_p[g].append(rows_p[g])
                kv_s[g].append(rows_s[g])
        xp, xs = xp + yp, xs + ys
        xp = half_swiglu(xp, norm_ffn2[i], w_ffn2_up[i], w_ffn2_down[i])
        xs = half_swiglu(xs, norm_ffn2[i], w_ffn2_up[i], w_ffn2_down[i])
    y_prompt = rms_norm(xp, norm_final)
    y_sample = rms_norm(xs, norm_final)
    return (y_prompt, y_sample,
            jnp.stack(h_p, 0), jnp.stack(h_s, 0), jnp.stack(conv_p, 0), jnp.stack(conv_s, 0),
            jnp.stack(kv_p[0], 0), jnp.stack(kv_s[0], 0),
            jnp.stack(kv_p[1], 0), jnp.stack(kv_s[1], 0),
            jnp.stack(kv_p[2], 0), jnp.stack(kv_s[2], 0))
```

```cpp
#include <hip/hip_runtime.h>
#include <cstdio>
#include <cstdint>
#include <cmath>
#define LAS __attribute__((address_space(3)))
namespace pg8 {
#define PG8_LAS __attribute__((address_space(3)))
typedef unsigned short bf16_t;
typedef short bf16x8 __attribute__((ext_vector_type(8)));
typedef float f32x4 __attribute__((ext_vector_type(4)));
typedef unsigned u32x4 __attribute__((ext_vector_type(4)));
constexpr int BM = 256, BK = 64, HALF = 128, HTB = HALF * BK * 2  , STAGE_BYTES = 8 * HTB, NXCD = 8, WGM = 8;

__host__ __device__ __forceinline__ int lds_byte(int r, int c) { const int st = (r >> 4) * 2 + (c >> 5), rr = r & 15, cc = c & 31, ob = rr * 64 + cc * 2; return st * 1024 + (ob ^ (((ob >> 9) & 1) << 5)); }
__host__ __device__ __forceinline__ void stage_rc(int b, int& R, int& C) { const int st = b / 1024, sb = b % 1024, swz = sb ^ (((sb >> 9) & 1) << 5); R = (st >> 1) * 16 + swz / 64; C = (st & 1) * 32 + (swz % 64) / 2; }
__host__ __device__ __forceinline__ int perm32(int rho) { const int n = rho >> 4, i = rho & 15; return 8 * (i >> 2) + 4 * n + (i & 3); }

struct Unit { int pm, pn; };
struct Gemm { const bf16_t* A; const bf16_t* Bt; int M, N, K; };

struct StaticOrder {
    int nM, nN, nwg, G, c;
    __host__ __device__ void init(int M, int N, int G_, int c_) { nM = M / BM; nN = N / BM; nwg = nM * nN; G = G_; c = c_; }
    __host__ __device__ bool next(int i, Unit& u) const {
        const long L = (long)i * G + c; if (L >= nwg) return false;
        int wgid = (int)L; { const int q = nwg / NXCD, r = nwg % NXCD, xcd = wgid % NXCD, off = wgid / NXCD; wgid = (xcd < r ? xcd * (q + 1) : r * (q + 1) + (xcd - r) * q) + off; }
        const int nig = WGM * nN, gid = wgid / nig, fm = gid * WGM, gsz = (nM - fm) < WGM ? (nM - fm) : WGM;
        u.pm = fm + ((wgid % nig) % gsz); u.pn = (wgid % nig) / gsz; return true;
    }
    __device__ __forceinline__ void a_ready(const Unit&) const {}
    __device__ __forceinline__ void done(const Unit&) const {}
};

__device__ __forceinline__ unsigned cvt_pk_bf16(float lo, float hi) { unsigned r; asm volatile("v_cvt_pk_bf16_f32 %0, %1, %2" : "=v"(r) : "v"(lo), "v"(hi)); return r; }
typedef float f32x2 __attribute__((ext_vector_type(2)));
typedef unsigned u32x2 __attribute__((ext_vector_type(2)));
__device__ __forceinline__ float frcp(float x) { return __builtin_amdgcn_rcpf(x); }
__device__ __forceinline__ float silu_mul(float g, float u) { return g * u * frcp(1.f + __expf(-g)); }
__device__ __forceinline__ float gelu_tanh(float x) { const float uu = 1.5957691216057308f * (x + 0.044715f * x * x * x); return x * frcp(1.f + __expf(-uu)); }
__device__ __forceinline__ float row_rs(const float* SS, int row) { const f32x4 s4 = *(const f32x4*)(SS + (size_t)row * 4); return rsqrtf(((s4.x + s4.y) + (s4.z + s4.w)) * (1.f / 1024.f) + 1e-6f); }
__device__ __forceinline__ u32x4 pack8(const f32x4& a, const f32x4& b) { u32x4 w; w.x = cvt_pk_bf16(a.x, a.y); w.y = cvt_pk_bf16(a.z, a.w); w.z = cvt_pk_bf16(b.x, b.y); w.w = cvt_pk_bf16(b.z, b.w); return w; }

struct EpiUp {
    static constexpr bool PERM = true, AFTER_DRAIN = false;
    const float* SS; bf16_t* H;
    __device__ __forceinline__ void operator()(const f32x4 (&acc)[2][2][4][2], const Unit& u, int wr, int wc, int fr, int fq) const {
        const int row0 = u.pm * BM + wr * 64 + fr, col0 = u.pn * 128 + wc * 32 + 8 * fq;
#pragma unroll
        for (int ai = 0; ai < 2; ++ai)
#pragma unroll
            for (int m = 0; m < 4; ++m) {
                const int row = row0 + ai * HALF + m * 16; const float rs = row_rs(SS, row);
                const f32x4 g0 = acc[ai][0][m][0] * rs, g1 = acc[ai][0][m][1] * rs, u0 = acc[ai][1][m][0] * rs, u1 = acc[ai][1][m][1] * rs;
                f32x4 h0, h1;
                h0.x = silu_mul(g0.x, u0.x); h0.y = silu_mul(g0.y, u0.y); h0.z = silu_mul(g0.z, u0.z); h0.w = silu_mul(g0.w, u0.w);
                h1.x = silu_mul(g1.x, u1.x); h1.y = silu_mul(g1.y, u1.y); h1.z = silu_mul(g1.z, u1.z); h1.w = silu_mul(g1.w, u1.w);
                *(u32x4*)(H + (size_t)row * 2816 + col0) = pack8(h0, h1);
            }
    }
};

struct EpiRes {
    static constexpr bool PERM = true, AFTER_DRAIN = true;
    float* X; bf16_t* Xb; float* SS; const float* bias; float scale;
    __device__ __forceinline__ void fused(f32x4 (&acc)[2][2][4][2], const Unit& u, int wr, int wc, int fr, int fq, PG8_LAS unsigned char* lds, int wid, int lane) const {
        PG8_LAS float* P = (PG8_LAS float*)lds;
        const int col0 = u.pn * BM + wc * 32 + 8 * fq;
#pragma unroll
        for (int ai = 0; ai < 2; ++ai)
#pragma unroll
            for (int m = 0; m < 4; ++m) {
                const int rt = ai * HALF + wr * 64 + m * 16 + fr; const size_t row = (size_t)u.pm * BM + rt; float ssq = 0.f;
#pragma unroll
                for (int bj = 0; bj < 2; ++bj) {
                    const int c = col0 + bj * HALF; float* xp = X + row * 1024 + c;
                    f32x4 x0 = *(const f32x4*)xp, x1 = *(const f32x4*)(xp + 4);
                    if (bias) { x0 += *(const f32x4*)(bias + c); x1 += *(const f32x4*)(bias + c + 4); }
                    x0 += acc[ai][bj][m][0] * scale; x1 += acc[ai][bj][m][1] * scale;
                    *(f32x4*)xp = x0; *(f32x4*)(xp + 4) = x1;
                    *(u32x4*)(Xb + row * 1024 + c) = pack8(x0, x1);
                    ssq += (x0.x * x0.x + x0.y * x0.y) + (x0.z * x0.z + x0.w * x0.w) + (x1.x * x1.x + x1.y * x1.y) + (x1.z * x1.z + x1.w * x1.w);
                }
                ssq += __shfl_xor(ssq, 16); ssq += __shfl_xor(ssq, 32);
                if (fq == 0) P[rt * 4 + wc] = ssq;
            }
        asm volatile("s_waitcnt lgkmcnt(0)" ::: "memory"); __builtin_amdgcn_s_barrier(); asm volatile("" ::: "memory");
        const int t = wid * 64 + lane;
        if (t < 256) { const f32x4 p = *(const PG8_LAS f32x4*)(P + t * 4); SS[((size_t)u.pm * BM + t) * 4 + u.pn] = (p.x + p.y) + (p.z + p.w); }
    }
};

struct EpiRin {
    static constexpr bool PERM = true, AFTER_DRAIN = false;
    const float* SS; const float* bias; bf16_t* YB; bf16_t* XBR;
    __device__ __forceinline__ void operator()(const f32x4 (&acc)[2][2][4][2], const Unit& u, int wr, int wc, int fr, int fq) const {
        const int row0 = u.pm * BM + wr * 64 + fr, col0 = u.pn * BM + wc * 32 + 8 * fq; const bool isy = u.pn < 4;
        bf16_t* O = isy ? YB : XBR; const int oc0 = isy ? col0 : col0 - 1024;
        f32x4 bv[2][2];
#pragma unroll
        for (int bj = 0; bj < 2; ++bj) { bv[bj][0] = *(const f32x4*)(bias + col0 + bj * HALF); bv[bj][1] = *(const f32x4*)(bias + col0 + bj * HALF + 4); }
#pragma unroll
        for (int ai = 0; ai < 2; ++ai)
#pragma unroll
            for (int m = 0; m < 4; ++m) {
                const int row = row0 + ai * HALF + m * 16; const float rs = row_rs(SS, row);
#pragma unroll
                for (int bj = 0; bj < 2; ++bj) {
                    f32x4 v0 = acc[ai][bj][m][0] * rs + bv[bj][0], v1 = acc[ai][bj][m][1] * rs + bv[bj][1];
                    if (isy) { v0.x = gelu_tanh(v0.x); v0.y = gelu_tanh(v0.y); v0.z = gelu_tanh(v0.z); v0.w = gelu_tanh(v0.w);
                               v1.x = gelu_tanh(v1.x); v1.y = gelu_tanh(v1.y); v1.z = gelu_tanh(v1.z); v1.w = gelu_tanh(v1.w); }
                    *(u32x4*)(O + (size_t)row * 1024 + oc0 + bj * HALF) = pack8(v0, v1);
                }
            }
    }
};

__device__ __forceinline__ void rope4(f32x4& a, f32x4& b, const f32x4 t0, const f32x4 t1) {
    const f32x4 x1 = a, x2 = b;
    a.x = x1.x * t0.x - x2.x * t0.y; b.x = x2.x * t0.x + x1.x * t0.y;
    a.y = x1.y * t0.z - x2.y * t0.w; b.y = x2.y * t0.z + x1.y * t0.w;
    a.z = x1.z * t1.x - x2.z * t1.y; b.z = x2.z * t1.x + x1.z * t1.y;
    a.w = x1.w * t1.z - x2.w * t1.w; b.w = x2.w * t1.z + x1.w * t1.w;
}
struct EpiQkv {
    static constexpr bool PERM = true, AFTER_DRAIN = false;
    const float* SS; const float* CS; bf16_t* QKV; float* out; int j;
    __device__ __forceinline__ void operator()(const f32x4 (&acc)[2][2][4][2], const Unit& u, int wr, int wc, int fr, int fq) const {
        const int g = u.pn / 12, which = (u.pn % 12) >> 2, hq = u.pn & 3, head = hq * 4 + wc, dd0 = 8 * fq;
        const int colbase = g * 3072 + which * 1024 + head * 64 + dd0;
        const int Wg = 128 << (2 * g); const size_t kvo = (g == 0 ? (size_t)17186816 : (g == 1 ? (size_t)18759680 : (size_t)23478272)) + (size_t)j * 2 * Wg * 2048; float* kvp = out + kvo;
        const int row0 = u.pm * BM + wr * 64 + fr;
#pragma unroll
        for (int ai = 0; ai < 2; ++ai)
#pragma unroll
            for (int m = 0; m < 4; ++m) {
                const int row = row0 + ai * HALF + m * 16, pos = row & 8191, b = row >> 13; const float rs = row_rs(SS, row);
                f32x4 a0 = acc[ai][0][m][0] * rs, a1 = acc[ai][0][m][1] * rs, b0 = acc[ai][1][m][0] * rs, b1 = acc[ai][1][m][1] * rs;
                if (which < 2) {
                    const f32x4* cs = (const f32x4*)(CS + ((size_t)pos * 32 + dd0) * 2);
                    rope4(a0, b0, cs[0], cs[1]); rope4(a1, b1, cs[2], cs[3]);
                    if (which == 0) { a0 *= 0.125f; a1 *= 0.125f; b0 *= 0.125f; b1 *= 0.125f; }
                }
                bf16_t* o = QKV + (size_t)row * 9216 + colbase;
                *(u32x4*)o = pack8(a0, a1); *(u32x4*)(o + 32) = pack8(b0, b1);
                if (which >= 1 && pos >= 8192 - Wg) {
                    float* kp = kvp + ((size_t)(b * Wg + pos - (8192 - Wg)) * 2 + (which - 1)) * 1024 + head * 64 + dd0;
                    *(f32x4*)kp = a0; *(f32x4*)(kp + 4) = a1; *(f32x4*)(kp + 32) = b0; *(f32x4*)(kp + 36) = b1;
                }
            }
    }
};

template <class Epi, class Sched, bool ALIGN_EPI = false, bool SP2 = false>
__device__ __forceinline__ void gemm_phase(PG8_LAS unsigned char* lds, const Gemm g, const Sched& S, const Epi& E) {
    const int tid = threadIdx.x, wid = __builtin_amdgcn_readfirstlane(tid >> 6), lane = tid & 63, wr = wid >> 2, wc = wid & 3, fr = lane & 15, fq = lane >> 4;
    const int K = g.K, nt = K / BK;
    unsigned voffA[2], voffB[2];
#pragma unroll
    for (int i = 0; i < 2; ++i) { int R, C; stage_rc(tid * 16 + i * 8192, R, C); const int Rb = Epi::PERM ? ((R & ~31) + perm32(R & 31)) : R;
        voffA[i] = (unsigned)(R * K + C) * 2u; voffB[i] = (unsigned)(Rb * K + C) * 2u; }
    const size_t kstep = (size_t)(BK * 2);
    const size_t hstep = (size_t)HALF * K * 2;
    const size_t tstep = 2 * hstep;
    const unsigned ldsw = (unsigned)wid * 1024u;
    const int aoff = lds_byte(wr * 64 + fr, fq * 8), boff = lds_byte(wc * 32 + fr, fq * 8);
#define PG8_SA(b, h) (((b) * 2 + (h)) * HTB)
#define PG8_SB(b, h) ((4 + (b) * 2 + (h)) * HTB)
#define PG8_STAGE(bufoff, gbase, voff) do { _Pragma("unroll") for (int _i = 0; _i < 2; ++_i) \
        __builtin_amdgcn_global_load_lds((const unsigned*)((const char*)(gbase) + (voff)[_i]), (PG8_LAS unsigned*)(lds + (bufoff) + ldsw + _i * 8192), 16, 0, 0); } while (0)
#define PG8_LDA(dst, b, h) do { _Pragma("unroll") for (int m = 0; m < 4; ++m) _Pragma("unroll") for (int k = 0; k < 2; ++k) dst[m][k] = *(const PG8_LAS bf16x8*)(lds + PG8_SA(b, h) + aoff + m * 2048 + k * 1024); } while (0)
#define PG8_LDB(dst, b, h) do { _Pragma("unroll") for (int n = 0; n < 2; ++n) _Pragma("unroll") for (int k = 0; k < 2; ++k) dst[n][k] = *(const PG8_LAS bf16x8*)(lds + PG8_SB(b, h) + boff + n * 2048 + k * 1024); } while (0)
#define PG8_MMA(ai, bj, At, Bt) do { __builtin_amdgcn_s_setprio(1); _Pragma("unroll") for (int m = 0; m < 4; ++m) _Pragma("unroll") for (int n = 0; n < 2; ++n) _Pragma("unroll") for (int k = 0; k < 2; ++k) \
        acc[ai][bj][m][n] = __builtin_amdgcn_mfma_f32_16x16x32_bf16(Bt[n][k], At[m][k], acc[ai][bj][m][n], 0, 0, 0); __builtin_amdgcn_s_setprio(0); } while (0)
#define PG8_WAIT_V(n) asm volatile("s_waitcnt vmcnt(" #n ")" ::: "memory")
#define PG8_WAIT_L(n) asm volatile("s_waitcnt lgkmcnt(" #n ")" ::: "memory")
#define PG8_BAR __builtin_amdgcn_s_barrier()
#define PG8_SCHED __builtin_amdgcn_sched_barrier(0)
    Unit cur, nxt; int ui = 0;
    if (!S.next(0, cur)) return;
    f32x4 acc[2][2][4][2];
#pragma unroll
    for (int a = 0; a < 2; ++a)
#pragma unroll
        for (int b = 0; b < 2; ++b)
#pragma unroll
            for (int m = 0; m < 4; ++m)
#pragma unroll
                for (int n = 0; n < 2; ++n) acc[a][b][m][n] = (f32x4){0.f, 0.f, 0.f, 0.f};
    bf16x8 At[4][2], B0[2][2], B1[2][2];
    const char* cA = (const char*)g.A + (size_t)cur.pm * tstep; const char* cB = (const char*)g.Bt + (size_t)cur.pn * tstep;
    S.a_ready(cur);
    if constexpr (SP2) {
        PG8_STAGE(PG8_SB(0, 0), cB, voffB); PG8_STAGE(PG8_SB(0, 1), cB + hstep, voffB); PG8_STAGE(PG8_SA(0, 0), cA, voffA); PG8_STAGE(PG8_SA(0, 1), cA + hstep, voffA);
        if (wr == 1) PG8_BAR;
        PG8_WAIT_V(2); PG8_BAR;
        PG8_STAGE(PG8_SB(1, 0), cB + kstep, voffB); PG8_STAGE(PG8_SA(1, 0), cA + kstep, voffA); PG8_STAGE(PG8_SB(1, 1), cB + hstep + kstep, voffB);
        PG8_WAIT_V(6); PG8_BAR;
    } else {
        PG8_STAGE(PG8_SB(0, 0), cB, voffB); PG8_STAGE(PG8_SA(0, 0), cA, voffA); PG8_STAGE(PG8_SB(0, 1), cB + hstep, voffB); PG8_STAGE(PG8_SA(0, 1), cA + hstep, voffA);
        if (wr == 1) PG8_BAR;
        PG8_WAIT_V(4); PG8_BAR;
        PG8_STAGE(PG8_SB(1, 0), cB + kstep, voffB); PG8_STAGE(PG8_SA(1, 0), cA + kstep, voffA); PG8_STAGE(PG8_SB(1, 1), cB + hstep + kstep, voffB);
        PG8_WAIT_V(6); PG8_BAR;
    }
    for (;;) {
        const bool has_next = S.next(ui + 1, nxt);
        const char* nA = has_next ? (const char*)g.A + (size_t)nxt.pm * tstep : cA; const char* nB = has_next ? (const char*)g.Bt + (size_t)nxt.pn * tstep : cB;
        for (int t = 0; t < nt; t += 2) {
            const bool last = (t == nt - 2);
            const char* a1 = cA + (size_t)(t + 1) * kstep;
            const char* a2 = last ? nA : cA + (size_t)(t + 2) * kstep; const char* b2 = last ? nB : cB + (size_t)(t + 2) * kstep;
            const char* a3 = a2 + kstep; const char* b3 = b2 + kstep;
            if (last && has_next) S.a_ready(nxt);
            if constexpr (SP2) {
            PG8_LDB(B0, 0, 0); PG8_LDB(B1, 0, 1); PG8_SCHED; PG8_LDA(At, 0, 0); PG8_STAGE(PG8_SA(1, 1), a1 + hstep, voffA);
            PG8_WAIT_V(8); PG8_WAIT_L(0); PG8_BAR; PG8_MMA(0, 0, At, B0); PG8_MMA(0, 1, At, B1); PG8_BAR; PG8_SCHED;
            PG8_LDA(At, 0, 1); PG8_STAGE(PG8_SB(0, 0), b2, voffB); PG8_STAGE(PG8_SB(0, 1), b2 + hstep, voffB); PG8_STAGE(PG8_SA(0, 0), a2, voffA);
            PG8_WAIT_V(8); PG8_WAIT_L(0); PG8_BAR; PG8_MMA(1, 0, At, B0); PG8_MMA(1, 1, At, B1); PG8_BAR; PG8_SCHED;
            PG8_LDB(B0, 1, 0); PG8_LDB(B1, 1, 1); PG8_SCHED; PG8_LDA(At, 1, 0); PG8_STAGE(PG8_SA(0, 1), a2 + hstep, voffA);
            PG8_WAIT_V(8); PG8_WAIT_L(0); PG8_BAR; PG8_MMA(0, 0, At, B0); PG8_MMA(0, 1, At, B1); PG8_BAR; PG8_SCHED;
            PG8_LDA(At, 1, 1); PG8_STAGE(PG8_SB(1, 0), b3, voffB); PG8_STAGE(PG8_SB(1, 1), b3 + hstep, voffB); PG8_STAGE(PG8_SA(1, 0), a3, voffA);
            PG8_WAIT_V(8); PG8_WAIT_L(0); PG8_BAR; PG8_MMA(1, 0, At, B0); PG8_MMA(1, 1, At, B1); PG8_BAR; PG8_SCHED;
            } else {
            PG8_LDB(B0, 0, 0); PG8_SCHED; PG8_LDA(At, 0, 0); PG8_STAGE(PG8_SA(1, 1), a1 + hstep, voffA);
            PG8_WAIT_L(8); PG8_BAR; PG8_WAIT_L(0); PG8_MMA(0, 0, At, B0); PG8_BAR; PG8_SCHED;
            PG8_LDB(B1, 0, 1); PG8_STAGE(PG8_SB(0, 0), b2, voffB);
            PG8_BAR; PG8_WAIT_L(0); PG8_MMA(0, 1, At, B1); PG8_BAR;
            PG8_LDA(At, 0, 1); PG8_STAGE(PG8_SA(0, 0), a2, voffA);
            PG8_BAR; PG8_WAIT_L(0); PG8_MMA(1, 0, At, B0); PG8_BAR; PG8_SCHED;
            PG8_STAGE(PG8_SB(0, 1), b2 + hstep, voffB);
            PG8_WAIT_V(6); PG8_BAR; PG8_MMA(1, 1, At, B1); PG8_BAR;
            PG8_LDB(B0, 1, 0); PG8_SCHED; PG8_LDA(At, 1, 0); PG8_STAGE(PG8_SA(0, 1), a2 + hstep, voffA);
            PG8_WAIT_L(8); PG8_BAR; PG8_WAIT_L(0); PG8_MMA(0, 0, At, B0); PG8_BAR; PG8_SCHED;
            PG8_LDB(B1, 1, 1); PG8_STAGE(PG8_SB(1, 0), b3, voffB);
            PG8_BAR; PG8_WAIT_L(0); PG8_MMA(0, 1, At, B1); PG8_BAR;
            PG8_LDA(At, 1, 1); PG8_STAGE(PG8_SA(1, 0), a3, voffA);
            PG8_BAR; PG8_WAIT_L(0); PG8_MMA(1, 0, At, B0); PG8_BAR; PG8_SCHED;
            PG8_STAGE(PG8_SB(1, 1), b3 + hstep, voffB);
            PG8_WAIT_V(6); PG8_BAR; PG8_MMA(1, 1, At, B1); PG8_BAR;
            }
        }
        if constexpr (ALIGN_EPI) { if (wr == 0) PG8_BAR; }
        if constexpr (!Epi::AFTER_DRAIN) { E(acc, cur, wr, wc, fr, fq); S.done(cur); }
        if (!has_next) break;
#pragma unroll
        for (int a = 0; a < 2; ++a)
#pragma unroll
            for (int b = 0; b < 2; ++b)
#pragma unroll
                for (int m = 0; m < 4; ++m)
#pragma unroll
                    for (int n = 0; n < 2; ++n) acc[a][b][m][n] = (f32x4){0.f, 0.f, 0.f, 0.f};
        cur = nxt; cA = nA; cB = nB; ++ui;
        if constexpr (ALIGN_EPI) { if (wr == 1) PG8_BAR; }
    }
    PG8_WAIT_V(0);
    if constexpr (!ALIGN_EPI) { if (wr == 0) PG8_BAR; }
    PG8_BAR;
    if constexpr (Epi::AFTER_DRAIN) { E.fused(acc, cur, wr, wc, fr, fq, lds, wid, lane); S.done(cur); }
#undef PG8_SA
#undef PG8_SB
#undef PG8_STAGE
#undef PG8_LDA
#undef PG8_LDB
#undef PG8_MMA
#undef PG8_WAIT_V
#undef PG8_WAIT_L
#undef PG8_BAR
#undef PG8_SCHED
}
}

#define XB_TMO      128
#define XB_XCNT(j)  (256  + 64 * (j))
#define XB_XSUB(j)  (1280 + 64 * (j))
#define XB_XGEN(j)  (2304 + 64 * (j))
#define XB_TOP      3328
#define XB_TOPGEN   3392
#define XCD_BAR_WORDS 3456
#define XB_SPIN_CAP (1u << 18)

__device__ __forceinline__ unsigned xb_ld(unsigned* p)              { return __hip_atomic_load(p, __ATOMIC_RELAXED, __HIP_MEMORY_SCOPE_AGENT); }
__device__ __forceinline__ unsigned xb_add(unsigned* p, unsigned v) { return __hip_atomic_fetch_add(p, v, __ATOMIC_RELAXED, __HIP_MEMORY_SCOPE_AGENT); }
__device__ __forceinline__ unsigned xb_xcc_id() { return (unsigned)__builtin_amdgcn_s_getreg((3 << 11) | 20) & 0xFu; }
#define XB_SPIN(cond, bar) do { unsigned _sp = 0; while (cond) { __builtin_amdgcn_s_sleep(1); \
    if ((++_sp & 255u) == 0u) { if (xb_ld(&(bar)[XB_TMO])) break; if (_sp > XB_SPIN_CAP) { atomicAdd(&(bar)[XB_TMO], 1u); break; } } } } while (0)

struct XcdBarrier {
    unsigned* bar; unsigned x;
    volatile LAS unsigned* st;
};

__device__ __forceinline__ XcdBarrier xcd_barrier_post(unsigned* bar, volatile LAS unsigned* st) {
    XcdBarrier b; b.bar = bar; b.x = xb_xcc_id(); b.st = st;
    if (threadIdx.x == 0) (void)xb_add(&bar[XB_XCNT(b.x)], 1u);
    return b;
}
__device__ __forceinline__ void xcd_barrier_complete(unsigned* bar, unsigned x, unsigned& nloc, unsigned& nx) {
    const unsigned G = gridDim.x * gridDim.y * gridDim.z;
    unsigned sum, cnt, mine, sp = 0u;
    for (;;) {
        sum = 0u; cnt = 0u; mine = 0u;
#pragma unroll
        for (unsigned j = 0; j < 16; ++j) { const unsigned c = xb_ld(&bar[XB_XCNT(j)]); sum += c; cnt += (c > 0u) ? 1u : 0u; mine = (j == x) ? c : mine; }
        if (sum == G) break;
        __builtin_amdgcn_s_sleep(1);
        if ((++sp & 255u) == 0u) { if (xb_ld(&bar[XB_TMO])) break; if (sp > XB_SPIN_CAP) { atomicAdd(&bar[XB_TMO], 1u); break; } }
    }
    nloc = mine > 0u ? mine : 1u; nx = cnt > 0u ? cnt : 1u;
}

__device__ __forceinline__ void xcd_barrier(const XcdBarrier& b) {
    asm volatile("s_waitcnt vmcnt(0)" ::: "memory");
    __syncthreads();
    if (threadIdx.x == 0) {
        unsigned* bar = b.bar;
        __builtin_amdgcn_s_waitcnt(0);
        unsigned nloc = b.st[0], nx = b.st[1];
        if (nloc == 0u) { xcd_barrier_complete(bar, b.x, nloc, nx); b.st[0] = nloc; b.st[1] = nx; }
        const unsigned old = xb_add(&bar[XB_XSUB(b.x)], 1u);
        const unsigned gen = old / nloc;
        if (old + 1u == (gen + 1u) * nloc) {
            __builtin_amdgcn_fence(__ATOMIC_RELEASE, "agent");
            asm volatile("s_waitcnt vmcnt(0)" ::: "memory");
            const unsigned og = xb_add(&bar[XB_TOP], 1u);
            const unsigned tg = og / nx;
            if (og + 1u == (tg + 1u) * nx) xb_add(&bar[XB_TOPGEN], 1u);
            else XB_SPIN(xb_ld(&bar[XB_TOPGEN]) == tg, bar);
            __builtin_amdgcn_fence(__ATOMIC_ACQUIRE, "agent");
            xb_add(&bar[XB_XGEN(b.x)], 1u);
            asm volatile("s_waitcnt vmcnt(0)" ::: "memory");
        } else {
            XB_SPIN(xb_ld(&bar[XB_XGEN(b.x)]) == gen, bar);
            __builtin_amdgcn_fence(__ATOMIC_ACQUIRE, "agent");
            asm volatile("s_waitcnt vmcnt(0)" ::: "memory");
        }
    }
    __syncthreads();
}

constexpr int D = 1024, DFF = 2816, NUP = 5632, SEQ = 8192, NBATCH = 2, MP = NBATCH * SEQ, NSQ = 32, TS = 4, MS = NSQ * TS, MT = MP + MS;
constexpr int NQKV = 9216, NH = 16, HD = 64, DEPTH = 4;
constexpr int NWAVES = 8, NTHR = NWAVES * 64;
typedef unsigned short bf16;
typedef float f32x4 __attribute__((ext_vector_type(4)));
typedef unsigned v4u __attribute__((ext_vector_type(4)));
typedef unsigned v2u __attribute__((ext_vector_type(2)));
typedef short bf16x8 __attribute__((ext_vector_type(8)));
#define LDS_WAIT() asm volatile("s_waitcnt lgkmcnt(0)" ::: "memory")

enum { I_XP = 0, I_XS, I_STH, I_STC, I_C128, I_C512, I_C2048, I_NF1, I_NMIX, I_NF2, I_WU1, I_WD1, I_WU2, I_WD2, I_WRIN, I_BRIN, I_WCONV, I_BCONV,
       I_WGA, I_BGA, I_WGX, I_BGX, I_LAM, I_WROUT, I_BROUT, I_WQKV, I_WO, I_NFIN, N_IN };
constexpr size_t O_Y = 0, O_HP = (size_t)MT * D, O_HS = O_HP + 2 * 2 * 1024, O_CP = O_HS + 2 * 32 * 1024, O_CS = O_CP + 2 * 2 * 3 * 1024, O_KV128P = O_CS + 2 * 32 * 3 * 1024,
    O_KV128S = O_KV128P + (size_t)2 * 2 * 128 * 2048, O_KV512P = O_KV128S + (size_t)2 * 32 * 4 * 2048, O_KV512S = O_KV512P + (size_t)2 * 2 * 512 * 2048,
    O_KV2048P = O_KV512S + (size_t)2 * 32 * 4 * 2048, O_KV2048S = O_KV2048P + (size_t)2 * 2 * 2048 * 2048, O_END = O_KV2048S + (size_t)2 * 32 * 4 * 2048;
static_assert(O_END == 40779776, "output size");

constexpr size_t MiB = 1u << 20;
constexpr size_t WS_CTL = 0, CTL_ZERO_BYTES = 1 * MiB;
constexpr size_t WS_CS = 1 * MiB;
constexpr size_t WS_SS = 4 * MiB;
constexpr size_t WS_SSS = 4 * MiB + 512 * 1024;
constexpr size_t WS_CARRY = 5 * MiB;
constexpr size_t WS_LSE = 6 * MiB;
constexpr size_t WS_W = 16 * MiB;
constexpr size_t SZ_WUP = (size_t)NUP * D * 2, SZ_WDN = (size_t)D * DFF * 2, SZ_WRIN = (size_t)2048 * D * 2, SZ_WSQ = (size_t)D * D * 2, SZ_WQKV = (size_t)NQKV * D * 2, SZ_WG = (size_t)8 * 128 * 128 * 2;
constexpr size_t WS_WUP = WS_W, WS_WDN = WS_WUP + 8 * SZ_WUP, WS_WRIN = WS_WDN + 8 * SZ_WDN, WS_WROUT = WS_WRIN + 2 * SZ_WRIN, WS_WQKV = WS_WROUT + 2 * SZ_WSQ, WS_WO = WS_WQKV + 2 * SZ_WQKV,
    WS_WG = WS_WO + 2 * SZ_WSQ, WS_WEND = WS_WG + 4 * SZ_WG;
static_assert(WS_WEND <= 208 * MiB, "weights");
constexpr size_t WS_X = 208 * MiB;
constexpr size_t WS_XB = 273 * MiB;
constexpr size_t WS_HID = 306 * MiB;
constexpr size_t WS_YB = 395 * MiB, WS_XBR = 428 * MiB, WS_AOP = 461 * MiB;
constexpr size_t WS_QKV = 494 * MiB;
constexpr size_t WS_OG = 785 * MiB;
constexpr size_t WS_XC = 979 * MiB, WS_AT = 1044 * MiB, WS_BT = 1109 * MiB, WS_END = 1174 * MiB;
static_assert(WS_X + (size_t)MT * D * 4 <= WS_XB && WS_XB + (size_t)MT * D * 2 <= WS_HID && WS_HID + (size_t)MT * DFF * 2 <= WS_YB && WS_YB + (size_t)MT * D * 2 <= WS_XBR && WS_AOP + (size_t)MT * D * 2 <= WS_QKV &&
              WS_QKV + (size_t)MT * NQKV * 2 <= WS_OG && WS_OG + (size_t)3 * MT * D * 4 <= WS_XC && WS_XC + (size_t)MT * D * 4 <= WS_AT && WS_BT + (size_t)MT * D * 4 <= WS_END, "ws map");
constexpr int CW_BAR = 4096;
constexpr int LDS_BYTES = 147456, RING_BYTES = 131072, MISC_OFF = RING_BYTES + 320, RS_OFF = RING_BYTES + 1024;

__device__ __forceinline__ unsigned f2bf(float f) { unsigned u = __builtin_bit_cast(unsigned, f); return (u + 0x7fffu + ((u >> 16) & 1u)) >> 16; }
__device__ __forceinline__ unsigned pk2(float lo, float hi) { return f2bf(lo) | (f2bf(hi) << 16); }
__device__ __forceinline__ float bf2f(bf16 v) { return __builtin_bit_cast(float, (unsigned)v << 16); }

struct Params { const float* in[N_IN]; float* out; unsigned char* ws; };

struct Frame {
    LAS unsigned char* lds;
    int tid, lane, wave, wg, G;
    const float* in[N_IN]; float* out; unsigned char* ws;
    template <class T> __device__ __forceinline__ T* W(size_t off) const { return (T*)(ws + off); }
};

__device__ __forceinline__ void tr_item(const float* W, int K, int N, int k0, int ns0, bf16* WT, int nd0, const float* gain, LAS float* scr, int lane) {
#pragma unroll 8
    for (int i = 0; i < 32; ++i) { const int kk = 2 * i + (lane >> 5); float v = W[(size_t)(k0 + kk) * N + ns0 + (lane & 31)]; if (gain) v *= gain[k0 + kk]; scr[kk * 33 + (lane & 31)] = v; }
    LDS_WAIT(); asm volatile("" ::: "memory");
    const int c = lane & 7;
#pragma unroll
    for (int j = 0; j < 4; ++j) { const int n = (lane >> 3) + 8 * j; const LAS float* s = scr + (8 * c) * 33 + n;
        v4u o; o.x = pk2(s[0 * 33], s[1 * 33]); o.y = pk2(s[2 * 33], s[3 * 33]); o.z = pk2(s[4 * 33], s[5 * 33]); o.w = pk2(s[6 * 33], s[7 * 33]);
        *(v4u*)(WT + (size_t)(nd0 + n) * K + k0 + 8 * c) = o; }
    LDS_WAIT(); asm volatile("" ::: "memory");
}
__device__ __forceinline__ void cs_entry(int pos, int i, float& c, float& s) {
    const float inv = exp2f(-(float)i * (13.287712379549449f / 32.0f));
    const float angf = (float)pos * inv; const double a = (double)angf;
    const double q = rint(a * 0.63661977236758134308); const double y = (a - q * 1.57079632679489655800) - q * 6.123233995736766e-17;
    const double y2 = y * y;
    const double sn = y * (1.0 + y2 * (-1.0 / 6 + y2 * (1.0 / 120 + y2 * (-1.0 / 5040 + y2 * (1.0 / 362880 + y2 * (-1.0 / 39916800 + y2 * (1.0 / 6227020800.0)))))));
    const double cn = 1.0 + y2 * (-0.5 + y2 * (1.0 / 24 + y2 * (-1.0 / 720 + y2 * (1.0 / 40320 + y2 * (-1.0 / 3628800 + y2 * (1.0 / 479001600.0 + y2 * (-1.0 / 87178291200.0)))))));
    const int qi = (int)((long long)q & 3);
    double cc, ss;
    if (qi == 0) { cc = cn; ss = sn; } else if (qi == 1) { cc = -sn; ss = cn; } else if (qi == 2) { cc = -cn; ss = -sn; } else { cc = sn; ss = -cn; }
    c = (float)cc; s = (float)ss;
}
__device__ __forceinline__ float wave_sum(float v) {
#pragma unroll
    for (int o = 1; o < 64; o <<= 1) v += __shfl_xor(v, o);
    return v;
}
__device__ __forceinline__ void ph_prologue(const Frame& F) {
    LAS float* scr = (LAS float*)(F.lds + F.wave * 16384);
    const int gw = F.wg * NWAVES + F.wave, NGW = F.G * NWAVES, lane = F.lane;
    constexpr int IT_UP = 16 * 176, IT_DN = 44 * 32, IT_RIN = 16 * 64, IT_SQ = 16 * 32, IT_QKV = 16 * 288, IT_G = 2 * 4;
    constexpr int N_UP = 8 * IT_UP, N_DN = 8 * IT_DN, N_RIN = 2 * IT_RIN, N_ROUT = 2 * IT_SQ, N_QKV = 2 * IT_QKV, N_WO = 2 * IT_SQ, N_G = 32 * IT_G;
    constexpr int NITEMS = N_UP + N_DN + N_RIN + N_ROUT + N_QKV + N_WO + N_G;
    for (int it = gw; it < NITEMS; it += NGW) {
        int r = it;
        if (r < N_UP) { const int mat = r / IT_UP, q = r % IT_UP, kb = q / 176, nb = q % 176, l = mat >> 1, f = mat & 1;
            const int n0 = 32 * nb, pn = n0 >> 8, bj = (n0 >> 7) & 1, j0 = n0 & 127, ns0 = bj * DFF + 128 * pn + j0;
            tr_item(F.in[f ? I_WU2 : I_WU1] + (size_t)l * D * NUP, D, NUP, 64 * kb, ns0, F.W<bf16>(WS_WUP + mat * SZ_WUP), n0, F.in[f ? I_NF2 : I_NF1] + l * D, scr, lane); continue; } r -= N_UP;
        if (r < N_DN) { const int mat = r / IT_DN, q = r % IT_DN, kb = q / 32, nb = q % 32, l = mat >> 1, f = mat & 1;
            tr_item(F.in[f ? I_WD2 : I_WD1] + (size_t)l * DFF * D, DFF, D, 64 * kb, 32 * nb, F.W<bf16>(WS_WDN + mat * SZ_WDN), 32 * nb, nullptr, scr, lane); continue; } r -= N_DN;
        if (r < N_RIN) { const int j = r / IT_RIN, q = r % IT_RIN, kb = q / 64, nb = q % 64;
            tr_item(F.in[I_WRIN] + (size_t)j * D * 2048, D, 2048, 64 * kb, 32 * nb, F.W<bf16>(WS_WRIN + j * SZ_WRIN), 32 * nb, F.in[I_NMIX] + (2 * j) * D, scr, lane); continue; } r -= N_RIN;
        if (r < N_ROUT) { const int j = r / IT_SQ, q = r % IT_SQ, kb = q / 32, nb = q % 32;
            tr_item(F.in[I_WROUT] + (size_t)j * D * D, D, D, 64 * kb, 32 * nb, F.W<bf16>(WS_WROUT + j * SZ_WSQ), 32 * nb, nullptr, scr, lane); continue; } r -= N_ROUT;
        if (r < N_QKV) { const int j = r / IT_QKV, q = r % IT_QKV, kb = q / 288, nb = q % 288;
            const int n0 = 32 * nb, pn = n0 >> 8, bj = (n0 >> 7) & 1, hh = (n0 >> 5) & 3, g = pn / 12, which = (pn % 12) >> 2, hq = pn & 3;
            const int ns0 = g * 3072 + which * 1024 + (4 * hq + hh) * 64 + 32 * bj;
            tr_item(F.in[I_WQKV] + (size_t)j * D * NQKV, D, NQKV, 64 * kb, ns0, F.W<bf16>(WS_WQKV + j * SZ_WQKV), n0, F.in[I_NMIX] + (2 * j + 1) * D, scr, lane); continue; } r -= N_QKV;
        if (r < N_WO) { const int j = r / IT_SQ, q = r % IT_SQ, kb = q / 32, nb = q % 32;
            tr_item(F.in[I_WO] + (size_t)j * D * D, D, D, 64 * kb, 32 * nb, F.W<bf16>(WS_WO + j * SZ_WSQ), 32 * nb, nullptr, scr, lane); continue; } r -= N_WO;
        { const int mb = r / IT_G, q = r % IT_G, kb = q / 4, nb = q % 4, j = mb >> 4, ax = (mb >> 3) & 1, blk = mb & 7;
            tr_item(F.in[ax ? I_WGX : I_WGA] + (size_t)(j * 8 + blk) * 16384, 128, 128, 64 * kb, 32 * nb, F.W<bf16>(WS_WG + (size_t)mb * 32768), 32 * nb, nullptr, scr, lane); }
    }
    { float* CS = F.W<float>(WS_CS); const int gt = F.wg * NTHR + F.tid, NGT = F.G * NTHR;
      for (int e = gt; e < 8196 * 32; e += NGT) { float c, s; cs_entry(e >> 5, e & 31, c, s); CS[2 * e] = c; CS[2 * e + 1] = s; } }
    { float* X = F.W<float>(WS_X); bf16* Xb = F.W<bf16>(WS_XB); float* SS = F.W<float>(WS_SS); float* SSS = F.W<float>(WS_SSS);
      for (int m = gw; m < MT; m += NGW) {
          const float* src = m < MP ? F.in[I_XP] + (size_t)m * D : F.in[I_XS] + (size_t)(m - MP) * D; float s = 0.f;
#pragma unroll
          for (int j = 0; j < 4; ++j) { const f32x4 v = *((const f32x4*)src + lane + 64 * j); *((f32x4*)(X + (size_t)m * D) + lane + 64 * j) = v;
              v2u w; w.x = pk2(v.x, v.y); w.y = pk2(v.z, v.w); *((v2u*)(Xb + (size_t)m * D) + lane + 64 * j) = w; s += (v.x * v.x + v.y * v.y) + (v.z * v.z + v.w * v.w); }
          s = wave_sum(s);
          if (m < MP) { if (lane < 4) SS[(size_t)m * 4 + lane] = lane == 0 ? s : 0.f; }
          else { if (lane < 32) SSS[(size_t)(m - MP) * 32 + lane] = lane == 0 ? s : 0.f; }
      } }
}

template <int RT, bool PAIR128, class Epi>
__device__ __forceinline__ void sample_gemm(const Frame& F, const bf16* A, const bf16* Bt, int K, int ncg, const Epi& epi) {
    __syncthreads();
    LAS f32x4* red = (LAS f32x4*)F.lds;
    const int lane = F.lane, fr = lane & 15, fq = lane >> 4, w = F.wave;
    const int ksl = K / 8, nst = ksl / 32, np = ncg * (8 / RT);
    for (int p = F.wg; p < np; p += F.G) {
        const int cg = p / (8 / RT), rtg = p % (8 / RT);
        const int base0 = PAIR128 ? 256 * (cg >> 3) + 16 * (cg & 7) : 32 * cg, base1 = PAIR128 ? base0 + 128 : base0 + 16;
        f32x4 acc[RT][2];
#pragma unroll
        for (int r = 0; r < RT; ++r) { acc[r][0] = (f32x4){0.f, 0.f, 0.f, 0.f}; acc[r][1] = (f32x4){0.f, 0.f, 0.f, 0.f}; }
        const bf16* w0p = Bt + (size_t)(base0 + fr) * K + w * ksl + 8 * fq; const bf16* w1p = Bt + (size_t)(base1 + fr) * K + w * ksl + 8 * fq;
        const bf16* xp = A + (size_t)(16 * rtg * RT + fr) * K + w * ksl + 8 * fq;
        for (int s = 0; s < nst; ++s) {
            const bf16x8 w0 = *(const bf16x8*)(w0p + 32 * s), w1 = *(const bf16x8*)(w1p + 32 * s);
#pragma unroll
            for (int r = 0; r < RT; ++r) { const bf16x8 x = *(const bf16x8*)(xp + (size_t)(16 * r) * K + 32 * s);
                acc[r][0] = __builtin_amdgcn_mfma_f32_16x16x32_bf16(w0, x, acc[r][0], 0, 0, 0); acc[r][1] = __builtin_amdgcn_mfma_f32_16x16x32_bf16(w1, x, acc[r][1], 0, 0, 0); }
        }
#pragma unroll
        for (int r = 0; r < RT; ++r) { red[((w * RT + r) * 2 + 0) * 64 + lane] = acc[r][0]; red[((w * RT + r) * 2 + 1) * 64 + lane] = acc[r][1]; }
        __syncthreads();
        for (int r = w; r < RT; r += NWAVES) {
            f32x4 v0 = (f32x4){0.f, 0.f, 0.f, 0.f}, v1 = v0;
#pragma unroll
            for (int ww = 0; ww < NWAVES; ++ww) { v0 += red[((ww * RT + r) * 2 + 0) * 64 + lane]; v1 += red[((ww * RT + r) * 2 + 1) * 64 + lane]; }
            epi(16 * (rtg * RT + r) + fr, cg, fq, v0, v1);
        }
        __syncthreads();
    }
}
__device__ __forceinline__ LAS float* sample_rs(const Frame& F) {
    __syncthreads();
    LAS float* rs = (LAS float*)(F.lds + RS_OFF);
    if (F.tid < MS) { const f32x4* p = (const f32x4*)(F.W<float>(WS_SSS) + (size_t)F.tid * 32); float s = 0.f;
#pragma unroll
        for (int i = 0; i < 8; ++i) { const f32x4 v = p[i]; s += (v.x + v.y) + (v.z + v.w); }
        rs[F.tid] = rsqrtf(s * (1.f / 1024.f) + 1e-6f); }
    __syncthreads();
    return rs;
}
using pg8::silu_mul; using pg8::gelu_tanh;
struct SEpiUp { LAS float* rs; bf16* H;
    __device__ __forceinline__ void operator()(int srow, int cg, int fq, f32x4 v0, f32x4 v1) const {
        const float r = rs[srow]; v0 *= r; v1 *= r;
        v2u w; w.x = pk2(silu_mul(v0.x, v1.x), silu_mul(v0.y, v1.y)); w.y = pk2(silu_mul(v0.z, v1.z), silu_mul(v0.w, v1.w));
        *(v2u*)(H + (size_t)(MP + srow) * DFF + 128 * (cg >> 3) + 16 * (cg & 7) + 4 * fq) = w; } };
struct SEpiRes { float* X; bf16* Xb; float* SSS; const float* bias; float scale;
    __device__ __forceinline__ void operator()(int srow, int cg, int fq, f32x4 v0, f32x4 v1) const {
        const int c = 32 * cg + 4 * fq; float* xp = X + (size_t)(MP + srow) * D + c;
        f32x4 x0 = *(const f32x4*)xp, x1 = *(const f32x4*)(xp + 16);
        if (bias) { x0 += *(const f32x4*)(bias + c); x1 += *(const f32x4*)(bias + c + 16); }
        x0 += v0 * scale; x1 += v1 * scale;
        *(f32x4*)xp = x0; *(f32x4*)(xp + 16) = x1;
        bf16* xb = Xb + (size_t)(MP + srow) * D + c;
        v2u a; a.x = pk2(x0.x, x0.y); a.y = pk2(x0.z, x0.w); *(v2u*)xb = a; a.x = pk2(x1.x, x1.y); a.y = pk2(x1.z, x1.w); *(v2u*)(xb + 16) = a;
        float ssq = (x0.x * x0.x + x0.y * x0.y) + (x0.z * x0.z + x0.w * x0.w) + (x1.x * x1.x + x1.y * x1.y) + (x1.z * x1.z + x1.w * x1.w);
        ssq += __shfl_xor(ssq, 16); ssq += __shfl_xor(ssq, 32);
        if (fq == 0) SSS[(size_t)srow * 32 + cg] = ssq; } };
struct SEpiRin { LAS float* rs; const float* bias; bf16* YB; bf16* XBR;
    __device__ __forceinline__ void operator()(int srow, int cg, int fq, f32x4 v0, f32x4 v1) const {
        const float r = rs[srow]; const int c = 32 * cg + 4 * fq;
        v0 = v0 * r + *(const f32x4*)(bias + c); v1 = v1 * r + *(const f32x4*)(bias + c + 16);
        const bool isy = c < 1024;
        if (isy) { v0.x = gelu_tanh(v0.x); v0.y = gelu_tanh(v0.y); v0.z = gelu_tanh(v0.z); v0.w = gelu_tanh(v0.w); v1.x = gelu_tanh(v1.x); v1.y = gelu_tanh(v1.y); v1.z = gelu_tanh(v1.z); v1.w = gelu_tanh(v1.w); }
        bf16* o = (isy ? YB : XBR) + (size_t)(MP + srow) * D + (isy ? c : c - 1024);
        v2u a; a.x = pk2(v0.x, v0.y); a.y = pk2(v0.z, v0.w); *(v2u*)o = a; a.x = pk2(v1.x, v1.y); a.y = pk2(v1.z, v1.w); *(v2u*)(o + 16) = a; } };
struct SEpiQkv { LAS float* rs; const float* CS; bf16* QKV; float* out; int j;
    __device__ __forceinline__ void operator()(int srow, int cg, int fq, f32x4 v0, f32x4 v1) const {
        const int pn = cg >> 3, sub = cg & 7, g = pn / 12, which = (pn % 12) >> 2, hq = pn & 3, head = 4 * hq + (sub >> 1), dd = 16 * (sub & 1) + 4 * fq;
        const float r = rs[srow]; v0 *= r; v1 *= r;
        if (which < 2) { const int pos = SEQ + (srow & 3); const f32x4* cs = (const f32x4*)(CS + ((size_t)pos * 32 + dd) * 2); pg8::rope4(v0, v1, cs[0], cs[1]);
            if (which == 0) { v0 *= 0.125f; v1 *= 0.125f; } }
        bf16* o = QKV + (size_t)(MP + srow) * NQKV + g * 3072 + which * 1024 + head * 64 + dd;
        v2u a; a.x = pk2(v0.x, v0.y); a.y = pk2(v0.z, v0.w); *(v2u*)o = a; a.x = pk2(v1.x, v1.y); a.y = pk2(v1.z, v1.w); *(v2u*)(o + 32) = a;
        if (which >= 1) { float* kp = out + (g == 0 ? O_KV128S : (g == 1 ? O_KV512S : O_KV2048S)) + (size_t)j * 32 * 4 * 2048 + ((size_t)srow * 2 + (which - 1)) * 1024 + head * 64 + dd; *(f32x4*)kp = v0; *(f32x4*)(kp + 32) = v1; } } };

#define GEMM_SP2 true
__device__ __forceinline__ void ph_up(const Frame& F, int l, int f) {
    const int mat = l * 2 + f; const bf16* Bt = F.W<bf16>(WS_WUP + mat * SZ_WUP);
    { pg8::Gemm g{F.W<bf16>(WS_XB), Bt, MP, NUP, D}; pg8::StaticOrder S; S.init(MP, NUP, F.G, F.wg);
      pg8::EpiUp E{F.W<float>(WS_SS), F.W<bf16>(WS_HID)};
      pg8::gemm_phase<pg8::EpiUp, pg8::StaticOrder, true, GEMM_SP2>(F.lds, g, S, E); }
    { LAS float* rs = sample_rs(F); SEpiUp E{rs, F.W<bf16>(WS_HID)};
      sample_gemm<8, true, SEpiUp>(F, F.W<bf16>(WS_XB) + (size_t)MP * D, Bt, D, NUP / 32, E); }
}
__device__ __forceinline__ void ph_res(const Frame& F, const bf16* A, const bf16* Bt, int K, const float* bias, float scale) {
    { pg8::Gemm g{A, Bt, MP, D, K}; pg8::StaticOrder S; S.init(MP, D, F.G, F.wg);
      pg8::EpiRes E{F.W<float>(WS_X), F.W<bf16>(WS_XB), F.W<float>(WS_SS), bias, scale};
      pg8::gemm_phase<pg8::EpiRes, pg8::StaticOrder, false, GEMM_SP2>(F.lds, g, S, E); }
    { SEpiRes E{F.W<float>(WS_X), F.W<bf16>(WS_XB), F.W<float>(WS_SSS), bias, scale};
      sample_gemm<1, false, SEpiRes>(F, A + (size_t)MP * K, Bt, K, D / 32, E); }
}
__device__ __forceinline__ void ph_rin(const Frame& F, int j) {
    const bf16* Bt = F.W<bf16>(WS_WRIN + j * SZ_WRIN); const float* bias = F.in[I_BRIN] + j * 2048;
    { pg8::Gemm g{F.W<bf16>(WS_XB), Bt, MP, 2048, D}; pg8::StaticOrder S; S.init(MP, 2048, F.G, F.wg);
      pg8::EpiRin E{F.W<float>(WS_SS), bias, F.W<bf16>(WS_YB), F.W<bf16>(WS_XBR)};
      pg8::gemm_phase<pg8::EpiRin, pg8::StaticOrder, true, GEMM_SP2>(F.lds, g, S, E); }
    { LAS float* rs = sample_rs(F); SEpiRin E{rs, bias, F.W<bf16>(WS_YB), F.W<bf16>(WS_XBR)};
      sample_gemm<2, false, SEpiRin>(F, F.W<bf16>(WS_XB) + (size_t)MP * D, Bt, D, 2048 / 32, E); }
}
__device__ __forceinline__ void ph_qkv(const Frame& F, int j) {
    const bf16* Bt = F.W<bf16>(WS_WQKV + j * SZ_WQKV);
    { pg8::Gemm g{F.W<bf16>(WS_XB), Bt, MP, NQKV, D}; pg8::StaticOrder S; S.init(MP, NQKV, F.G, F.wg);
      static_assert(O_KV128P == 17186816 && O_KV512P == 18759680 && O_KV2048P == 23478272, "EpiQkv offsets");
      pg8::EpiQkv E{F.W<float>(WS_SS), F.W<float>(WS_CS), F.W<bf16>(WS_QKV), F.out, j};
      pg8::gemm_phase<pg8::EpiQkv, pg8::StaticOrder, true, GEMM_SP2>(F.lds, g, S, E); }
    { LAS float* rs = sample_rs(F);
      SEpiQkv E{rs, F.W<float>(WS_CS), F.W<bf16>(WS_QKV), F.out, j};
      sample_gemm<8, true, SEpiQkv>(F, F.W<bf16>(WS_XB) + (size_t)MP * D, Bt, D, NQKV / 32, E); }
}

__device__ __forceinline__ float sigmoidf_(float x) { return 1.f / (1.f + expf(-x)); }
__device__ __forceinline__ void ph_conv_simple(const Frame& F, int j) {
    const bf16* XBR = F.W<bf16>(WS_XBR); float* XC = F.W<float>(WS_XC);
    const float* wc = F.in[I_WCONV] + j * 4 * D; const float* bc = F.in[I_BCONV] + j * D; const float* st = F.in[I_STC] + (size_t)j * NSQ * 3 * D;
    for (size_t idx = (size_t)F.wg * NTHR + F.tid; idx < (size_t)MT * D; idx += (size_t)F.G * NTHR) {
        const int row = (int)(idx >> 10), c = (int)(idx & 1023); const bool samp = row >= MP; const int t = samp ? ((row - MP) & 3) : (row & 8191); const int r0 = row - t;
        float a = bc[c];
#pragma unroll
        for (int k = 0; k < 4; ++k) { const int tt = t + k - 3; float xv;
            if (tt >= 0) xv = bf2f(XBR[(size_t)(r0 + tt) * D + c]); else if (samp) xv = st[((size_t)((row - MP) >> 2) * 3 + (tt + 3)) * D + c]; else xv = 0.f;
            a += wc[k * D + c] * xv; }
        XC[idx] = a;
    }
}
__device__ __forceinline__ void ph_gates_simple(const Frame& F, int j) {
    const float* XC = F.W<float>(WS_XC); float* AT = F.W<float>(WS_AT); float* BT = F.W<float>(WS_BT);
    for (size_t idx = (size_t)F.wg * NTHR + F.tid; idx < (size_t)MT * D; idx += (size_t)F.G * NTHR) {
        const int row = (int)(idx >> 10), c = (int)(idx & 1023), blk = c >> 7, jc = c & 127;
        const float* xr = XC + (size_t)row * D + blk * 128; const float* wa = F.in[I_WGA] + (size_t)(j * 8 + blk) * 16384 + jc; const float* wx = F.in[I_WGX] + (size_t)(j * 8 + blk) * 16384 + jc;
        float sa = F.in[I_BGA][j * D + c], sx = F.in[I_BGX][j * D + c];
        for (int i = 0; i < 128; ++i) { const float xv = xr[i]; sa += xv * wa[i * 128]; sx += xv * wx[i * 128]; }
        const float ga = sigmoidf_(sa), gx = sigmoidf_(sx); const float lam = F.in[I_LAM][j * D + c]; const float sp = log1pf(expf(-lam));
        const float la = -8.0f * ga * sp; AT[idx] = expf(la); BT[idx] = sqrtf(-expm1f(2.f * la)) * gx * XC[idx];
    }
}
__device__ __forceinline__ void ph_scan_simple(const Frame& F, int j) {
    const float* AT = F.W<float>(WS_AT); const float* BT = F.W<float>(WS_BT); const bf16* YB = F.W<bf16>(WS_YB); const bf16* XBR = F.W<bf16>(WS_XBR); bf16* HY = F.W<bf16>(WS_AOP);
    for (int idx = F.wg * NTHR + F.tid; idx < 34 * D; idx += F.G * NTHR) {
        const int s = idx >> 10, c = idx & 1023; int row0, n; float h;
        if (s < 2) { row0 = s * SEQ; n = SEQ; h = 0.f; } else { row0 = MP + 4 * (s - 2); n = 4; h = F.in[I_STH][(size_t)(j * NSQ + (s - 2)) * D + c]; }
        for (int t = 0; t < n; ++t) { const size_t o = (size_t)(row0 + t) * D + c; h = AT[o] * h + BT[o]; HY[o] = (bf16)f2bf(h * bf2f(YB[o])); }
        if (s < 2) { F.out[O_HP + (size_t)(j * 2 + s) * D + c] = h;
            for (int i = 0; i < 3; ++i) F.out[O_CP + ((size_t)(j * 2 + s) * 3 + i) * D + c] = bf2f(XBR[(size_t)(row0 + SEQ - 3 + i) * D + c]); }
        else { F.out[O_HS + (size_t)(j * NSQ + (s - 2)) * D + c] = h;
            for (int i = 0; i < 3; ++i) F.out[O_CS + ((size_t)(j * NSQ + (s - 2)) * 3 + i) * D + c] = bf2f(XBR[(size_t)(row0 + 1 + i) * D + c]); }
    }
}
__device__ __forceinline__ void ph_attn_simple(const Frame& F, int j) {
    const bf16* QKV = F.W<bf16>(WS_QKV); float* OG = F.W<float>(WS_OG); float* LSE = F.W<float>(WS_LSE);
    const float* c0 = F.in[I_C128]; const float* c1 = F.in[I_C512]; const float* c2 = F.in[I_C2048];
    for (int idx = F.wg * NTHR + F.tid; idx < MT * 96; idx += F.G * NTHR) {
        const int half = idx & 1, head = (idx >> 1) & 15, g = (idx >> 5) % 3, row = idx / 96; const bool samp = row >= MP;
        const int dil = 1 << (2 * g), Wg = 128 << (2 * g); const int t = samp ? ((row - MP) & 3) : (row & 8191), pos = samp ? SEQ + t : t, nsq = (row - MP) >> 2;
        const float* cache = (g == 0 ? c0 : (g == 1 ? c1 : c2)) + (size_t)(j * NSQ + (samp ? nsq : 0)) * Wg * 2048;
        float q[32], o[32];
        { const bf16* qp = QKV + (size_t)row * NQKV + g * 3072 + head * 64 + 32 * half;
#pragma unroll
          for (int i = 0; i < 32; ++i) { q[i] = bf2f(qp[i]); o[i] = 0.f; } }
        float mx = -INFINITY, l = 0.f;
        for (int k = 0; k <= 128; ++k) {
            const int p = pos - dil * k; if (p < 0) break;
            float s = 0.f;
            const bool newtok = (!samp || p >= SEQ);
            const bf16* kpb = QKV + (size_t)(row - dil * k) * NQKV + g * 3072 + 1024 + head * 64 + 32 * half;
            const float* kpf = cache + ((size_t)(p - (SEQ - Wg)) * 2) * 1024 + head * 64 + 32 * half;
            if (newtok) {
#pragma unroll
                for (int i = 0; i < 32; ++i) s += q[i] * bf2f(kpb[i]);
            } else {
#pragma unroll
                for (int i = 0; i < 32; ++i) s += q[i] * kpf[i];
            }
            s += __shfl_xor(s, 1);
            const float mn = fmaxf(mx, s), corr = expf(mx - mn), pe = expf(s - mn);
            l = l * corr + pe;
            if (newtok) {
#pragma unroll
                for (int i = 0; i < 32; ++i) o[i] = o[i] * corr + pe * bf2f(kpb[1024 + i]);
            } else {
#pragma unroll
                for (int i = 0; i < 32; ++i) o[i] = o[i] * corr + pe * kpf[1024 + i];
            }
            mx = mn;
        }
        const float inv = 1.f / l; float* op = OG + ((size_t)g * MT + row) * D + head * 64 + 32 * half;
#pragma unroll
        for (int i = 0; i < 32; ++i) op[i] = o[i] * inv;
        if (half == 0) LSE[((size_t)g * MT + row) * 16 + head] = mx + logf(l);
    }
}
__device__ __forceinline__ void ph_merge_simple(const Frame& F) {
    const float* OG = F.W<float>(WS_OG); const float* LSE = F.W<float>(WS_LSE); bf16* OM = F.W<bf16>(WS_AOP);
    for (size_t idx = (size_t)F.wg * NTHR + F.tid; idx < (size_t)MT * D; idx += (size_t)F.G * NTHR) {
        const size_t row = idx >> 10; const int c = (int)(idx & 1023), head = c >> 6;
        const float l0 = LSE[(0 * (size_t)MT + row) * 16 + head], l1 = LSE[(1 * (size_t)MT + row) * 16 + head], l2 = LSE[(2 * (size_t)MT + row) * 16 + head];
        const float mx = fmaxf(l0, fmaxf(l1, l2)), w0 = expf(l0 - mx), w1 = expf(l1 - mx), w2 = expf(l2 - mx);
        const float v = (w0 * OG[idx] + w1 * OG[(size_t)MT * D + idx] + w2 * OG[2 * (size_t)MT * D + idx]) / (w0 + w1 + w2);
        OM[idx] = (bf16)f2bf(v);
    }
}
__device__ __forceinline__ void ph_final(const Frame& F) {
    const float* X = F.W<float>(WS_X); const float* SS = F.W<float>(WS_SS); const float* SSS = F.W<float>(WS_SSS); const float* gf = F.in[I_NFIN];
    const int gw = F.wg * NWAVES + F.wave, NGW = F.G * NWAVES, lane = F.lane;
    for (int m = gw; m < MT; m += NGW) {
        float s;
        if (m < MP) { const f32x4 v = *(const f32x4*)(SS + (size_t)m * 4); s = (v.x + v.y) + (v.z + v.w); }
        else { const float v = lane < 32 ? SSS[(size_t)(m - MP) * 32 + lane] : 0.f; s = wave_sum(v); }
        const float rs = rsqrtf(s * (1.f / 1024.f) + 1e-6f);
#pragma unroll
        for (int jj = 0; jj < 4; ++jj) { const f32x4 v = *((const f32x4*)(X + (size_t)m * D) + lane + 64 * jj); const f32x4 gg = *((const f32x4*)gf + lane + 64 * jj);
            *((f32x4*)(F.out + O_Y + (size_t)m * D) + lane + 64 * jj) = v * rs * gg; }
    }
}

enum { PH_PRO = 0, PH_UP, PH_DN, PH_RIN, PH_CONV, PH_GATES, PH_SCAN, PH_ROUT, PH_QKV, PH_ATTN, PH_MERGE, PH_AOUT, PH_FINAL };
template <int PH>
__global__ void __launch_bounds__(NTHR, 2) k_phase(Params p, int l, int f) {
    extern __shared__ __attribute__((aligned(16))) unsigned char lds_raw[];
    Frame F;
    F.lds = (LAS unsigned char*)lds_raw; F.tid = threadIdx.x; F.lane = F.tid & 63; F.wave = __builtin_amdgcn_readfirstlane(F.tid >> 6); F.wg = blockIdx.x; F.G = gridDim.x;
#pragma unroll
    for (int i = 0; i < N_IN; ++i) F.in[i] = p.in[i];
    F.out = p.out; F.ws = p.ws;
    const int j = l >> 1;
    if constexpr (PH == PH_PRO) ph_prologue(F);
    if constexpr (PH == PH_UP) ph_up(F, l, f);
    if constexpr (PH == PH_DN) ph_res(F, F.W<bf16>(WS_HID), F.W<bf16>(WS_WDN + (l * 2 + f) * SZ_WDN), DFF, nullptr, 0.5f);
    if constexpr (PH == PH_RIN) ph_rin(F, j);
    if constexpr (PH == PH_CONV) ph_conv_simple(F, j);
    if constexpr (PH == PH_GATES) ph_gates_simple(F, j);
    if constexpr (PH == PH_SCAN) ph_scan_simple(F, j);
    if constexpr (PH == PH_ROUT) ph_res(F, F.W<bf16>(WS_AOP), F.W<bf16>(WS_WROUT + j * SZ_WSQ), D, F.in[I_BROUT] + j * D, 1.0f);
    if constexpr (PH == PH_QKV) ph_qkv(F, j);
    if constexpr (PH == PH_ATTN) ph_attn_simple(F, j);
    if constexpr (PH == PH_MERGE) ph_merge_simple(F);
    if constexpr (PH == PH_AOUT) ph_res(F, F.W<bf16>(WS_AOP), F.W<bf16>(WS_WO + j * SZ_WSQ), D, nullptr, 1.0f);
    if constexpr (PH == PH_FINAL) ph_final(F);
}

template <int PH> static void launch_phase(const Params& p, int l, int f, int grid, hipStream_t stream) {
    static bool attr = false;
    if (!attr) { (void)hipFuncSetAttribute((const void*)k_phase<PH>, hipFuncAttributeMaxDynamicSharedMemorySize, LDS_BYTES); attr = true; }
    hipLaunchKernelGGL(k_phase<PH>, dim3(grid), dim3(NTHR), LDS_BYTES, stream, p, l, f);
}

extern "C" void kernel_launch(void* const* d_in, const int* in_sizes, int n_in, void* d_out, int out_size, void* d_ws, size_t ws_size, hipStream_t stream) {
    if (n_in != N_IN || (size_t)out_size != O_END || ws_size < WS_END) { fprintf(stderr, "kernel_launch: unexpected shapes (n_in %d, out %d, ws %zu); nothing launched\n", n_in, out_size, ws_size); return; }
    Params p{};
    for (int i = 0; i < N_IN; ++i) p.in[i] = (const float*)d_in[i];
    p.out = (float*)d_out; p.ws = (unsigned char*)d_ws;
    const int grid = 256;
    (void)hipMemsetAsync((char*)d_ws + WS_CTL, 0, CTL_ZERO_BYTES, stream);
    launch_phase<PH_PRO>(p, 0, 0, grid, stream);
    for (int l = 0; l < DEPTH; ++l) {
        launch_phase<PH_UP>(p, l, 0, grid, stream); launch_phase<PH_DN>(p, l, 0, grid, stream);
        if ((l & 1) == 0) { launch_phase<PH_RIN>(p, l, 0, grid, stream); launch_phase<PH_CONV>(p, l, 0, grid, stream); launch_phase<PH_GATES>(p, l, 0, grid, stream); launch_phase<PH_SCAN>(p, l, 0, grid, stream); launch_phase<PH_ROUT>(p, l, 0, grid, stream); }
        else { launch_phase<PH_QKV>(p, l, 0, grid, stream); launch_phase<PH_ATTN>(p, l, 0, grid, stream); launch_phase<PH_MERGE>(p, l, 0, grid, stream); launch_phase<PH_AOUT>(p, l, 0, grid, stream); }
        launch_phase<PH_UP>(p, l, 1, grid, stream); launch_phase<PH_DN>(p, l, 1, grid, stream);
    }
    launch_phase<PH_FINAL>(p, 0, 0, grid, stream);
}
```

```cpp
#include <hip/hip_runtime.h>
#include <cstdio>
#include <cstdint>
#include <cmath>
#define LAS __attribute__((address_space(3)))
namespace pg8 {
#define PG8_LAS __attribute__((address_space(3)))
typedef unsigned short bf16_t;
typedef short bf16x8 __attribute__((ext_vector_type(8)));
typedef float f32x4 __attribute__((ext_vector_type(4)));
typedef unsigned u32x4 __attribute__((ext_vector_type(4)));
constexpr int BM = 256, BK = 64, HALF = 128, HTB = HALF * BK * 2  , STAGE_BYTES = 8 * HTB, NXCD = 8, WGM = 8;

__host__ __device__ __forceinline__ int lds_byte(int r, int c) { const int st = (r >> 4) * 2 + (c >> 5), rr = r & 15, cc = c & 31, ob = rr * 64 + cc * 2; return st * 1024 + (ob ^ (((ob >> 9) & 1) << 5)); }
__host__ __device__ __forceinline__ void stage_rc(int b, int& R, int& C) { const int st = b / 1024, sb = b % 1024, swz = sb ^ (((sb >> 9) & 1) << 5); R = (st >> 1) * 16 + swz / 64; C = (st & 1) * 32 + (swz % 64) / 2; }
__host__ __device__ __forceinline__ int perm32(int rho) { const int n = rho >> 4, i = rho & 15; return 8 * (i >> 2) + 4 * n + (i & 3); }

struct Unit { int pm, pn; };
struct Gemm { const bf16_t* A; const bf16_t* Bt; int M, N, K; };

struct StaticOrder {
    int nM, nN, nwg, G, c;
    __host__ __device__ void init(int M, int N, int G_, int c_) { nM = M / BM; nN = N / BM; nwg = nM * nN; G = G_; c = c_; }
    __host__ __device__ bool next(int i, Unit& u) const {
        const long L = (long)i * G + c; if (L >= nwg) return false;
        int wgid = (int)L; { const int q = nwg / NXCD, r = nwg % NXCD, xcd = wgid % NXCD, off = wgid / NXCD; wgid = (xcd < r ? xcd * (q + 1) : r * (q + 1) + (xcd - r) * q) + off; }
        const int nig = WGM * nN, gid = wgid / nig, fm = gid * WGM, gsz = (nM - fm) < WGM ? (nM - fm) : WGM;
        u.pm = fm + ((wgid % nig) % gsz); u.pn = (wgid % nig) / gsz; return true;
    }
    __device__ __forceinline__ void a_ready(const Unit&) const {}
    __device__ __forceinline__ void done(const Unit&) const {}
};

typedef float f32x2_cv __attribute__((ext_vector_type(2))); typedef __bf16 bf16x2_cv __attribute__((ext_vector_type(2)));
__device__ __forceinline__ unsigned cvt_pk_bf16(float lo, float hi) { const f32x2_cv v = {lo, hi}; const bf16x2_cv b = __builtin_convertvector(v, bf16x2_cv); return __builtin_bit_cast(unsigned, b); }
typedef float f32x2 __attribute__((ext_vector_type(2)));
__device__ __forceinline__ float shfl_at(float v, int srclane) { return __builtin_bit_cast(float, __builtin_amdgcn_ds_bpermute(srclane << 2, __builtin_bit_cast(int, v))); }
__device__ __forceinline__ float shx(float v, int lane, int k) { return shfl_at(v, lane ^ k); }
typedef unsigned u32x2 __attribute__((ext_vector_type(2)));
__device__ __forceinline__ float frcp(float x) { return __builtin_amdgcn_rcpf(x); }
__device__ __forceinline__ float silu_mul(float g, float u) { return g * u * frcp(1.f + __expf(-g)); }
__device__ __forceinline__ f32x2 silu_mul2(const f32x2 g, const f32x2 u, const f32x2 c1, const f32x2 ir) { const f32x2 t = g * c1; f32x2 e; e.x = __builtin_amdgcn_exp2f(t.x); e.y = __builtin_amdgcn_exp2f(t.y);
    const f32x2 d = e * ir + ir; f32x2 r; r.x = frcp(d.x); r.y = frcp(d.y); return (g * u) * r; }
__device__ __forceinline__ float gelu_tanh(float x) { const float uu = 1.5957691216057308f * (x + 0.044715f * x * x * x); return x * frcp(1.f + __expf(-uu)); }
__device__ __forceinline__ float row_rs(const float* SS, int row) { const f32x4 s4 = *(const f32x4*)(SS + (size_t)row * 4); return rsqrtf(((s4.x + s4.y) + (s4.z + s4.w)) * (1.f / 1024.f) + 1e-6f); }
__device__ __forceinline__ u32x4 pack8(const f32x4& a, const f32x4& b) { u32x4 w; w.x = cvt_pk_bf16(a.x, a.y); w.y = cvt_pk_bf16(a.z, a.w); w.z = cvt_pk_bf16(b.x, b.y); w.w = cvt_pk_bf16(b.z, b.w); return w; }

struct EpiUp {
    static constexpr bool PERM = true, AFTER_DRAIN = false;
    const float* SS; bf16_t* H; const PG8_LAS float* rs_s;
    __device__ __forceinline__ void operator()(const f32x4 (&acc)[2][2][4][2], const Unit& u, int wr, int wc, int fr, int fq) const {
        const int row0 = u.pm * BM + wr * 64 + fr, col0 = u.pn * 128 + wc * 32 + 8 * fq; const bool smp = u.pm >= 64;
        float rsv[2][4];
#pragma unroll
        for (int ai = 0; ai < 2; ++ai)
#pragma unroll
            for (int m = 0; m < 4; ++m) rsv[ai][m] = row_rs(SS, smp ? 0 : row0 + ai * HALF + m * 16);
        if (smp) {
#pragma unroll
            for (int ai = 0; ai < 2; ++ai)
#pragma unroll
                for (int m = 0; m < 4; ++m) rsv[ai][m] = rs_s[(row0 + ai * HALF + m * 16 - 16384) & 127]; }
#pragma unroll
        for (int ai = 0; ai < 2; ++ai)
#pragma unroll
            for (int m = 0; m < 4; ++m) {
                const int row = row0 + ai * HALF + m * 16; const float rs = rsv[ai][m];
                const float c1s = rs * -1.4426950408889634f, irs = frcp(rs * rs); const f32x2 c1 = {c1s, c1s}, ir = {irs, irs};
                const f32x4 ga = acc[ai][0][m][0], gb = acc[ai][0][m][1], ua = acc[ai][1][m][0], ub = acc[ai][1][m][1];
                const f32x2 q0 = silu_mul2((f32x2){ga.x, ga.y}, (f32x2){ua.x, ua.y}, c1, ir), q1 = silu_mul2((f32x2){ga.z, ga.w}, (f32x2){ua.z, ua.w}, c1, ir);
                const f32x2 q2 = silu_mul2((f32x2){gb.x, gb.y}, (f32x2){ub.x, ub.y}, c1, ir), q3 = silu_mul2((f32x2){gb.z, gb.w}, (f32x2){ub.z, ub.w}, c1, ir);
                const f32x4 h0 = {q0.x, q0.y, q1.x, q1.y}, h1 = {q2.x, q2.y, q3.x, q3.y};
                *(u32x4*)(H + (size_t)row * 2816 + col0) = pack8(h0, h1);
            }
    }
};

__device__ __forceinline__ float ublo(unsigned u) { return __builtin_bit_cast(float, u << 16); }
__device__ __forceinline__ float ubhi(unsigned u) { return __builtin_bit_cast(float, u & 0xffff0000u); }
struct EpiRes {
    static constexpr bool PERM = true, AFTER_DRAIN = true;
    bf16_t* Xb; float* SS; const float* bias; float scale;
    __device__ __forceinline__ void fused(f32x4 (&acc)[2][2][4][2], const Unit& u, int wr, int wc, int fr, int fq, PG8_LAS unsigned char* lds, int wid, int lane) const {
        PG8_LAS float* P = (PG8_LAS float*)lds;
        const int col0 = u.pn * BM + wc * 32 + 8 * fq;
        f32x4 bv[2][2];
#pragma unroll
        for (int bj = 0; bj < 2; ++bj) { bv[bj][0] = bias ? *(const f32x4*)(bias + col0 + bj * HALF) : (f32x4){0.f, 0.f, 0.f, 0.f}; bv[bj][1] = bias ? *(const f32x4*)(bias + col0 + bj * HALF + 4) : (f32x4){0.f, 0.f, 0.f, 0.f}; }
        u32x4 xw[2][4][2];
#pragma unroll
        for (int ai = 0; ai < 2; ++ai)
#pragma unroll
            for (int m = 0; m < 4; ++m)
#pragma unroll
                for (int bj = 0; bj < 2; ++bj) xw[ai][m][bj] = *(const u32x4*)(Xb + ((size_t)u.pm * BM + ai * HALF + wr * 64 + m * 16 + fr) * 1024 + col0 + bj * HALF);
#pragma unroll
        for (int ai = 0; ai < 2; ++ai)
#pragma unroll
            for (int m = 0; m < 4; ++m) {
                const int rt = ai * HALF + wr * 64 + m * 16 + fr; const size_t row = (size_t)u.pm * BM + rt; float ssq = 0.f;
#pragma unroll
                for (int bj = 0; bj < 2; ++bj) {
                    bf16_t* xp = Xb + row * 1024 + col0 + bj * HALF; const u32x4 xv = xw[ai][m][bj];
                    f32x4 x0 = (f32x4){ublo(xv.x), ubhi(xv.x), ublo(xv.y), ubhi(xv.y)}, x1 = (f32x4){ublo(xv.z), ubhi(xv.z), ublo(xv.w), ubhi(xv.w)};
                    x0 += acc[ai][bj][m][0] * scale + bv[bj][0]; x1 += acc[ai][bj][m][1] * scale + bv[bj][1];
                    *(u32x4*)xp = pack8(x0, x1);
                    ssq += (x0.x * x0.x + x0.y * x0.y) + (x0.z * x0.z + x0.w * x0.w) + (x1.x * x1.x + x1.y * x1.y) + (x1.z * x1.z + x1.w * x1.w);
                }
                ssq += shx(ssq, lane, 16); ssq += shx(ssq, lane, 32);
                if (fq == 0) P[rt * 4 + wc] = ssq;
            }
        asm volatile("s_waitcnt lgkmcnt(0)" ::: "memory"); __builtin_amdgcn_s_barrier(); asm volatile("" ::: "memory");
        const int t = wid * 64 + lane;
        if (t < 256) { const f32x4 p = *(const PG8_LAS f32x4*)(P + t * 4); SS[((size_t)u.pm * BM + t) * 4 + u.pn] = (p.x + p.y) + (p.z + p.w); }
    }
};

struct EpiRin {
    static constexpr bool PERM = true, AFTER_DRAIN = false;
    const float* SS; const float* bias; bf16_t* YB; bf16_t* XBR;
    __device__ __forceinline__ void operator()(const f32x4 (&acc)[2][2][4][2], const Unit& u, int wr, int wc, int fr, int fq) const {
        const int row0 = u.pm * BM + wr * 64 + fr, col0 = u.pn * BM + wc * 32 + 8 * fq; const bool isy = u.pn < 4;
        bf16_t* O = isy ? YB : XBR; const int oc0 = isy ? col0 : col0 - 1024;
        f32x4 bv[2][2];
#pragma unroll
        for (int bj = 0; bj < 2; ++bj) { bv[bj][0] = *(const f32x4*)(bias + col0 + bj * HALF); bv[bj][1] = *(const f32x4*)(bias + col0 + bj * HALF + 4); }
        float rsv[2][4];
#pragma unroll
        for (int ai = 0; ai < 2; ++ai)
#pragma unroll
            for (int m = 0; m < 4; ++m) rsv[ai][m] = row_rs(SS, row0 + ai * HALF + m * 16);
#pragma unroll
        for (int ai = 0; ai < 2; ++ai)
#pragma unroll
            for (int m = 0; m < 4; ++m) {
                const int row = row0 + ai * HALF + m * 16; const float rs = rsv[ai][m];
#pragma unroll
                for (int bj = 0; bj < 2; ++bj) {
                    f32x4 v0 = acc[ai][bj][m][0] * rs + bv[bj][0], v1 = acc[ai][bj][m][1] * rs + bv[bj][1];
                    if (isy) { v0.x = gelu_tanh(v0.x); v0.y = gelu_tanh(v0.y); v0.z = gelu_tanh(v0.z); v0.w = gelu_tanh(v0.w);
                               v1.x = gelu_tanh(v1.x); v1.y = gelu_tanh(v1.y); v1.z = gelu_tanh(v1.z); v1.w = gelu_tanh(v1.w); }
                    *(u32x4*)(O + (size_t)row * 1024 + oc0 + bj * HALF) = pack8(v0, v1);
                }
            }
    }
};

__device__ __forceinline__ void rope4(f32x4& a, f32x4& b, const f32x4 t0, const f32x4 t1) {
    const f32x4 x1 = a, x2 = b;
    a.x = x1.x * t0.x - x2.x * t0.y; b.x = x2.x * t0.x + x1.x * t0.y;
    a.y = x1.y * t0.z - x2.y * t0.w; b.y = x2.y * t0.z + x1.y * t0.w;
    a.z = x1.z * t1.x - x2.z * t1.y; b.z = x2.z * t1.x + x1.z * t1.y;
    a.w = x1.w * t1.z - x2.w * t1.w; b.w = x2.w * t1.z + x1.w * t1.w;
}
__device__ __forceinline__ f32x4 rot2(const f32x4 t, const f32x4 r) { return (f32x4){t.x * r.x - t.y * r.y, t.y * r.x + t.x * r.y, t.z * r.z - t.w * r.w, t.w * r.z + t.z * r.w}; }
struct EpiQkv {
    static constexpr bool PERM = true, AFTER_DRAIN = false;
    const float* SS; const float* CS; bf16_t* QKV; float* out; int j;
    __device__ __forceinline__ void operator()(const f32x4 (&acc)[2][2][4][2], const Unit& u, int wr, int wc, int fr, int fq) const {
        const int g = u.pn / 12, which = (u.pn % 12) >> 2, hq = u.pn & 3, head = hq * 4 + wc, dd0 = 8 * fq;
        const int colbase = g * 3072 + which * 1024 + head * 64 + dd0;
        const int Wg = 128 << (2 * g); const size_t kvo = (g == 0 ? (size_t)17186816 : (g == 1 ? (size_t)18759680 : (size_t)23478272)) + (size_t)j * 2 * Wg * 2048; float* kvp = out + kvo;
        const int row0 = u.pm * BM + wr * 64 + fr, pos0 = row0 & 8191, b = row0 >> 13;
        float rsv[2][4];
#pragma unroll
        for (int ai = 0; ai < 2; ++ai)
#pragma unroll
            for (int m = 0; m < 4; ++m) rsv[ai][m] = row_rs(SS, row0 + ai * HALF + m * 16);
#pragma unroll
        for (int n = 0; n < 2; ++n) {
            f32x4 t[2], r16[2], r80[2];
            if (which < 2) {
#pragma unroll
                for (int i = 0; i < 2; ++i) { t[i] = *((const f32x4*)(CS + ((size_t)pos0 * 32 + dd0 + 4 * n) * 2) + i); r16[i] = *((const f32x4*)(CS + ((size_t)16 * 32 + dd0 + 4 * n) * 2) + i); r80[i] = *((const f32x4*)(CS + ((size_t)80 * 32 + dd0 + 4 * n) * 2) + i); }
            }
#pragma unroll
            for (int ai = 0; ai < 2; ++ai)
#pragma unroll
                for (int m = 0; m < 4; ++m) {
                    const int row = row0 + ai * HALF + m * 16, pos = pos0 + ai * HALF + m * 16; const float rs = rsv[ai][m];
                    f32x4 a0 = acc[ai][0][m][n] * rs, b0 = acc[ai][1][m][n] * rs;
                    if (which < 2) {
                        rope4(a0, b0, t[0], t[1]);
                        if (which == 0) { a0 *= 0.125f; b0 *= 0.125f; }
                        if (m < 3) { t[0] = rot2(t[0], r16[0]); t[1] = rot2(t[1], r16[1]); } else if (ai == 0) { t[0] = rot2(t[0], r80[0]); t[1] = rot2(t[1], r80[1]); }
                    }
                    bf16_t* o = QKV + (size_t)row * 9216 + colbase + 4 * n;
                    u32x2 w0, w1; w0.x = cvt_pk_bf16(a0.x, a0.y); w0.y = cvt_pk_bf16(a0.z, a0.w); w1.x = cvt_pk_bf16(b0.x, b0.y); w1.y = cvt_pk_bf16(b0.z, b0.w);
                    *(u32x2*)o = w0; *(u32x2*)(o + 32) = w1;
                    if (which >= 1 && pos >= 8192 - Wg) {
                        float* kp = kvp + ((size_t)(b * Wg + pos - (8192 - Wg)) * 2 + (which - 1)) * 1024 + head * 64 + dd0 + 4 * n;
                        *(f32x4*)kp = a0; *(f32x4*)(kp + 32) = b0;
                    }
                }
        }
    }
};

template <class Epi, class Sched, bool ALIGN_EPI = false, bool SP2 = false>
__device__ __forceinline__ void gemm_phase(PG8_LAS unsigned char* lds, const Gemm g, const Sched& S, const Epi& E, int tid_in) {
    int tid_ = tid_in; asm volatile("" : "+v"(tid_));
    const int tid = tid_, wid = __builtin_amdgcn_readfirstlane(tid >> 6), lane = tid & 63, wr = wid >> 2, wc = wid & 3, fr = lane & 15, fq = lane >> 4;
    const int K = g.K, nt = K / BK;
    unsigned voffA[2], voffB[2];
#pragma unroll
    for (int i = 0; i < 2; ++i) { int R, C; stage_rc(tid * 16 + i * 8192, R, C); const int Rb = Epi::PERM ? ((R & ~31) + perm32(R & 31)) : R;
        voffA[i] = (unsigned)(R * K + C) * 2u; voffB[i] = (unsigned)(Rb * K + C) * 2u; }
    const size_t kstep = (size_t)(BK * 2);
    const size_t hstep = (size_t)HALF * K * 2;
    const size_t tstep = 2 * hstep;
    const unsigned ldsw = (unsigned)wid * 1024u;
    const int aoff = lds_byte(wr * 64 + fr, fq * 8), boff = lds_byte(wc * 32 + fr, fq * 8);
#define PG8_SA(b, h) (((b) * 2 + (h)) * HTB)
#define PG8_SB(b, h) ((4 + (b) * 2 + (h)) * HTB)
#define PG8_STAGE(bufoff, gbase, voff) do { _Pragma("unroll") for (int _i = 0; _i < 2; ++_i) \
        __builtin_amdgcn_global_load_lds((const unsigned*)((const char*)(gbase) + (voff)[_i]), (PG8_LAS unsigned*)(lds + (bufoff) + ldsw + _i * 8192), 16, 0, 0); } while (0)
#define PG8_LDA(dst, b, h) do { _Pragma("unroll") for (int m = 0; m < 4; ++m) _Pragma("unroll") for (int k = 0; k < 2; ++k) dst[m][k] = *(const PG8_LAS bf16x8*)(lds + PG8_SA(b, h) + aoff + m * 2048 + k * 1024); } while (0)
#define PG8_LDB(dst, b, h) do { _Pragma("unroll") for (int n = 0; n < 2; ++n) _Pragma("unroll") for (int k = 0; k < 2; ++k) dst[n][k] = *(const PG8_LAS bf16x8*)(lds + PG8_SB(b, h) + boff + n * 2048 + k * 1024); } while (0)
#define PG8_MMA(ai, bj, At, Bt) do { __builtin_amdgcn_s_setprio(1); _Pragma("unroll") for (int m = 0; m < 4; ++m) _Pragma("unroll") for (int n = 0; n < 2; ++n) _Pragma("unroll") for (int k = 0; k < 2; ++k) \
        acc[ai][bj][m][n] = __builtin_amdgcn_mfma_f32_16x16x32_bf16(Bt[n][k], At[m][k], acc[ai][bj][m][n], 0, 0, 0); __builtin_amdgcn_s_setprio(0); } while (0)
#define PG8_WAIT_V(n) asm volatile("s_waitcnt vmcnt(" #n ")" ::: "memory")
#define PG8_WAIT_L(n) asm volatile("s_waitcnt lgkmcnt(" #n ")" ::: "memory")
#define PG8_BAR __builtin_amdgcn_s_barrier()
#define PG8_SCHED __builtin_amdgcn_sched_barrier(0)
    Unit cur, nxt; int ui = 0;
    if (!S.next(0, cur)) return;
    f32x4 acc[2][2][4][2];
#pragma unroll
    for (int a = 0; a < 2; ++a)
#pragma unroll
        for (int b = 0; b < 2; ++b)
#pragma unroll
            for (int m = 0; m < 4; ++m)
#pragma unroll
                for (int n = 0; n < 2; ++n) acc[a][b][m][n] = (f32x4){0.f, 0.f, 0.f, 0.f};
    bf16x8 At[4][2], B0[2][2], B1[2][2];
    const char* cA = (const char*)g.A + (size_t)cur.pm * tstep; const char* cB = (const char*)g.Bt + (size_t)cur.pn * tstep;
    S.a_ready(cur);
    if constexpr (SP2) {
        PG8_STAGE(PG8_SB(0, 0), cB, voffB); PG8_STAGE(PG8_SB(0, 1), cB + hstep, voffB); PG8_STAGE(PG8_SA(0, 0), cA, voffA); PG8_STAGE(PG8_SA(0, 1), cA + hstep, voffA);
        if (wr == 1) PG8_BAR;
        PG8_WAIT_V(2); PG8_BAR;
        PG8_STAGE(PG8_SB(1, 0), cB + kstep, voffB); PG8_STAGE(PG8_SA(1, 0), cA + kstep, voffA); PG8_STAGE(PG8_SB(1, 1), cB + hstep + kstep, voffB);
        PG8_WAIT_V(6); PG8_BAR;
    } else {
        PG8_STAGE(PG8_SB(0, 0), cB, voffB); PG8_STAGE(PG8_SA(0, 0), cA, voffA); PG8_STAGE(PG8_SB(0, 1), cB + hstep, voffB); PG8_STAGE(PG8_SA(0, 1), cA + hstep, voffA);
        if (wr == 1) PG8_BAR;
        PG8_WAIT_V(4); PG8_BAR;
        PG8_STAGE(PG8_SB(1, 0), cB + kstep, voffB); PG8_STAGE(PG8_SA(1, 0), cA + kstep, voffA); PG8_STAGE(PG8_SB(1, 1), cB + hstep + kstep, voffB);
        PG8_WAIT_V(6); PG8_BAR;
    }
    for (;;) {
        const bool has_next = S.next(ui + 1, nxt);
        const char* nA = has_next ? (const char*)g.A + (size_t)nxt.pm * tstep : cA; const char* nB = has_next ? (const char*)g.Bt + (size_t)nxt.pn * tstep : cB;
        for (int t = 0; t < nt; t += 2) {
            const bool last = (t == nt - 2);
            const char* a1 = cA + (size_t)(t + 1) * kstep;
            const char* a2 = last ? nA : cA + (size_t)(t + 2) * kstep; const char* b2 = last ? nB : cB + (size_t)(t + 2) * kstep;
            const char* a3 = a2 + kstep; const char* b3 = b2 + kstep;
            if (last && has_next) S.a_ready(nxt);
            if constexpr (SP2) {
            PG8_LDB(B0, 0, 0); PG8_LDB(B1, 0, 1); PG8_SCHED; PG8_LDA(At, 0, 0); PG8_STAGE(PG8_SA(1, 1), a1 + hstep, voffA);
            PG8_WAIT_V(8); PG8_WAIT_L(0); PG8_BAR; PG8_MMA(0, 0, At, B0); PG8_MMA(0, 1, At, B1); PG8_BAR; PG8_SCHED;
            PG8_LDA(At, 0, 1); PG8_STAGE(PG8_SB(0, 0), b2, voffB); PG8_STAGE(PG8_SB(0, 1), b2 + hstep, voffB); PG8_STAGE(PG8_SA(0, 0), a2, voffA);
            PG8_WAIT_V(8); PG8_WAIT_L(0); PG8_BAR; PG8_MMA(1, 0, At, B0); PG8_MMA(1, 1, At, B1); PG8_BAR; PG8_SCHED;
            PG8_LDB(B0, 1, 0); PG8_LDB(B1, 1, 1); PG8_SCHED; PG8_LDA(At, 1, 0); PG8_STAGE(PG8_SA(0, 1), a2 + hstep, voffA);
            PG8_WAIT_V(8); PG8_WAIT_L(0); PG8_BAR; PG8_MMA(0, 0, At, B0); PG8_MMA(0, 1, At, B1); PG8_BAR; PG8_SCHED;
            PG8_LDA(At, 1, 1); PG8_STAGE(PG8_SB(1, 0), b3, voffB); PG8_STAGE(PG8_SB(1, 1), b3 + hstep, voffB); PG8_STAGE(PG8_SA(1, 0), a3, voffA);
            PG8_WAIT_V(8); PG8_WAIT_L(0); PG8_BAR; PG8_MMA(1, 0, At, B0); PG8_MMA(1, 1, At, B1); PG8_BAR; PG8_SCHED;
            } else {
            PG8_LDB(B0, 0, 0); PG8_SCHED; PG8_LDA(At, 0, 0); PG8_STAGE(PG8_SA(1, 1), a1 + hstep, voffA);
            PG8_WAIT_L(8); PG8_BAR; PG8_WAIT_L(0); PG8_MMA(0, 0, At, B0); PG8_BAR; PG8_SCHED;
            PG8_LDB(B1, 0, 1); PG8_STAGE(PG8_SB(0, 0), b2, voffB);
            PG8_BAR; PG8_WAIT_L(0); PG8_MMA(0, 1, At, B1); PG8_BAR;
            PG8_LDA(At, 0, 1); PG8_STAGE(PG8_SA(0, 0), a2, voffA);
            PG8_BAR; PG8_WAIT_L(0); PG8_MMA(1, 0, At, B0); PG8_BAR; PG8_SCHED;
            PG8_STAGE(PG8_SB(0, 1), b2 + hstep, voffB);
            PG8_WAIT_V(6); PG8_BAR; PG8_MMA(1, 1, At, B1); PG8_BAR;
            PG8_LDB(B0, 1, 0); PG8_SCHED; PG8_LDA(At, 1, 0); PG8_STAGE(PG8_SA(0, 1), a2 + hstep, voffA);
            PG8_WAIT_L(8); PG8_BAR; PG8_WAIT_L(0); PG8_MMA(0, 0, At, B0); PG8_BAR; PG8_SCHED;
            PG8_LDB(B1, 1, 1); PG8_STAGE(PG8_SB(1, 0), b3, voffB);
            PG8_BAR; PG8_WAIT_L(0); PG8_MMA(0, 1, At, B1); PG8_BAR;
            PG8_LDA(At, 1, 1); PG8_STAGE(PG8_SA(1, 0), a3, voffA);
            PG8_BAR; PG8_WAIT_L(0); PG8_MMA(1, 0, At, B0); PG8_BAR; PG8_SCHED;
            PG8_STAGE(PG8_SB(1, 1), b3 + hstep, voffB);
            PG8_WAIT_V(6); PG8_BAR; PG8_MMA(1, 1, At, B1); PG8_BAR;
            }
        }
        if constexpr (ALIGN_EPI) { if (wr == 0) PG8_BAR; }
        if constexpr (!Epi::AFTER_DRAIN) { E(acc, cur, wr, wc, fr, fq); S.done(cur); }
        if (!has_next) break;
#pragma unroll
        for (int a = 0; a < 2; ++a)
#pragma unroll
            for (int b = 0; b < 2; ++b)
#pragma unroll
                for (int m = 0; m < 4; ++m)
#pragma unroll
                    for (int n = 0; n < 2; ++n) acc[a][b][m][n] = (f32x4){0.f, 0.f, 0.f, 0.f};
        cur = nxt; cA = nA; cB = nB; ++ui;
        if constexpr (ALIGN_EPI) { if (wr == 1) PG8_BAR; }
    }
    PG8_WAIT_V(0);
    if constexpr (!ALIGN_EPI) { if (wr == 0) PG8_BAR; }
    PG8_BAR;
    if constexpr (Epi::AFTER_DRAIN) { E.fused(acc, cur, wr, wc, fr, fq, lds, wid, lane); S.done(cur); }
#undef PG8_SA
#undef PG8_SB
#undef PG8_STAGE
#undef PG8_LDA
#undef PG8_LDB
#undef PG8_MMA
#undef PG8_WAIT_V
#undef PG8_WAIT_L
#undef PG8_BAR
#undef PG8_SCHED
}
}

#define XB_TMO      128
#define XB_XCNT(j)  (256  + 64 * (j))
#define XB_XSUB(j)  (1280 + 64 * (j))
#define XB_XGEN(j)  (2304 + 64 * (j))
#define XB_TOP      3328
#define XB_TOPGEN   3392
#define XCD_BAR_WORDS 3456
#define XB_SPIN_CAP (1u << 18)

__device__ __forceinline__ unsigned xb_ld(unsigned* p)              { return __hip_atomic_load(p, __ATOMIC_RELAXED, __HIP_MEMORY_SCOPE_AGENT); }
__device__ __forceinline__ unsigned xb_add(unsigned* p, unsigned v) { return __hip_atomic_fetch_add(p, v, __ATOMIC_RELAXED, __HIP_MEMORY_SCOPE_AGENT); }
__device__ __forceinline__ unsigned xb_xcc_id() { return (unsigned)__builtin_amdgcn_s_getreg((3 << 11) | 20) & 0xFu; }
#define XB_SPIN(cond, bar) do { unsigned _sp = 0; while (cond) { __builtin_amdgcn_s_sleep(1); \
    if ((++_sp & 255u) == 0u) { if (xb_ld(&(bar)[XB_TMO])) break; if (_sp > XB_SPIN_CAP) { atomicAdd(&(bar)[XB_TMO], 1u); break; } } } } while (0)

struct XcdBarrier {
    unsigned* bar; unsigned x; bool lead;
    volatile LAS unsigned* st;
};

__device__ __forceinline__ XcdBarrier xcd_barrier_post(unsigned* bar, volatile LAS unsigned* st) {
    XcdBarrier b; b.bar = bar; b.x = xb_xcc_id(); b.st = st; b.lead = threadIdx.x == 0;
    if (threadIdx.x == 0) (void)xb_add(&bar[XB_XCNT(b.x)], 1u);
    return b;
}
__device__ __forceinline__ void xcd_barrier_complete(unsigned* bar, unsigned x, unsigned& nloc, unsigned& nx) {
    const unsigned G = gridDim.x * gridDim.y * gridDim.z;
    unsigned sum, cnt, mine, sp = 0u;
    for (;;) {
        sum = 0u; cnt = 0u; mine = 0u;
#pragma unroll
        for (unsigned j = 0; j < 16; ++j) { const unsigned c = xb_ld(&bar[XB_XCNT(j)]); sum += c; cnt += (c > 0u) ? 1u : 0u; mine = (j == x) ? c : mine; }
        if (sum == G) break;
        __builtin_amdgcn_s_sleep(1);
        if ((++sp & 255u) == 0u) { if (xb_ld(&bar[XB_TMO])) break; if (sp > XB_SPIN_CAP) { atomicAdd(&bar[XB_TMO], 1u); break; } }
    }
    nloc = mine > 0u ? mine : 1u; nx = cnt > 0u ? cnt : 1u;
}

__device__ __forceinline__ void xcd_barrier(const XcdBarrier& b) {
    asm volatile("s_waitcnt vmcnt(0)" ::: "memory");
    __syncthreads();
    if (b.lead) {
        unsigned* bar = b.bar;
        __builtin_amdgcn_s_waitcnt(0);
        unsigned nloc = b.st[0], nx = b.st[1];
        if (nloc == 0u) { xcd_barrier_complete(bar, b.x, nloc, nx); b.st[0] = nloc; b.st[1] = nx; }
        const unsigned old = xb_add(&bar[XB_XSUB(b.x)], 1u);
        const unsigned gen = old / nloc;
        if (old + 1u == (gen + 1u) * nloc) {
            __builtin_amdgcn_fence(__ATOMIC_RELEASE, "agent");
            asm volatile("s_waitcnt vmcnt(0)" ::: "memory");
            const unsigned og = xb_add(&bar[XB_TOP], 1u);
            const unsigned tg = og / nx;
            if (og + 1u == (tg + 1u) * nx) xb_add(&bar[XB_TOPGEN], 1u);
            else XB_SPIN(xb_ld(&bar[XB_TOPGEN]) == tg, bar);
            __builtin_amdgcn_fence(__ATOMIC_ACQUIRE, "agent");
            xb_add(&bar[XB_XGEN(b.x)], 1u);
            asm volatile("s_waitcnt vmcnt(0)" ::: "memory");
        } else {
            XB_SPIN(xb_ld(&bar[XB_XGEN(b.x)]) == gen, bar);
            __builtin_amdgcn_fence(__ATOMIC_ACQUIRE, "agent");
            asm volatile("s_waitcnt vmcnt(0)" ::: "memory");
        }
    }
    __syncthreads();
}

constexpr int D = 1024, DFF = 2816, NUP = 5632, SEQ = 8192, NBATCH = 2, MP = NBATCH * SEQ, NSQ = 32, TS = 4, MS = NSQ * TS, MT = MP + MS;
constexpr int NQKV = 9216, NH = 16, HD = 64, DEPTH = 4;
constexpr int NWAVES = 8, NTHR = NWAVES * 64;
typedef unsigned short bf16;
typedef float f32x4 __attribute__((ext_vector_type(4)));
typedef unsigned v4u __attribute__((ext_vector_type(4)));
typedef unsigned v2u __attribute__((ext_vector_type(2)));
typedef short bf16x8 __attribute__((ext_vector_type(8)));
#define LDS_WAIT() asm volatile("s_waitcnt lgkmcnt(0)" ::: "memory")

enum { I_XP = 0, I_XS, I_STH, I_STC, I_C128, I_C512, I_C2048, I_NF1, I_NMIX, I_NF2, I_WU1, I_WD1, I_WU2, I_WD2, I_WRIN, I_BRIN, I_WCONV, I_BCONV,
       I_WGA, I_BGA, I_WGX, I_BGX, I_LAM, I_WROUT, I_BROUT, I_WQKV, I_WO, I_NFIN, N_IN };
constexpr size_t O_Y = 0, O_HP = (size_t)MT * D, O_HS = O_HP + 2 * 2 * 1024, O_CP = O_HS + 2 * 32 * 1024, O_CS = O_CP + 2 * 2 * 3 * 1024, O_KV128P = O_CS + 2 * 32 * 3 * 1024,
    O_KV128S = O_KV128P + (size_t)2 * 2 * 128 * 2048, O_KV512P = O_KV128S + (size_t)2 * 32 * 4 * 2048, O_KV512S = O_KV512P + (size_t)2 * 2 * 512 * 2048,
    O_KV2048P = O_KV512S + (size_t)2 * 32 * 4 * 2048, O_KV2048S = O_KV2048P + (size_t)2 * 2 * 2048 * 2048, O_END = O_KV2048S + (size_t)2 * 32 * 4 * 2048;
static_assert(O_END == 40779776, "output size");

constexpr size_t MiB = 1u << 20;
constexpr size_t WS_CTL = 0, CTL_ZERO_BYTES = 1 * MiB;
constexpr size_t WS_CS = 1 * MiB;
constexpr size_t WS_SS = 4 * MiB;
constexpr size_t WS_SSS = 4 * MiB + 512 * 1024;
constexpr size_t WS_CARRY = 5 * MiB;
constexpr size_t WS_LSE = 6 * MiB;
constexpr size_t WS_W = 16 * MiB;
constexpr size_t SZ_WUP = (size_t)NUP * D * 2, SZ_WDN = (size_t)D * DFF * 2, SZ_WRIN = (size_t)2048 * D * 2, SZ_WSQ = (size_t)D * D * 2, SZ_WQKV = (size_t)NQKV * D * 2, SZ_WG = (size_t)8 * 128 * 128 * 2;
constexpr size_t WS_WUP = WS_W, WS_WDN = WS_WUP + 8 * SZ_WUP, WS_WRIN = WS_WDN + 8 * SZ_WDN, WS_WROUT = WS_WRIN + 2 * SZ_WRIN, WS_WQKV = WS_WROUT + 2 * SZ_WSQ, WS_WO = WS_WQKV + 2 * SZ_WQKV,
    WS_WG = WS_WO + 2 * SZ_WSQ, WS_WEND = WS_WG + 4 * SZ_WG;
static_assert(WS_WEND <= 208 * MiB, "weights");
constexpr int MTP = MP + 256;
constexpr size_t WS_XB = 273 * MiB;
constexpr size_t WS_HID = 306 * MiB;
constexpr size_t WS_YB = 396 * MiB, WS_XBR = 429 * MiB, WS_AOP = 462 * MiB;
constexpr size_t WS_QKV = 495 * MiB;
constexpr size_t WS_OG = 786 * MiB;
constexpr size_t WS_END = 884 * MiB;
static_assert(WS_WEND <= WS_XB && WS_XB + (size_t)MTP * D * 2 <= WS_HID && WS_HID + (size_t)MTP * DFF * 2 <= WS_YB && WS_YB + (size_t)MT * D * 2 <= WS_XBR && WS_XBR + (size_t)MT * D * 2 <= WS_AOP &&
              WS_AOP + (size_t)MT * D * 2 <= WS_QKV && WS_QKV + (size_t)MT * NQKV * 2 <= WS_OG && WS_OG + (size_t)3 * MT * D * 2 <= WS_END, "ws map");
constexpr int CW_BAR = 4096;
constexpr int LDS_BYTES = 147456, RING_BYTES = 131072, MISC_OFF = RING_BYTES + 320, RS_OFF = RING_BYTES + 1024;

__device__ __forceinline__ unsigned f2bf(float f) { unsigned u = __builtin_bit_cast(unsigned, f); return (u + 0x7fffu + ((u >> 16) & 1u)) >> 16; }
__device__ __forceinline__ unsigned pk2(float lo, float hi) { return pg8::cvt_pk_bf16(lo, hi); }
__device__ __forceinline__ float bf2f(bf16 v) { return __builtin_bit_cast(float, (unsigned)v << 16); }
__device__ __forceinline__ float bflo(unsigned u) { return __builtin_bit_cast(float, u << 16); }
__device__ __forceinline__ float bfhi(unsigned u) { return __builtin_bit_cast(float, u & 0xffff0000u); }

struct Params { const float* in[N_IN]; float* out; unsigned char* ws; };

#define GAS __attribute__((address_space(1)))
struct Frame {
    LAS unsigned char* lds;
    int tid, lane, wave, wg, G;
    GAS float* out_g; GAS unsigned char* ws_g;
    __device__ __forceinline__ const float* in(int i) const { const __attribute__((address_space(4))) Params* kp = (const __attribute__((address_space(4))) Params*)__builtin_amdgcn_kernarg_segment_ptr(); asm volatile("" : "+s"(kp)); return (const float*)(const GAS float*)kp->in[i]; }
    __device__ __forceinline__ float* outp() const { return (float*)out_g; }
    template <class T> __device__ __forceinline__ T* W(size_t off) const { return (T*)(GAS T*)(ws_g + off); }
};
__device__ __forceinline__ int lane_now() { int l; asm volatile("v_mbcnt_lo_u32_b32 %0, -1, 0\n\tv_mbcnt_hi_u32_b32 %0, -1, %0" : "=v"(l)); return l; }
__device__ __forceinline__ Frame phase_frame(const Frame& F0) {
    Frame F = F0; int wv = F0.wave; asm volatile("" : "+s"(wv));
    int t = wv * 64 + lane_now(); F.tid = t; F.lane = t & 63; F.wave = wv;
    asm volatile("" : "+s"(F.ws_g), "+s"(F.out_g)); return F;
}
__device__ __forceinline__ void tr_item64(const float* W, int K, int N, int k0, int ns0, int sstride, bf16* WT, int nd0, const float* gain, LAS unsigned* scr, int lane) {
    const int kk = lane >> 4, nn = lane & 15; const float* src = W + (size_t)(k0 + 16 * kk) * N + ns0 + (nn >> 3) * sstride + 4 * (nn & 7);
    f32x4 v[16];
#pragma unroll
    for (int i = 0; i < 16; ++i) v[i] = *(const f32x4*)(src + (size_t)i * N);
    if (gain) {
#pragma unroll
        for (int i = 0; i < 16; ++i) v[i] *= gain[k0 + 16 * kk + i]; }
#pragma unroll
    for (int e = 0; e < 4; ++e) { v4u lo, hi;
        lo.x = pk2(v[0][e], v[1][e]); lo.y = pk2(v[2][e], v[3][e]); lo.z = pk2(v[4][e], v[5][e]); lo.w = pk2(v[6][e], v[7][e]);
        hi.x = pk2(v[8][e], v[9][e]); hi.y = pk2(v[10][e], v[11][e]); hi.z = pk2(v[12][e], v[13][e]); hi.w = pk2(v[14][e], v[15][e]);
        LAS v4u* d = (LAS v4u*)(scr + (4 * nn + e) * 36 + 8 * kk); d[0] = lo; d[1] = hi; }
    LDS_WAIT(); asm volatile("" ::: "memory");
    const int c = lane & 7, ns = lane >> 3;
#pragma unroll
    for (int q = 0; q < 8; ++q) { const int n = 8 * q + ns; const v4u o = *(const LAS v4u*)(scr + n * 36 + 4 * c); *(v4u*)(WT + (size_t)(nd0 + n) * K + k0 + 8 * c) = o; }
    LDS_WAIT(); asm volatile("" ::: "memory");
}
__device__ __forceinline__ void cs_entry(int pos, int i, float& c, float& s) {
    const float inv = exp2f(-(float)i * (13.287712379549449f / 32.0f));
    const float angf = (float)pos * inv; const double a = (double)angf;
    const double q = rint(a * 0.63661977236758134308); const double y = (a - q * 1.57079632679489655800) - q * 6.123233995736766e-17;
    const double y2 = y * y;
    const double sn = y * (1.0 + y2 * (-1.0 / 6 + y2 * (1.0 / 120 + y2 * (-1.0 / 5040 + y2 * (1.0 / 362880 + y2 * (-1.0 / 39916800 + y2 * (1.0 / 6227020800.0)))))));
    const double cn = 1.0 + y2 * (-0.5 + y2 * (1.0 / 24 + y2 * (-1.0 / 720 + y2 * (1.0 / 40320 + y2 * (-1.0 / 3628800 + y2 * (1.0 / 479001600.0 + y2 * (-1.0 / 87178291200.0)))))));
    const int qi = (int)((long long)q & 3);
    double cc, ss;
    if (qi == 0) { cc = cn; ss = sn; } else if (qi == 1) { cc = -sn; ss = cn; } else if (qi == 2) { cc = -cn; ss = -sn; } else { cc = sn; ss = -cn; }
    c = (float)cc; s = (float)ss;
}
using pg8::shfl_at; using pg8::shx;
__device__ __forceinline__ float wave_sum(float v, int lane) {
#pragma unroll
    for (int o = 1; o < 64; o <<= 1) v += shx(v, lane, o);
    return v;
}
constexpr int CV_PRO = 2112, CV_TOTAL = 23680;
__device__ __forceinline__ int cv_bound(int k) { return k <= 0 ? 2112 : k <= 1 ? 5362 : k <= 2 ? 8612 : k <= 3 ? 11862 : k <= 4 ? 14816 : k <= 5 ? 17770 : k <= 6 ? 20724 : 23680; }
__device__ __forceinline__ void cv_item(const Frame& F, int it, LAS unsigned* scr, int lane) {
    int r = it;
    if (r < 1408) { const int kb = r / 88, nb = r % 88, n0 = 64 * nb, pn = n0 >> 8, bj = (n0 >> 7) & 1, j0 = n0 & 127, ns0 = bj * DFF + 128 * pn + j0;
        tr_item64(F.in(I_WU1) + (size_t)0 * D * NUP, D, NUP, 64 * kb, ns0, 32, F.W<bf16>(WS_WUP + (size_t)0 * SZ_WUP), n0, F.in(I_NF1) + 0 * D, scr, lane); return; } r -= 1408;
    if (r < 704) { const int kb = r / 16, nb = r % 16;
        tr_item64(F.in(I_WD1) + (size_t)0 * DFF * D, DFF, D, 64 * kb, 64 * nb, 32, F.W<bf16>(WS_WDN + (size_t)0 * SZ_WDN), 64 * nb, nullptr, scr, lane); return; } r -= 704;
    if (r < 512) { const int kb = r / 32, nb = r % 32;
        tr_item64(F.in(I_WRIN) + (size_t)0 * D * 2048, D, 2048, 64 * kb, 64 * nb, 32, F.W<bf16>(WS_WRIN + (size_t)0 * SZ_WRIN), 64 * nb, F.in(I_NMIX) + 0 * D, scr, lane); return; } r -= 512;
    if (r < 64) { const int mb16 = r >> 2, q = r & 3, kb = q >> 1, nb = q & 1, ax = mb16 >> 3, blk = mb16 & 7, mb = (0 * 2 + ax) * 8 + blk;
        tr_item64(F.in(ax ? I_WGX : I_WGA) + (size_t)(0 * 8 + blk) * 16384, 128, 128, 64 * kb, 64 * nb, 32, F.W<bf16>(WS_WG + (size_t)mb * 32768), 64 * nb, nullptr, scr, lane); return; } r -= 64;
    if (r < 256) { const int kb = r / 16, nb = r % 16;
        tr_item64(F.in(I_WROUT) + (size_t)0 * D * D, D, D, 64 * kb, 64 * nb, 32, F.W<bf16>(WS_WROUT + (size_t)0 * SZ_WSQ), 64 * nb, nullptr, scr, lane); return; } r -= 256;
    if (r < 1408) { const int kb = r / 88, nb = r % 88, n0 = 64 * nb, pn = n0 >> 8, bj = (n0 >> 7) & 1, j0 = n0 & 127, ns0 = bj * DFF + 128 * pn + j0;
        tr_item64(F.in(I_WU2) + (size_t)0 * D * NUP, D, NUP, 64 * kb, ns0, 32, F.W<bf16>(WS_WUP + (size_t)1 * SZ_WUP), n0, F.in(I_NF2) + 0 * D, scr, lane); return; } r -= 1408;
    if (r < 704) { const int kb = r / 16, nb = r % 16;
        tr_item64(F.in(I_WD2) + (size_t)0 * DFF * D, DFF, D, 64 * kb, 64 * nb, 32, F.W<bf16>(WS_WDN + (size_t)1 * SZ_WDN), 64 * nb, nullptr, scr, lane); return; } r -= 704;
    if (r < 1408) { const int kb = r / 88, nb = r % 88, n0 = 64 * nb, pn = n0 >> 8, bj = (n0 >> 7) & 1, j0 = n0 & 127, ns0 = bj * DFF + 128 * pn + j0;
        tr_item64(F.in(I_WU1) + (size_t)1 * D * NUP, D, NUP, 64 * kb, ns0, 32, F.W<bf16>(WS_WUP + (size_t)2 * SZ_WUP), n0, F.in(I_NF1) + 1 * D, scr, lane); return; } r -= 1408;
    if (r < 704) { const int kb = r / 16, nb = r % 16;
        tr_item64(F.in(I_WD1) + (size_t)1 * DFF * D, DFF, D, 64 * kb, 64 * nb, 32, F.W<bf16>(WS_WDN + (size_t)2 * SZ_WDN), 64 * nb, nullptr, scr, lane); return; } r -= 704;
    if (r < 2304) { const int kb = r / 144, nb = r % 144, n0 = 64 * nb, pn = n0 >> 8, bj = (n0 >> 7) & 1, hh = (n0 >> 5) & 3, g = pn / 12, which = (pn % 12) >> 2, hq = pn & 3, ns0 = g * 3072 + which * 1024 + (4 * hq + hh) * 64 + 32 * bj;
        tr_item64(F.in(I_WQKV) + (size_t)0 * D * NQKV, D, NQKV, 64 * kb, ns0, 64, F.W<bf16>(WS_WQKV + (size_t)0 * SZ_WQKV), n0, F.in(I_NMIX) + 1 * D, scr, lane); return; } r -= 2304;
    if (r < 256) { const int kb = r / 16, nb = r % 16;
        tr_item64(F.in(I_WO) + (size_t)0 * D * D, D, D, 64 * kb, 64 * nb, 32, F.W<bf16>(WS_WO + (size_t)0 * SZ_WSQ), 64 * nb, nullptr, scr, lane); return; } r -= 256;
    if (r < 1408) { const int kb = r / 88, nb = r % 88, n0 = 64 * nb, pn = n0 >> 8, bj = (n0 >> 7) & 1, j0 = n0 & 127, ns0 = bj * DFF + 128 * pn + j0;
        tr_item64(F.in(I_WU2) + (size_t)1 * D * NUP, D, NUP, 64 * kb, ns0, 32, F.W<bf16>(WS_WUP + (size_t)3 * SZ_WUP), n0, F.in(I_NF2) + 1 * D, scr, lane); return; } r -= 1408;
    if (r < 704) { const int kb = r / 16, nb = r % 16;
        tr_item64(F.in(I_WD2) + (size_t)1 * DFF * D, DFF, D, 64 * kb, 64 * nb, 32, F.W<bf16>(WS_WDN + (size_t)3 * SZ_WDN), 64 * nb, nullptr, scr, lane); return; } r -= 704;
    if (r < 1408) { const int kb = r / 88, nb = r % 88, n0 = 64 * nb, pn = n0 >> 8, bj = (n0 >> 7) & 1, j0 = n0 & 127, ns0 = bj * DFF + 128 * pn + j0;
        tr_item64(F.in(I_WU1) + (size_t)2 * D * NUP, D, NUP, 64 * kb, ns0, 32, F.W<bf16>(WS_WUP + (size_t)4 * SZ_WUP), n0, F.in(I_NF1) + 2 * D, scr, lane); return; } r -= 1408;
    if (r < 704) { const int kb = r / 16, nb = r % 16;
        tr_item64(F.in(I_WD1) + (size_t)2 * DFF * D, DFF, D, 64 * kb, 64 * nb, 32, F.W<bf16>(WS_WDN + (size_t)4 * SZ_WDN), 64 * nb, nullptr, scr, lane); return; } r -= 704;
    if (r < 512) { const int kb = r / 32, nb = r % 32;
        tr_item64(F.in(I_WRIN) + (size_t)1 * D * 2048, D, 2048, 64 * kb, 64 * nb, 32, F.W<bf16>(WS_WRIN + (size_t)1 * SZ_WRIN), 64 * nb, F.in(I_NMIX) + 2 * D, scr, lane); return; } r -= 512;
    if (r < 64) { const int mb16 = r >> 2, q = r & 3, kb = q >> 1, nb = q & 1, ax = mb16 >> 3, blk = mb16 & 7, mb = (1 * 2 + ax) * 8 + blk;
        tr_item64(F.in(ax ? I_WGX : I_WGA) + (size_t)(1 * 8 + blk) * 16384, 128, 128, 64 * kb, 64 * nb, 32, F.W<bf16>(WS_WG + (size_t)mb * 32768), 64 * nb, nullptr, scr, lane); return; } r -= 64;
    if (r < 256) { const int kb = r / 16, nb = r % 16;
        tr_item64(F.in(I_WROUT) + (size_t)1 * D * D, D, D, 64 * kb, 64 * nb, 32, F.W<bf16>(WS_WROUT + (size_t)1 * SZ_WSQ), 64 * nb, nullptr, scr, lane); return; } r -= 256;
    if (r < 1408) { const int kb = r / 88, nb = r % 88, n0 = 64 * nb, pn = n0 >> 8, bj = (n0 >> 7) & 1, j0 = n0 & 127, ns0 = bj * DFF + 128 * pn + j0;
        tr_item64(F.in(I_WU2) + (size_t)2 * D * NUP, D, NUP, 64 * kb, ns0, 32, F.W<bf16>(WS_WUP + (size_t)5 * SZ_WUP), n0, F.in(I_NF2) + 2 * D, scr, lane); return; } r -= 1408;
    if (r < 704) { const int kb = r / 16, nb = r % 16;
        tr_item64(F.in(I_WD2) + (size_t)2 * DFF * D, DFF, D, 64 * kb, 64 * nb, 32, F.W<bf16>(WS_WDN + (size_t)5 * SZ_WDN), 64 * nb, nullptr, scr, lane); return; } r -= 704;
    if (r < 1408) { const int kb = r / 88, nb = r % 88, n0 = 64 * nb, pn = n0 >> 8, bj = (n0 >> 7) & 1, j0 = n0 & 127, ns0 = bj * DFF + 128 * pn + j0;
        tr_item64(F.in(I_WU1) + (size_t)3 * D * NUP, D, NUP, 64 * kb, ns0, 32, F.W<bf16>(WS_WUP + (size_t)6 * SZ_WUP), n0, F.in(I_NF1) + 3 * D, scr, lane); return; } r -= 1408;
    if (r < 704) { const int kb = r / 16, nb = r % 16;
        tr_item64(F.in(I_WD1) + (size_t)3 * DFF * D, DFF, D, 64 * kb, 64 * nb, 32, F.W<bf16>(WS_WDN + (size_t)6 * SZ_WDN), 64 * nb, nullptr, scr, lane); return; } r -= 704;
    if (r < 2304) { const int kb = r / 144, nb = r % 144, n0 = 64 * nb, pn = n0 >> 8, bj = (n0 >> 7) & 1, hh = (n0 >> 5) & 3, g = pn / 12, which = (pn % 12) >> 2, hq = pn & 3, ns0 = g * 3072 + which * 1024 + (4 * hq + hh) * 64 + 32 * bj;
        tr_item64(F.in(I_WQKV) + (size_t)1 * D * NQKV, D, NQKV, 64 * kb, ns0, 64, F.W<bf16>(WS_WQKV + (size_t)1 * SZ_WQKV), n0, F.in(I_NMIX) + 3 * D, scr, lane); return; } r -= 2304;
    if (r < 256) { const int kb = r / 16, nb = r % 16;
        tr_item64(F.in(I_WO) + (size_t)1 * D * D, D, D, 64 * kb, 64 * nb, 32, F.W<bf16>(WS_WO + (size_t)1 * SZ_WSQ), 64 * nb, nullptr, scr, lane); return; } r -= 256;
    if (r < 1408) { const int kb = r / 88, nb = r % 88, n0 = 64 * nb, pn = n0 >> 8, bj = (n0 >> 7) & 1, j0 = n0 & 127, ns0 = bj * DFF + 128 * pn + j0;
        tr_item64(F.in(I_WU2) + (size_t)3 * D * NUP, D, NUP, 64 * kb, ns0, 32, F.W<bf16>(WS_WUP + (size_t)7 * SZ_WUP), n0, F.in(I_NF2) + 3 * D, scr, lane); return; } r -= 1408;
    if (r < 704) { const int kb = r / 16, nb = r % 16;
        tr_item64(F.in(I_WD2) + (size_t)3 * DFF * D, DFF, D, 64 * kb, 64 * nb, 32, F.W<bf16>(WS_WDN + (size_t)7 * SZ_WDN), 64 * nb, nullptr, scr, lane); return; } r -= 704;
}
__device__ __forceinline__ void ph_prologue(const Frame& F0) { const Frame F = phase_frame(F0);
    LAS unsigned* scr = (LAS unsigned*)(F.lds + F.wave * 16384);
    const int gw = F.wg * NWAVES + F.wave, NGW = F.G * NWAVES, lane = F.lane;
    for (int it = gw; it < CV_PRO; it += NGW) cv_item(F, it, scr, lane);
    { float* CS = F.W<float>(WS_CS); const int gt = F.wg * NTHR + F.tid, NGT = F.G * NTHR;
      for (int e = gt; e < 8196 * 32; e += NGT) { float c, s; cs_entry(e >> 5, e & 31, c, s); CS[2 * e] = c; CS[2 * e + 1] = s; } }
    { bf16* Xb = F.W<bf16>(WS_XB); float* SS = F.W<float>(WS_SS); float* SSS = F.W<float>(WS_SSS);
      for (int m = gw; m < MT; m += NGW) {
          const float* src = m < MP ? F.in(I_XP) + (size_t)m * D : F.in(I_XS) + (size_t)(m - MP) * D; float s = 0.f;
#pragma unroll
          for (int j = 0; j < 4; ++j) { const f32x4 v = *((const f32x4*)src + lane + 64 * j);
              v2u w; w.x = pk2(v.x, v.y); w.y = pk2(v.z, v.w); *((v2u*)(Xb + (size_t)m * D) + lane + 64 * j) = w; s += (v.x * v.x + v.y * v.y) + (v.z * v.z + v.w * v.w); }
          s = wave_sum(s, lane);
          if (m < MP) { if (lane < 4) SS[(size_t)m * 4 + lane] = lane == 0 ? s : 0.f; }
          else { if (lane < 32) SSS[(size_t)(m - MP) * 32 + lane] = lane == 0 ? s : 0.f; }
      } }
}

template <int RT, bool PAIR128, int K, class Epi>
__device__ __forceinline__ void sample_gemm(const Frame& F, const bf16* A, const bf16* Bt, int ncg, const Epi& epi) {
    __syncthreads();
    LAS f32x4* red = (LAS f32x4*)F.lds;
    const int lane = F.lane, fr = lane & 15, fq = lane >> 4, w = F.wave;
    constexpr int ksl = K / 8, nst = ksl / 32; const int np = ncg * (8 / RT);
    for (int p = F.wg; p < np; p += F.G) {
        const int cg = p / (8 / RT), rtg = p % (8 / RT);
        const int base0 = PAIR128 ? 256 * (cg >> 3) + 16 * (cg & 7) : 32 * cg, base1 = PAIR128 ? base0 + 128 : base0 + 16;
        const bf16* w0p = Bt + (size_t)(base0 + fr) * K + w * ksl + 8 * fq; const bf16* w1p = Bt + (size_t)(base1 + fr) * K + w * ksl + 8 * fq;
        const bf16* xp = A + (size_t)(16 * rtg * RT + fr) * K + w * ksl + 8 * fq;
        bf16x8 w0[nst], w1[nst], x[nst][RT];
#pragma unroll
        for (int s = 0; s < nst; ++s) { w0[s] = *(const bf16x8*)(w0p + 32 * s); w1[s] = *(const bf16x8*)(w1p + 32 * s);
#pragma unroll
            for (int r = 0; r < RT; ++r) x[s][r] = *(const bf16x8*)(xp + (size_t)(16 * r) * K + 32 * s); }
        f32x4 acc[RT][2];
#pragma unroll
        for (int r = 0; r < RT; ++r) { acc[r][0] = (f32x4){0.f, 0.f, 0.f, 0.f}; acc[r][1] = (f32x4){0.f, 0.f, 0.f, 0.f}; }
#pragma unroll
        for (int s = 0; s < nst; ++s)
#pragma unroll
            for (int r = 0; r < RT; ++r) { acc[r][0] = __builtin_amdgcn_mfma_f32_16x16x32_bf16(w0[s], x[s][r], acc[r][0], 0, 0, 0); acc[r][1] = __builtin_amdgcn_mfma_f32_16x16x32_bf16(w1[s], x[s][r], acc[r][1], 0, 0, 0); }
#pragma unroll
        for (int r = 0; r < RT; ++r) { red[((w * RT + r) * 2 + 0) * 64 + lane] = acc[r][0]; red[((w * RT + r) * 2 + 1) * 64 + lane] = acc[r][1]; }
        __syncthreads();
        for (int r = w; r < RT; r += NWAVES) {
            f32x4 v0 = (f32x4){0.f, 0.f, 0.f, 0.f}, v1 = v0;
#pragma unroll
            for (int ww = 0; ww < NWAVES; ++ww) { v0 += red[((ww * RT + r) * 2 + 0) * 64 + lane]; v1 += red[((ww * RT + r) * 2 + 1) * 64 + lane]; }
            epi(16 * (rtg * RT + r) + fr, cg, fq, v0, v1, lane);
        }
        __syncthreads();
    }
}
__device__ __forceinline__ LAS float* sample_rs(const Frame& F) {
    __syncthreads();
    LAS float* rs = (LAS float*)(F.lds + RS_OFF);
    if (F.tid < MS) { const f32x4* p = (const f32x4*)(F.W<float>(WS_SSS) + (size_t)F.tid * 32); float s = 0.f;
#pragma unroll
        for (int i = 0; i < 8; ++i) { const f32x4 v = p[i]; s += (v.x + v.y) + (v.z + v.w); }
        rs[F.tid] = rsqrtf(s * (1.f / 1024.f) + 1e-6f); }
    __syncthreads();
    return rs;
}
using pg8::silu_mul; using pg8::gelu_tanh;
struct SEpiRes { bf16* Xb; float* SSS; const float* bias; float scale;
    __device__ __forceinline__ void operator()(int srow, int cg, int fq, f32x4 v0, f32x4 v1, int lane) const {
        const int c = 32 * cg + 4 * fq; bf16* xb = Xb + (size_t)(MP + srow) * D + c;
        const v2u w0 = *(const v2u*)xb, w1 = *(const v2u*)(xb + 16);
        f32x4 x0 = (f32x4){bflo(w0.x), bfhi(w0.x), bflo(w0.y), bfhi(w0.y)}, x1 = (f32x4){bflo(w1.x), bfhi(w1.x), bflo(w1.y), bfhi(w1.y)};
        if (bias) { x0 += *(const f32x4*)(bias + c); x1 += *(const f32x4*)(bias + c + 16); }
        x0 += v0 * scale; x1 += v1 * scale;
        v2u a; a.x = pk2(x0.x, x0.y); a.y = pk2(x0.z, x0.w); *(v2u*)xb = a; a.x = pk2(x1.x, x1.y); a.y = pk2(x1.z, x1.w); *(v2u*)(xb + 16) = a;
        float ssq = (x0.x * x0.x + x0.y * x0.y) + (x0.z * x0.z + x0.w * x0.w) + (x1.x * x1.x + x1.y * x1.y) + (x1.z * x1.z + x1.w * x1.w);
        ssq += shx(ssq, lane, 16); ssq += shx(ssq, lane, 32);
        if (fq == 0) SSS[(size_t)srow * 32 + cg] = ssq; } };
struct SEpiRin { LAS float* rs; const float* bias; bf16* YB; bf16* XBR;
    __device__ __forceinline__ void operator()(int srow, int cg, int fq, f32x4 v0, f32x4 v1, int lane) const {
        const float r = rs[srow]; const int c = 32 * cg + 4 * fq;
        v0 = v0 * r + *(const f32x4*)(bias + c); v1 = v1 * r + *(const f32x4*)(bias + c + 16);
        const bool isy = c < 1024;
        if (isy) { v0.x = gelu_tanh(v0.x); v0.y = gelu_tanh(v0.y); v0.z = gelu_tanh(v0.z); v0.w = gelu_tanh(v0.w); v1.x = gelu_tanh(v1.x); v1.y = gelu_tanh(v1.y); v1.z = gelu_tanh(v1.z); v1.w = gelu_tanh(v1.w); }
        bf16* o = (isy ? YB : XBR) + (size_t)(MP + srow) * D + (isy ? c : c - 1024);
        v2u a; a.x = pk2(v0.x, v0.y); a.y = pk2(v0.z, v0.w); *(v2u*)o = a; a.x = pk2(v1.x, v1.y); a.y = pk2(v1.z, v1.w); *(v2u*)(o + 16) = a; } };
struct SEpiQkv { LAS float* rs; const float* CS; bf16* QKV; float* out; int j;
    __device__ __forceinline__ void operator()(int srow, int cg, int fq, f32x4 v0, f32x4 v1, int lane) const {
        const int pn = cg >> 3, sub = cg & 7, g = pn / 12, which = (pn % 12) >> 2, hq = pn & 3, head = 4 * hq + (sub >> 1), dd = 16 * (sub & 1) + 4 * fq;
        const float r = rs[srow]; v0 *= r; v1 *= r;
        if (which < 2) { const int pos = SEQ + (srow & 3); const f32x4* cs = (const f32x4*)(CS + ((size_t)pos * 32 + dd) * 2); pg8::rope4(v0, v1, cs[0], cs[1]);
            if (which == 0) { v0 *= 0.125f; v1 *= 0.125f; } }
        bf16* o = QKV + (size_t)(MP + srow) * NQKV + g * 3072 + which * 1024 + head * 64 + dd;
        v2u a; a.x = pk2(v0.x, v0.y); a.y = pk2(v0.z, v0.w); *(v2u*)o = a; a.x = pk2(v1.x, v1.y); a.y = pk2(v1.z, v1.w); *(v2u*)(o + 32) = a;
        if (which >= 1) { float* kp = out + (g == 0 ? O_KV128S : (g == 1 ? O_KV512S : O_KV2048S)) + (size_t)j * 32 * 4 * 2048 + ((size_t)srow * 2 + (which - 1)) * 1024 + head * 64 + dd; *(f32x4*)kp = v0; *(f32x4*)(kp + 32) = v1; } } };

#define GEMM_SP2 true
__device__ __forceinline__ void ph_up(const Frame& F0, int l, int f) { const Frame F = phase_frame(F0);
    const int mat = l * 2 + f; const bf16* Bt = F.W<bf16>(WS_WUP + mat * SZ_WUP);
    LAS float* rs = sample_rs(F);
    pg8::Gemm g{F.W<bf16>(WS_XB), Bt, MTP, NUP, D}; pg8::StaticOrder S; S.init(MTP, NUP, F.G, F.wg);
    pg8::EpiUp E{F.W<float>(WS_SS), F.W<bf16>(WS_HID), rs};
    if (F.wg >= 150 && mat < 7) { LAS unsigned* scr = (LAS unsigned*)(F.lds + F.wave * 16384); const int lo = cv_bound(mat), hi = cv_bound(mat + 1);
        for (int it = lo + (F.wg - 150) * NWAVES + F.wave; it < hi; it += 106 * NWAVES) cv_item(F, it, scr, F.lane);
        __syncthreads(); }
    pg8::gemm_phase<pg8::EpiUp, pg8::StaticOrder, true, GEMM_SP2>(F.lds, g, S, E, F.tid);
}
__device__ __forceinline__ void ph_res(const Frame& F0, const bf16* A, const bf16* Bt, int K, const float* bias, float scale) { const Frame F = phase_frame(F0);
    { pg8::Gemm g{A, Bt, MP, D, K}; pg8::StaticOrder S; S.init(MP, D, F.G, F.wg);
      pg8::EpiRes E{F.W<bf16>(WS_XB), F.W<float>(WS_SS), bias, scale};
      pg8::gemm_phase<pg8::EpiRes, pg8::StaticOrder, false, GEMM_SP2>(F.lds, g, S, E, F.tid); }
    { SEpiRes E{F.W<bf16>(WS_XB), F.W<float>(WS_SSS), bias, scale};
      if (K == D) sample_gemm<1, false, D, SEpiRes>(F, A + (size_t)MP * D, Bt, D / 32, E); else sample_gemm<1, false, DFF, SEpiRes>(F, A + (size_t)MP * DFF, Bt, D / 32, E); }
}
__device__ __forceinline__ void ph_rin(const Frame& F0, int j) { const Frame F = phase_frame(F0);
    const bf16* Bt = F.W<bf16>(WS_WRIN + j * SZ_WRIN); const float* bias = F.in(I_BRIN) + j * 2048;
    { pg8::Gemm g{F.W<bf16>(WS_XB), Bt, MP, 2048, D}; pg8::StaticOrder S; S.init(MP, 2048, F.G, F.wg);
      pg8::EpiRin E{F.W<float>(WS_SS), bias, F.W<bf16>(WS_YB), F.W<bf16>(WS_XBR)};
      pg8::gemm_phase<pg8::EpiRin, pg8::StaticOrder, true, GEMM_SP2>(F.lds, g, S, E, F.tid); }
    { LAS float* rs = sample_rs(F); SEpiRin E{rs, bias, F.W<bf16>(WS_YB), F.W<bf16>(WS_XBR)};
      sample_gemm<2, false, D, SEpiRin>(F, F.W<bf16>(WS_XB) + (size_t)MP * D, Bt, 2048 / 32, E); }
}
__device__ __forceinline__ void ph_qkv(const Frame& F0, int j) { const Frame F = phase_frame(F0);
    const bf16* Bt = F.W<bf16>(WS_WQKV + j * SZ_WQKV);
    { pg8::Gemm g{F.W<bf16>(WS_XB), Bt, MP, NQKV, D}; pg8::StaticOrder S; S.init(MP, NQKV, F.G, F.wg);
      static_assert(O_KV128P == 17186816 && O_KV512P == 18759680 && O_KV2048P == 23478272, "EpiQkv offsets");
      pg8::EpiQkv E{F.W<float>(WS_SS), F.W<float>(WS_CS), F.W<bf16>(WS_QKV), F.outp(), j};
      pg8::gemm_phase<pg8::EpiQkv, pg8::StaticOrder, true, GEMM_SP2>(F.lds, g, S, E, F.tid); }
    { LAS float* rs = sample_rs(F);
      SEpiQkv E{rs, F.W<float>(WS_CS), F.W<bf16>(WS_QKV), F.outp(), j};
      sample_gemm<8, true, D, SEpiQkv>(F, F.W<bf16>(WS_XB) + (size_t)MP * D, Bt, NQKV / 32, E); }
}

__device__ __forceinline__ void ph_merge(const Frame& F0) { const Frame F = phase_frame(F0);
    const bf16* OG = F.W<bf16>(WS_OG); const float* LSE = F.W<float>(WS_LSE); bf16* OM = F.W<bf16>(WS_AOP);
    for (int idx = F.wg * NTHR + F.tid; idx < MT * 128; idx += F.G * NTHR) {
        const size_t row = idx >> 7; const int c8 = idx & 127, head = c8 >> 3; const size_t off = row * D + 8 * c8;
        const v4u a0 = *(const v4u*)(OG + off), a1 = *(const v4u*)(OG + (size_t)MT * D + off), a2 = *(const v4u*)(OG + 2 * (size_t)MT * D + off);
        const float l0 = LSE[row * 16 + head], l1 = LSE[((size_t)MT + row) * 16 + head], l2 = LSE[(2 * (size_t)MT + row) * 16 + head];
        const float mx = fmaxf(l0, fmaxf(l1, l2)); float w0 = __expf(l0 - mx), w1 = __expf(l1 - mx), w2 = __expf(l2 - mx); const float inv = 1.f / (w0 + w1 + w2); w0 *= inv; w1 *= inv; w2 *= inv;
        v4u o;
        o.x = pg8::cvt_pk_bf16(w0 * bflo(a0.x) + w1 * bflo(a1.x) + w2 * bflo(a2.x), w0 * bfhi(a0.x) + w1 * bfhi(a1.x) + w2 * bfhi(a2.x));
        o.y = pg8::cvt_pk_bf16(w0 * bflo(a0.y) + w1 * bflo(a1.y) + w2 * bflo(a2.y), w0 * bfhi(a0.y) + w1 * bfhi(a1.y) + w2 * bfhi(a2.y));
        o.z = pg8::cvt_pk_bf16(w0 * bflo(a0.z) + w1 * bflo(a1.z) + w2 * bflo(a2.z), w0 * bfhi(a0.z) + w1 * bfhi(a1.z) + w2 * bfhi(a2.z));
        o.w = pg8::cvt_pk_bf16(w0 * bflo(a0.w) + w1 * bflo(a1.w) + w2 * bflo(a2.w), w0 * bfhi(a0.w) + w1 * bfhi(a1.w) + w2 * bfhi(a2.w));
        *(v4u*)(OM + off) = o;
    }
}
__device__ __forceinline__ void ph_final(const Frame& F0) { const Frame F = phase_frame(F0);
    const bf16* Xb = F.W<bf16>(WS_XB); const float* SS = F.W<float>(WS_SS); const float* SSS = F.W<float>(WS_SSS); const float* gf = F.in(I_NFIN);
    const int gw = F.wg * NWAVES + F.wave, NGW = F.G * NWAVES, lane = F.lane;
    for (int m = gw; m < MT; m += NGW) {
        float s;
        if (m < MP) { const f32x4 v = *(const f32x4*)(SS + (size_t)m * 4); s = (v.x + v.y) + (v.z + v.w); }
        else { const float v = lane < 32 ? SSS[(size_t)(m - MP) * 32 + lane] : 0.f; s = wave_sum(v, lane); }
        const float rs = rsqrtf(s * (1.f / 1024.f) + 1e-6f);
#pragma unroll
        for (int jj = 0; jj < 4; ++jj) { const v2u xw = *((const v2u*)(Xb + (size_t)m * D) + lane + 64 * jj); const f32x4 v = (f32x4){bflo(xw.x), bfhi(xw.x), bflo(xw.y), bfhi(xw.y)}; const f32x4 gg = *((const f32x4*)gf + lane + 64 * jj);
            *((f32x4*)(F.outp() + O_Y + (size_t)m * D) + lane + 64 * jj) = v * rs * gg; }
    }
}

constexpr int XP = 132, YP = 136;
constexpr int SC_XC = 0, SC_Y = 64 * XP * 4;
struct ScanW { bf16x8 wa[4], wx[4]; float ba, bx, m8sp; };
__device__ __forceinline__ float sigm(float x) { return __builtin_amdgcn_rcpf(1.f + __builtin_amdgcn_exp2f(-1.4426950408889634f * x)); }
__device__ __forceinline__ void scan_load_w(const Frame& F, int j, int blk, int w, int fr, int fq, ScanW& W) {
    const bf16* wa = F.W<bf16>(WS_WG + (size_t)((j * 2 + 0) * 8 + blk) * 32768) + (size_t)(16 * w + fr) * 128 + 8 * fq;
    const bf16* wx = F.W<bf16>(WS_WG + (size_t)((j * 2 + 1) * 8 + blk) * 32768) + (size_t)(16 * w + fr) * 128 + 8 * fq;
#pragma unroll
    for (int ks = 0; ks < 4; ++ks) { W.wa[ks] = *(const bf16x8*)(wa + 32 * ks); W.wx[ks] = *(const bf16x8*)(wx + 32 * ks); }
    const int ch = j * D + blk * 128 + 16 * w + fr;
    W.ba = F.in(I_BGA)[ch]; W.bx = F.in(I_BGX)[ch]; W.m8sp = -8.0f * 1.4426950408889634f * log1pf(expf(-F.in(I_LAM)[ch]));
}
__device__ __forceinline__ void scan_rowtile(const LAS float* xc, const ScanW& W, int fr, int fq, int cl, float (&a)[4], float (&b)[4]) {
    f32x4 da = (f32x4){0.f, 0.f, 0.f, 0.f}, dx = da;
#pragma unroll
    for (int ks = 0; ks < 4; ++ks) {
        const LAS float* p = xc + fr * XP + 32 * ks + 8 * fq; const f32x4 v0 = *(const LAS f32x4*)p, v1 = *(const LAS f32x4*)(p + 4);
        const v4u pk = pg8::pack8(v0, v1); const bf16x8 af = __builtin_bit_cast(bf16x8, pk);
        da = __builtin_amdgcn_mfma_f32_16x16x32_bf16(af, W.wa[ks], da, 0, 0, 0); dx = __builtin_amdgcn_mfma_f32_16x16x32_bf16(af, W.wx[ks], dx, 0, 0, 0);
    }
#pragma unroll
    for (int i = 0; i < 4; ++i) {
        const float xcv = xc[(4 * fq + i) * XP + cl]; const float ga = sigm(da[i] + W.ba), gx = sigm(dx[i] + W.bx);
        const float ai = __builtin_amdgcn_exp2f(W.m8sp * ga); a[i] = ai; b[i] = __builtin_amdgcn_sqrtf(fmaxf(1.f - ai * ai, 0.f)) * gx * xcv;
    }
}
constexpr int SC_P = SC_Y + 64 * YP * 2;
__device__ __forceinline__ void ph_scan(const Frame& F0, int j) { const Frame F = phase_frame(F0);
    __syncthreads();
    const int wg = F.wg, b = wg >> 7, blk = (wg >> 4) & 7, span = wg & 15;
    const int lane = F.lane, fr = lane & 15, fq = lane >> 4, w = F.wave, cl = 16 * w + fr, ch = blk * 128 + cl;
    LAS float* xc = (LAS float*)(F.lds + SC_XC); LAS bf16* yt = (LAS bf16*)(F.lds + SC_Y); LAS bf16* pt = (LAS bf16*)(F.lds + SC_P);
    const bf16* XBR = F.W<bf16>(WS_XBR); bf16* YB = F.W<bf16>(WS_YB); bf16* HY = F.W<bf16>(WS_AOP);
    float2* CARRY = F.W<float2>(WS_CARRY);
    const int c4 = F.tid & 31, tq = F.tid >> 5;
    if (wg < 256) {
    ScanW W; scan_load_w(F, j, blk, w, fr, fq, W);
    f32x4 cw[4], cb;
#pragma unroll
    for (int k = 0; k < 4; ++k) cw[k] = *(const f32x4*)(F.in(I_WCONV) + (size_t)(j * 4 + k) * D + blk * 128 + 4 * c4);
    cb = *(const f32x4*)(F.in(I_BCONV) + (size_t)j * D + blk * 128 + 4 * c4);
    float h = 0.f, ptot = 1.f;
    const int t0 = span * 512; const size_t rowb = (size_t)b * SEQ + t0;
    v2u xr[7], yr[4];
#define SCAN_LOAD(k) do { _Pragma("unroll") for (int rr = 0; rr < 7; ++rr) { const int tt = t0 + 64 * (k) + 4 * tq - 3 + rr; \
        const v2u xl_ = *(const v2u*)(XBR + ((size_t)b * SEQ + (tt < 0 ? 0 : tt)) * D + blk * 128 + 4 * c4); xr[rr].x = tt >= 0 ? xl_.x : 0u; xr[rr].y = tt >= 0 ? xl_.y : 0u; } \
        _Pragma("unroll") for (int i = 0; i < 4; ++i) yr[i] = *(const v2u*)(YB + (rowb + 64 * (k) + 4 * tq + i) * D + blk * 128 + 4 * c4); } while (0)
    SCAN_LOAD(0);
    for (int k = 0; k < 8; ++k) {
#pragma unroll
        for (int i = 0; i < 4; ++i) { f32x4 o = cb;
#pragma unroll
            for (int kk = 0; kk < 4; ++kk) { const v2u x = xr[i + kk]; o += cw[kk] * (f32x4){bflo(x.x), bfhi(x.x), bflo(x.y), bfhi(x.y)}; }
            *(LAS f32x4*)(xc + (4 * tq + i) * XP + 4 * c4) = o;
            *(LAS v2u*)(yt + (4 * tq + i) * YP + 4 * c4) = yr[i]; }
        __syncthreads();
        if (k + 1 < 8) SCAN_LOAD(k + 1);
        float a[4][4], bb[4][4], A4[4], B4[4];
#pragma unroll
        for (int rt = 0; rt < 4; ++rt) { scan_rowtile(xc + 16 * rt * XP, W, fr, fq, cl, a[rt], bb[rt]);
            A4[rt] = (a[rt][0] * a[rt][1]) * (a[rt][2] * a[rt][3]); B4[rt] = ((bb[rt][0] * a[rt][1] + bb[rt][1]) * a[rt][2] + bb[rt][2]) * a[rt][3] + bb[rt][3]; }
        float As[4][4], Bs[4][4];
#pragma unroll
        for (int rt = 0; rt < 4; ++rt)
#pragma unroll
            for (int q = 0; q < 4; ++q) { As[rt][q] = shfl_at(A4[rt], fr + 16 * q); Bs[rt][q] = shfl_at(B4[rt], fr + 16 * q); }
#pragma unroll
        for (int rt = 0; rt < 4; ++rt) {
            const float h1 = As[rt][0] * h + Bs[rt][0], h2 = As[rt][1] * h1 + Bs[rt][1], h3 = As[rt][2] * h2 + Bs[rt][2], h4 = As[rt][3] * h3 + Bs[rt][3];
            const float p1 = As[rt][0] * ptot, p2 = As[rt][1] * p1, p3 = As[rt][2] * p2, p4 = As[rt][3] * p3;
            float hh = fq == 0 ? h : (fq == 1 ? h1 : (fq == 2 ? h2 : h3)), pp = fq == 0 ? ptot : (fq == 1 ? p1 : (fq == 2 ? p2 : p3));
#pragma unroll
            for (int i = 0; i < 4; ++i) { hh = a[rt][i] * hh + bb[rt][i]; pp *= a[rt][i]; const int o = (16 * rt + 4 * fq + i) * YP + cl; const float yv = bf2f(yt[o]); yt[o] = (bf16)f2bf(hh * yv); pt[o] = (bf16)f2bf(pp * yv); }
            h = h4; ptot = p4;
        }
        __syncthreads();
        { const int r = F.tid >> 3, sg = F.tid & 7; const size_t go = (rowb + 64 * k + r) * D + blk * 128 + 16 * sg;
          const LAS v4u* s = (const LAS v4u*)(yt + r * YP + 16 * sg); v4u* d = (v4u*)(HY + go); d[0] = s[0]; d[1] = s[1];
          const LAS v4u* s2 = (const LAS v4u*)(pt + r * YP + 16 * sg); v4u* d2 = (v4u*)(YB + go); d2[0] = s2[0]; d2[1] = s2[1]; }
        __syncthreads();
    }
#undef SCAN_LOAD
    if (fq == 0) CARRY[(size_t)(b * 16 + span) * D + ch] = make_float2(ptot, h);
    if (span == 15 && F.tid < 384) { const int i = F.tid >> 7, c = F.tid & 127; F.outp()[O_CP + ((size_t)(j * 2 + b) * 3 + i) * D + blk * 128 + c] = bf2f(XBR[((size_t)b * SEQ + SEQ - 3 + i) * D + blk * 128 + c]); }
    }
    if (wg < 64) {
        __syncthreads();
        const int rt8 = wg >> 3, sblk = wg & 7, sch = sblk * 128 + cl;
        ScanW W; scan_load_w(F, j, sblk, w, fr, fq, W);
        { const int tok = tq, n = 4 * rt8 + (tok >> 2), t = tok & 3; f32x4 o = *(const f32x4*)(F.in(I_BCONV) + (size_t)j * D + sblk * 128 + 4 * c4);
#pragma unroll
          for (int kk = 0; kk < 4; ++kk) { const int tt = t + kk - 3; f32x4 xv;
              if (tt >= 0) { const v2u x = *(const v2u*)(XBR + ((size_t)MP + 4 * n + tt) * D + sblk * 128 + 4 * c4); xv = (f32x4){bflo(x.x), bfhi(x.x), bflo(x.y), bfhi(x.y)}; }
              else xv = *(const f32x4*)(F.in(I_STC) + ((size_t)(j * NSQ + n) * 3 + (tt + 3)) * D + sblk * 128 + 4 * c4);
              o += *(const f32x4*)(F.in(I_WCONV) + (size_t)(j * 4 + kk) * D + sblk * 128 + 4 * c4) * xv; }
          *(LAS f32x4*)(xc + tok * XP + 4 * c4) = o;
          *(LAS v2u*)(yt + tok * YP + 4 * c4) = *(const v2u*)(YB + ((size_t)MP + 4 * n + t) * D + sblk * 128 + 4 * c4); }
        __syncthreads();
        { float a[4], bb[4]; scan_rowtile(xc, W, fr, fq, cl, a, bb);
          const int n = 4 * rt8 + fq; float hh = F.in(I_STH)[(size_t)(j * NSQ + n) * D + sch];
#pragma unroll
          for (int i = 0; i < 4; ++i) { hh = a[i] * hh + bb[i]; LAS bf16* yp = yt + (4 * fq + i) * YP + cl; *yp = (bf16)f2bf(hh * bf2f(*yp)); }
          F.outp()[O_HS + (size_t)(j * NSQ + n) * D + sch] = hh; }
        __syncthreads();
        if (F.tid < 128) { const int r = F.tid >> 3, sg = F.tid & 7; const LAS v4u* s = (const LAS v4u*)(yt + r * YP + 16 * sg); v4u* d = (v4u*)(HY + ((size_t)MP + 16 * rt8 + r) * D + sblk * 128 + 16 * sg); d[0] = s[0]; d[1] = s[1]; }
        for (int e = F.tid; e < 4 * 3 * 128; e += NTHR) { const int c = e & 127, i = (e >> 7) % 3, sq = e / 384, n = 4 * rt8 + sq;
            F.outp()[O_CS + ((size_t)(j * NSQ + n) * 3 + i) * D + sblk * 128 + c] = bf2f(XBR[((size_t)MP + 4 * n + 1 + i) * D + sblk * 128 + c]); }
    }
}

__device__ __forceinline__ void ph_scan_fix(const Frame& F0, int j) { const Frame F = phase_frame(F0);
    __syncthreads();
    const int wg = F.wg, b = wg >> 7, blk = (wg >> 4) & 7, span = wg & 15;
    if (span == 0) return;
    LAS float* hin = (LAS float*)F.lds;
    const float2* CARRY = F.W<float2>(WS_CARRY); const bf16* PY = F.W<bf16>(WS_YB); bf16* HY = F.W<bf16>(WS_AOP);
    if (F.tid < 128) { const int ch = blk * 128 + F.tid; float h = 0.f;
        for (int s = 0; s < span; ++s) { const float2 cv = CARRY[(size_t)(b * 16 + s) * D + ch]; h = cv.x * h + cv.y; }
        hin[F.tid] = h;
        if (span == 15) { const float2 cv = CARRY[(size_t)(b * 16 + 15) * D + ch]; F.outp()[O_HP + (size_t)(j * 2 + b) * D + ch] = cv.x * h + cv.y; } }
    __syncthreads();
    const int c8 = F.tid & 15, r = F.tid >> 4; float hv[8];
#pragma unroll
    for (int e = 0; e < 8; ++e) hv[e] = hin[8 * c8 + e];
    const size_t rowb = (size_t)b * SEQ + span * 512;
#pragma unroll 4
    for (int it = 0; it < 16; ++it) { const size_t go = (rowb + 32 * it + r) * D + blk * 128 + 8 * c8;
        const v4u hl = *(const v4u*)(HY + go), pv = *(const v4u*)(PY + go); v4u o;
        o.x = pk2(bflo(hl.x) + bflo(pv.x) * hv[0], bfhi(hl.x) + bfhi(pv.x) * hv[1]); o.y = pk2(bflo(hl.y) + bflo(pv.y) * hv[2], bfhi(hl.y) + bfhi(pv.y) * hv[3]);
        o.z = pk2(bflo(hl.z) + bflo(pv.z) * hv[4], bfhi(hl.z) + bfhi(pv.z) * hv[5]); o.w = pk2(bflo(hl.w) + bflo(pv.w) * hv[6], bfhi(hl.w) + bfhi(pv.w) * hv[7]);
        *(v4u*)(HY + go) = o; }
}

constexpr int KP = 72;
constexpr int AT_HALF = 128 * KP * 2, AT_K = 0, AT_V = 2 * AT_HALF;
typedef short s16x4 __attribute__((ext_vector_type(4)));
typedef short v4i16_t __attribute__((ext_vector_type(4)));
__device__ __forceinline__ s16x4 vtr(const LAS unsigned char* p) { return __builtin_bit_cast(s16x4, __builtin_amdgcn_ds_read_tr16_b64_v4i16((LAS v4i16_t*)p)); }
__device__ __forceinline__ void attn_decode(int u, int& g, int& b, int& head, int& r, int& nb) { const int combo = u >> 6, idx = u & 63; g = combo >> 5; b = (combo >> 4) & 1; head = combo & 15; r = idx >> (6 - 2 * g); nb = idx & ((64 >> (2 * g)) - 1); }
template <bool LAST>
__device__ __forceinline__ void ph_attn(const Frame& F0, int j) { const Frame F = phase_frame(F0);
    __syncthreads();
    const int lane = F.lane, fr = lane & 15, fq = lane >> 4, w = F.wave, tid = F.tid;
    const bf16* QKV = F.W<bf16>(WS_QKV); bf16* OG = F.W<bf16>(WS_OG); float* LSE = F.W<float>(WS_LSE); bf16* OM = F.W<bf16>(WS_AOP);
    LAS unsigned char* lds = F.lds;
    constexpr int UPW = LAST ? 8 : 16; const int ubase = LAST ? 4096 + F.wg * UPW : F.wg * UPW;
#define AT_GLOAD(dst, g_, b_, head_, r_, blk_) do { _Pragma("unroll") for (int i = 0; i < 4; ++i) { const int c = tid + 512 * i, wh = c >> 10, row = (c >> 3) & 127, sg = c & 7; \
        dst[i] = (blk_) < 0 ? (v4u){0u, 0u, 0u, 0u} : *(const v4u*)(QKV + ((size_t)(b_) * SEQ + (((blk_) * 128 + row) << (2 * (g_))) + (r_)) * NQKV + (g_) * 3072 + (1 + wh) * 1024 + (head_) * 64 + 8 * sg); } } while (0)
#define AT_LSTORE(src, blk_) do { _Pragma("unroll") for (int i = 0; i < 4; ++i) { const int c = tid + 512 * i, wh = c >> 10, row = (c >> 3) & 127, sg = c & 7; \
        *(LAS v4u*)(lds + wh * AT_V + ((blk_) & 1) * AT_HALF + (row * KP + 8 * sg) * 2) = src[i]; } } while (0)
    v4u ncur[4], nprev[4]; bf16x8 qn[2];
#define AT_QLOAD(g_, b_, head_, r_, nb_) do { const bf16* qp_ = QKV + ((size_t)(b_) * SEQ + ((((nb_) * 128 + 16 * w + fr) << (2 * (g_))) + (r_))) * NQKV + (g_) * 3072 + (head_) * 64 + 8 * fq; qn[0] = *(const bf16x8*)qp_; qn[1] = *(const bf16x8*)(qp_ + 32); } while (0)
    int g, b, head, r, nb; attn_decode(ubase, g, b, head, r, nb);
    AT_GLOAD(ncur, g, b, head, r, nb); AT_GLOAD(nprev, g, b, head, r, nb - 1); AT_QLOAD(g, b, head, r, nb);
    bool need_prev = true;
    for (int ui = 0; ui < UPW; ++ui) {
        AT_LSTORE(ncur, nb); if (need_prev) AT_LSTORE(nprev, nb - 1);
        bf16x8 qf[2]; qf[0] = qn[0]; qf[1] = qn[1];
        __syncthreads();
        const size_t qrow = (size_t)b * SEQ + (((nb * 128 + 16 * w + fr) << (2 * g)) + r);
        int g2 = g, b2 = b, head2 = head, r2 = r, nb2 = nb; bool np2 = false;
        if (ui + 1 < UPW) { attn_decode(ubase + ui + 1, g2, b2, head2, r2, nb2); np2 = !(g2 == g && b2 == b && head2 == head && r2 == r && nb2 == nb + 1);
            AT_GLOAD(ncur, g2, b2, head2, r2, nb2); if (np2) AT_GLOAD(nprev, g2, b2, head2, r2, nb2 - 1); AT_QLOAD(g2, b2, head2, r2, nb2); }
        v2u mo0[4], mo1[4]; float ml0 = 0.f, ml1 = 0.f;
        if (LAST) { const bf16* o0p = OG + qrow * D + head * 64 + 4 * fq; const bf16* o1p = o0p + (size_t)MT * D;
#pragma unroll
            for (int dt = 0; dt < 4; ++dt) { mo0[dt] = *(const v2u*)(o0p + 16 * dt); mo1[dt] = *(const v2u*)(o1p + 16 * dt); }
            ml0 = LSE[qrow * 16 + head]; ml1 = LSE[((size_t)MT + qrow) * 16 + head]; }
        f32x4 sacc[9];
#pragma unroll
        for (int jj = 0; jj < 9; ++jj) { const int kt = w + jj; const int blk = kt < 8 ? nb - 1 : nb;
            const LAS unsigned char* kp = lds + AT_K + (blk & 1) * AT_HALF + (((kt & 7) * 16 + fr) * KP + 8 * fq) * 2;
            const bf16x8 k0 = *(const LAS bf16x8*)kp, k1 = *(const LAS bf16x8*)(kp + 64);
            f32x4 s = (f32x4){0.f, 0.f, 0.f, 0.f};
            s = __builtin_amdgcn_mfma_f32_16x16x32_bf16(k0, qf[0], s, 0, 0, 0); s = __builtin_amdgcn_mfma_f32_16x16x32_bf16(k1, qf[1], s, 0, 0, 0); sacc[jj] = s; }
        const float NEG = -1e30f; float mx = NEG;
#pragma unroll
        for (int i = 0; i < 4; ++i) { if (4 * fq + i < fr) sacc[0][i] = NEG; if (4 * fq + i > fr) sacc[8][i] = NEG; }
        if (nb == 0) {
#pragma unroll
            for (int jj = 0; jj < 8; ++jj) if (w + jj < 8) sacc[jj] = (f32x4){NEG, NEG, NEG, NEG}; }
#pragma unroll
        for (int jj = 0; jj < 9; ++jj) mx = fmaxf(mx, fmaxf(fmaxf(sacc[jj][0], sacc[jj][1]), fmaxf(sacc[jj][2], sacc[jj][3])));
        mx = fmaxf(mx, shx(mx, lane, 16)); mx = fmaxf(mx, shx(mx, lane, 32));
        float sum = 0.f;
#pragma unroll
        for (int jj = 0; jj < 9; ++jj)
#pragma unroll
            for (int i = 0; i < 4; ++i) { const float p = __expf(sacc[jj][i] - mx); sacc[jj][i] = p; sum += p; }
        sum += shx(sum, lane, 16); sum += shx(sum, lane, 32);
        f32x4 oacc[4];
#pragma unroll
        for (int dt = 0; dt < 4; ++dt) oacc[dt] = (f32x4){0.f, 0.f, 0.f, 0.f};
#pragma unroll
        for (int pp = 0; pp < 5; ++pp) { const int j0 = 2 * pp, j1 = pp < 4 ? 2 * pp + 1 : 2 * pp; const int kt0 = w + j0, kt1 = w + j1;
            const f32x4 p0 = sacc[j0], p1 = pp < 4 ? sacc[j1] : (f32x4){0.f, 0.f, 0.f, 0.f};
            const v4u pk = pg8::pack8(p0, p1); const bf16x8 pf = __builtin_bit_cast(bf16x8, pk);
            const LAS unsigned char* v0p = lds + AT_V + (((kt0 < 8 ? nb - 1 : nb) & 1) * AT_HALF) + (((kt0 & 7) * 16 + 4 * fq + (fr >> 2)) * KP + 4 * (fr & 3)) * 2;
            const LAS unsigned char* v1p = lds + AT_V + (((kt1 < 8 ? nb - 1 : nb) & 1) * AT_HALF) + (((kt1 & 7) * 16 + 4 * fq + (fr >> 2)) * KP + 4 * (fr & 3)) * 2;
#pragma unroll
            for (int dt = 0; dt < 4; ++dt) { const s16x4 a = vtr(v0p + 32 * dt), c = vtr(v1p + 32 * dt);
                const bf16x8 vf = (bf16x8){a[0], a[1], a[2], a[3], c[0], c[1], c[2], c[3]};
                oacc[dt] = __builtin_amdgcn_mfma_f32_16x16x32_bf16(vf, pf, oacc[dt], 0, 0, 0); } }
        if (!LAST) {
            const float inv = 1.f / sum; bf16* op = OG + ((size_t)g * MT + qrow) * D + head * 64 + 4 * fq;
#pragma unroll
            for (int dt = 0; dt < 4; ++dt) { const f32x4 o = oacc[dt] * inv; v2u pw; pw.x = pg8::cvt_pk_bf16(o.x, o.y); pw.y = pg8::cvt_pk_bf16(o.z, o.w); *(v2u*)(op + 16 * dt) = pw; }
            if (fq == 0) LSE[((size_t)g * MT + qrow) * 16 + head] = mx + __logf(sum);
        } else {
            const float ml2 = mx + __logf(sum), mm = fmaxf(ml0, fmaxf(ml1, ml2)); float w0 = __expf(ml0 - mm), w1 = __expf(ml1 - mm), w2 = __expf(ml2 - mm);
            const float wi = 1.f / (w0 + w1 + w2); w0 *= wi; w1 *= wi; w2 *= wi / sum; bf16* op = OM + qrow * D + head * 64 + 4 * fq;
#pragma unroll
            for (int dt = 0; dt < 4; ++dt) { const f32x4 o2 = oacc[dt]; v2u pw;
                pw.x = pg8::cvt_pk_bf16(w0 * bflo(mo0[dt].x) + w1 * bflo(mo1[dt].x) + w2 * o2.x, w0 * bfhi(mo0[dt].x) + w1 * bfhi(mo1[dt].x) + w2 * o2.y);
                pw.y = pg8::cvt_pk_bf16(w0 * bflo(mo0[dt].y) + w1 * bflo(mo1[dt].y) + w2 * o2.z, w0 * bfhi(mo0[dt].y) + w1 * bfhi(mo1[dt].y) + w2 * o2.w);
                *(v2u*)(op + 16 * dt) = pw; }
        }
        __syncthreads();
        g = g2; b = b2; head = head2; r = r2; nb = nb2; need_prev = np2;
    }
#undef AT_GLOAD
#undef AT_LSTORE
#undef AT_QLOAD
}
template <bool LAST>
__device__ __forceinline__ void ph_attn_sample(const Frame& F0, int j) { const Frame F = phase_frame(F0);
    const int lane = F.lane, w = F.wave;
    const bf16* QKV = F.W<bf16>(WS_QKV); bf16* OG = F.W<bf16>(WS_OG); float* LSE = F.W<float>(WS_LSE); bf16* OM = F.W<bf16>(WS_AOP);
    const float* c0 = F.in(I_C128); const float* c1 = F.in(I_C512); const float* c2 = F.in(I_C2048);
    for (int it3 = LAST ? 2 : 0; it3 < (LAST ? 3 : 2); ++it3) {
        const int id = it3 * 2048 + F.wg * NWAVES + w;
        const int sg = id >> 11, srow = (id >> 4) & 127, shead = id & 15, n = srow >> 2, t = srow & 3, dil = 1 << (2 * sg), Wg = 128 << (2 * sg), ks = lane >> 4, d4 = lane & 15;
        const float* cache = (sg == 0 ? c0 : (sg == 1 ? c1 : c2)) + (size_t)(j * NSQ + n) * Wg * 2048 + shead * 64 + 4 * d4;
        const bf16* nk = QKV + (size_t)(MP + 4 * n) * NQKV + sg * 3072 + 1024 + shead * 64 + 4 * d4;
        f32x4 q4; { const v2u x = *(const v2u*)(QKV + (size_t)(MP + srow) * NQKV + sg * 3072 + shead * 64 + 4 * d4); q4 = (f32x4){bflo(x.x), bfhi(x.x), bflo(x.y), bfhi(x.y)}; }
        float sc[33];
#define AT_SKEY(it_, which_, dst_) do { const int k_ = 4 * (it_) + ks; const int p_ = SEQ + t - dil * k_; dst_ = (f32x4){0.f, 0.f, 0.f, 0.f}; \
            if (k_ <= 128) { if (p_ >= SEQ) { const v2u a_ = *(const v2u*)(nk + (size_t)(p_ - SEQ) * NQKV + (which_) * 1024); dst_ = (f32x4){bflo(a_.x), bfhi(a_.x), bflo(a_.y), bfhi(a_.y)}; } \
                             else dst_ = *(const f32x4*)(cache + (size_t)(p_ - (SEQ - Wg)) * 2048 + (which_) * 1024); } } while (0)
#pragma unroll
        for (int c3 = 0; c3 < 3; ++c3) { f32x4 kk[11];
#pragma unroll
            for (int i = 0; i < 11; ++i) AT_SKEY(11 * c3 + i, 0, kk[i]);
#pragma unroll
            for (int i = 0; i < 11; ++i) { float s = (q4.x * kk[i].x + q4.y * kk[i].y) + (q4.z * kk[i].z + q4.w * kk[i].w);
                s += shx(s, lane, 1); s += shx(s, lane, 2); s += shx(s, lane, 4); s += shx(s, lane, 8); sc[11 * c3 + i] = (4 * (11 * c3 + i) + ks <= 128) ? s : -1e30f; } }
        float m = -1e30f;
#pragma unroll
        for (int i = 0; i < 33; ++i) m = fmaxf(m, sc[i]);
        float l = 0.f;
#pragma unroll
        for (int i = 0; i < 33; ++i) { sc[i] = __expf(sc[i] - m); l += sc[i]; }
        f32x4 o4 = (f32x4){0.f, 0.f, 0.f, 0.f};
#pragma unroll
        for (int c3 = 0; c3 < 3; ++c3) { f32x4 vv[11];
#pragma unroll
            for (int i = 0; i < 11; ++i) AT_SKEY(11 * c3 + i, 1, vv[i]);
#pragma unroll
            for (int i = 0; i < 11; ++i) o4 += vv[i] * sc[11 * c3 + i]; }
#undef AT_SKEY
#pragma unroll
        for (int off = 16; off <= 32; off <<= 1) {
            const float m2 = shx(m, lane, off), l2 = shx(l, lane, off); f32x4 o2; o2.x = shx(o4.x, lane, off); o2.y = shx(o4.y, lane, off); o2.z = shx(o4.z, lane, off); o2.w = shx(o4.w, lane, off);
            const float mn = fmaxf(m, m2), e1 = __expf(m - mn), e2 = __expf(m2 - mn); l = l * e1 + l2 * e2; o4 = o4 * e1 + o2 * e2; m = mn;
        }
        if (ks == 0) {
            if (!LAST) { const f32x4 o = o4 * (1.f / l); v2u pw; pw.x = pg8::cvt_pk_bf16(o.x, o.y); pw.y = pg8::cvt_pk_bf16(o.z, o.w); *(v2u*)(OG + ((size_t)sg * MT + MP + srow) * D + shead * 64 + 4 * d4) = pw; if (d4 == 0) LSE[((size_t)sg * MT + MP + srow) * 16 + shead] = m + __logf(l); }
            else { const size_t orow = (size_t)MP + srow; const v2u a0 = *(const v2u*)(OG + orow * D + shead * 64 + 4 * d4), a1 = *(const v2u*)(OG + ((size_t)MT + orow) * D + shead * 64 + 4 * d4);
                const float l0 = LSE[orow * 16 + shead], l1 = LSE[((size_t)MT + orow) * 16 + shead], l2 = m + __logf(l), mm = fmaxf(l0, fmaxf(l1, l2)); float w0 = __expf(l0 - mm), w1 = __expf(l1 - mm), w2 = __expf(l2 - mm);
                const float wi = 1.f / (w0 + w1 + w2); w0 *= wi; w1 *= wi; w2 *= wi / l; v2u pw;
                pw.x = pg8::cvt_pk_bf16(w0 * bflo(a0.x) + w1 * bflo(a1.x) + w2 * o4.x, w0 * bfhi(a0.x) + w1 * bfhi(a1.x) + w2 * o4.y); pw.y = pg8::cvt_pk_bf16(w0 * bflo(a0.y) + w1 * bflo(a1.y) + w2 * o4.z, w0 * bfhi(a0.y) + w1 * bfhi(a1.y) + w2 * o4.w);
                *(v2u*)(OM + orow * D + shead * 64 + 4 * d4) = pw; }
        }
    }
}

#ifndef REP_PRO
#define REP_PRO 1
#endif
#ifndef REP_UP
#define REP_UP 1
#endif
#ifndef REP_RIN
#define REP_RIN 1
#endif
#ifndef REP_SCAN
#define REP_SCAN 1
#endif
#ifndef REP_QKV
#define REP_QKV 1
#endif
#ifndef REP_ATTN
#define REP_ATTN 1
#endif
#ifndef REP_BAR
#define REP_BAR 0
#endif
#ifndef REP_DN
#define REP_DN 1
#endif
#ifndef REP_AOUT
#define REP_AOUT 1
#endif
#ifndef REP_ATTN_S
#define REP_ATTN_S 1
#endif
#ifndef REP_MERGE
#define REP_MERGE 1
#endif
#ifndef REP_FINAL
#define REP_FINAL 1
#endif
__global__ void __launch_bounds__(NTHR, 2) mega_fwd(Params p) {
    extern __shared__ __attribute__((aligned(16))) unsigned char lds_raw[];
    Frame F;
    F.lds = (LAS unsigned char*)lds_raw; F.tid = threadIdx.x; F.lane = F.tid & 63; F.wave = __builtin_amdgcn_readfirstlane(F.tid >> 6); F.wg = blockIdx.x; F.G = gridDim.x;
    F.out_g = (GAS float*)p.out; F.ws_g = (GAS unsigned char*)p.ws;
    for (int u = F.tid; u < (LDS_BYTES - RING_BYTES) / 4; u += NTHR) ((LAS unsigned*)(F.lds + RING_BYTES))[u] = 0u;
    __syncthreads();
    XcdBarrier bar = xcd_barrier_post((unsigned*)(p.ws + WS_CTL) + CW_BAR, (volatile LAS unsigned*)(F.lds + MISC_OFF) + 8);
#define GRID_BAR() do { XcdBarrier bb_ = bar; bb_.x = xb_xcc_id(); asm volatile("" : "+s"(bb_.bar), "+s"(bb_.x)); bb_.lead = (F.wave == 0) && (lane_now() == 0); xcd_barrier(bb_); } while (0)
    for (int rep = 0; rep < REP_PRO; ++rep) { ph_prologue(F); GRID_BAR(); }
    for (int l = 0; l < DEPTH; ++l) {
        const int j = l >> 1;
        for (int rep = 0; rep < REP_BAR; ++rep) GRID_BAR();
        for (int f = 0; f < 2; ++f) {
            for (int rep = 0; rep < REP_UP; ++rep) { ph_up(F, l, f); GRID_BAR(); }
            for (int rep = 1; rep < REP_DN; ++rep) { ph_res(F, F.W<bf16>(WS_HID), F.W<bf16>(WS_WDN + (size_t)(l * 2 + f) * SZ_WDN), DFF, nullptr, 0.0f); GRID_BAR(); }
            ph_res(F, F.W<bf16>(WS_HID), F.W<bf16>(WS_WDN + (size_t)(l * 2 + f) * SZ_WDN), DFF, nullptr, 0.5f); GRID_BAR();
            if (f == 0) {
                if ((l & 1) == 0) {
                    for (int rep = 0; rep < REP_RIN; ++rep) { ph_rin(F, j); GRID_BAR(); }
                    for (int rep = 0; rep < REP_SCAN; ++rep) { ph_scan(F, j); GRID_BAR(); }
                    ph_scan_fix(F, j); GRID_BAR();
                    ph_res(F, F.W<bf16>(WS_AOP), F.W<bf16>(WS_WROUT + (size_t)j * SZ_WSQ), D, F.in(I_BROUT) + j * D, 1.0f); GRID_BAR();
                } else {
                    for (int rep = 0; rep < REP_QKV; ++rep) { ph_qkv(F, j); GRID_BAR(); }
                    ph_attn_sample<false>(F, j); ph_attn<false>(F, j); GRID_BAR();
                    ph_attn_sample<true>(F, j); ph_attn<true>(F, j); GRID_BAR();
                    for (int rep = 1; rep < REP_AOUT; ++rep) { ph_res(F, F.W<bf16>(WS_AOP), F.W<bf16>(WS_WO + (size_t)j * SZ_WSQ), D, nullptr, 0.0f); GRID_BAR(); }
                    ph_res(F, F.W<bf16>(WS_AOP), F.W<bf16>(WS_WO + (size_t)j * SZ_WSQ), D, nullptr, 1.0f); GRID_BAR();
                }
            }
        }
    }
    for (int rep = 0; rep < REP_FINAL; ++rep) ph_final(F);
}

extern "C" void kernel_launch(void* const* d_in, const int* in_sizes, int n_in, void* d_out, int out_size, void* d_ws, size_t ws_size, hipStream_t stream) {
    static int grid = 0;
    if (grid == 0) {
        if (n_in != N_IN || (size_t)out_size != O_END || ws_size < WS_END) { fprintf(stderr, "kernel_launch: unexpected shapes (n_in %d, out %d, ws %zu); nothing launched\n", n_in, out_size, ws_size); grid = -1; return; }
        int dev = 0, cus = 0, per_cu = 0;
        if (hipGetDevice(&dev) != hipSuccess || hipDeviceGetAttribute(&cus, hipDeviceAttributeMultiprocessorCount, dev) != hipSuccess) { grid = -1; return; }
        if (hipFuncSetAttribute((const void*)mega_fwd, hipFuncAttributeMaxDynamicSharedMemorySize, LDS_BYTES) != hipSuccess) { grid = -1; return; }
        if (hipOccupancyMaxActiveBlocksPerMultiprocessor(&per_cu, (const void*)mega_fwd, NTHR, LDS_BYTES) != hipSuccess || per_cu < 1) { fprintf(stderr, "kernel_launch: occupancy query says %d blocks per CU\n", per_cu); }
        (void)hipGetLastError();
        if (cus != 256) { fprintf(stderr, "kernel_launch: built for 256 CUs, device has %d; nothing launched\n", cus); grid = -1; return; }
        grid = cus;
    }
    if (grid < 0) return;
    if (hipMemsetAsync((char*)d_ws + WS_CTL, 0, CTL_ZERO_BYTES, stream) != hipSuccess) return;
    Params p{};
    for (int i = 0; i < N_IN; ++i) p.in[i] = (const float*)d_in[i];
    p.out = (float*)d_out; p.ws = (unsigned char*)d_ws;
    hipLaunchKernelGGL(mega_fwd, dim3(grid), dim3(NTHR), LDS_BYTES, stream, p);
}
```

```cpp
#include <hip/hip_runtime.h>
#include <cstdio>
#include <cstdint>
#include <cmath>
#define LAS __attribute__((address_space(3)))
#ifndef TPROBE
#define TPROBE -1
#endif
#ifndef TPROBE_PH
#define TPROBE_PH 0
#endif
namespace pg8 {
#define PG8_LAS __attribute__((address_space(3)))
typedef unsigned short bf16_t;
typedef short bf16x8 __attribute__((ext_vector_type(8)));
typedef float f32x4 __attribute__((ext_vector_type(4)));
typedef unsigned u32x4 __attribute__((ext_vector_type(4)));
constexpr int BM = 256, BK = 64, HALF = 128, HTB = HALF * BK * 2  , STAGE_BYTES = 8 * HTB, NXCD = 8, WGM = 8;

__host__ __device__ __forceinline__ int lds_byte(int r, int c) { const int st = (r >> 4) * 2 + (c >> 5), rr = r & 15, cc = c & 31, ob = rr * 64 + cc * 2; return st * 1024 + (ob ^ (((ob >> 9) & 1) << 5)); }
__host__ __device__ __forceinline__ void stage_rc(int b, int& R, int& C) { const int st = b / 1024, sb = b % 1024, swz = sb ^ (((sb >> 9) & 1) << 5); R = (st >> 1) * 16 + swz / 64; C = (st & 1) * 32 + (swz % 64) / 2; }
__host__ __device__ __forceinline__ int perm32(int rho) { const int n = rho >> 4, i = rho & 15; return 8 * (i >> 2) + 4 * n + (i & 3); }

struct Unit { int pm, pn; };
struct Gemm { const bf16_t* A; const bf16_t* Bt; int M, N, K; };

struct StaticOrder {
    int nM, nN, nwg, G, c;
    __host__ __device__ void init(int M, int N, int G_, int c_) { nM = M / BM; nN = N / BM; nwg = nM * nN; G = G_; c = c_; }
    __host__ __device__ bool next(int i, Unit& u) const {
        const long L = (long)i * G + c; if (L >= nwg) return false;
        int wgid = (int)L; { const int q = nwg / NXCD, r = nwg % NXCD, xcd = wgid % NXCD, off = wgid / NXCD; wgid = (xcd < r ? xcd * (q + 1) : r * (q + 1) + (xcd - r) * q) + off; }
        const int nig = WGM * nN, gid = wgid / nig, fm = gid * WGM, gsz = (nM - fm) < WGM ? (nM - fm) : WGM;
        u.pm = fm + ((wgid % nig) % gsz); u.pn = (wgid % nig) / gsz; return true;
    }
    __device__ __forceinline__ void a_ready(const Unit&) const {}
    __device__ __forceinline__ void done(const Unit&) const {}
};

typedef float f32x2_cv __attribute__((ext_vector_type(2))); typedef __bf16 bf16x2_cv __attribute__((ext_vector_type(2)));
__device__ __forceinline__ unsigned cvt_pk_bf16(float lo, float hi) { const f32x2_cv v = {lo, hi}; const bf16x2_cv b = __builtin_convertvector(v, bf16x2_cv); return __builtin_bit_cast(unsigned, b); }
typedef float f32x2 __attribute__((ext_vector_type(2)));
__device__ __forceinline__ float shfl_at(float v, int srclane) { return __builtin_bit_cast(float, __builtin_amdgcn_ds_bpermute(srclane << 2, __builtin_bit_cast(int, v))); }
__device__ __forceinline__ float shx(float v, int lane, int k) { return shfl_at(v, lane ^ k); }
typedef unsigned u32x2 __attribute__((ext_vector_type(2)));
__device__ __forceinline__ float frcp(float x) { return __builtin_amdgcn_rcpf(x); }
__device__ __forceinline__ float silu_mul(float g, float u) { return g * u * frcp(1.f + __expf(-g)); }
__device__ __forceinline__ f32x2 silu_mul2(const f32x2 g, const f32x2 u, const f32x2 c1, const f32x2 ir) { const f32x2 t = g * c1; f32x2 e; e.x = __builtin_amdgcn_exp2f(t.x); e.y = __builtin_amdgcn_exp2f(t.y);
    const f32x2 d = e * ir + ir; f32x2 r; r.x = frcp(d.x); r.y = frcp(d.y); return (g * u) * r; }
__device__ __forceinline__ f32x2 gelu_tanh2(const f32x2 x) { const f32x2 x2 = x * x; const f32x2 u = (x * -2.3022082f) * (x2 * 0.044715f + 1.0f); f32x2 e; e.x = __builtin_amdgcn_exp2f(u.x); e.y = __builtin_amdgcn_exp2f(u.y);
    const f32x2 d = e + 1.0f; f32x2 r; r.x = frcp(d.x); r.y = frcp(d.y); return x * r; }
__device__ __forceinline__ float gelu_tanh(float x) { const float uu = 1.5957691216057308f * (x + 0.044715f * x * x * x); return x * frcp(1.f + __expf(-uu)); }
__device__ __forceinline__ float row_rs(const float* SS, int row) { const f32x4 s4 = *(const f32x4*)(SS + (size_t)row * 4); return rsqrtf(((s4.x + s4.y) + (s4.z + s4.w)) * (1.f / 1024.f) + 1e-6f); }
__device__ __forceinline__ u32x4 pack8(const f32x4& a, const f32x4& b) { u32x4 w; w.x = cvt_pk_bf16(a.x, a.y); w.y = cvt_pk_bf16(a.z, a.w); w.z = cvt_pk_bf16(b.x, b.y); w.w = cvt_pk_bf16(b.z, b.w); return w; }

struct EpiUp {
    static constexpr bool PERM = true, AFTER_DRAIN = false;
    const float* SS; bf16_t* H; const PG8_LAS float* rs_s;
    __device__ __forceinline__ void operator()(const f32x4 (&acc)[2][2][4][2], const Unit& u, int wr, int wc, int fr, int fq) const {
        const int row0 = u.pm * BM + wr * 64 + fr, col0 = u.pn * 128 + wc * 32 + 8 * fq; const bool smp = u.pm >= 64;
        float rsv[2][4];
#pragma unroll
        for (int ai = 0; ai < 2; ++ai)
#pragma unroll
            for (int m = 0; m < 4; ++m) rsv[ai][m] = row_rs(SS, smp ? 0 : row0 + ai * HALF + m * 16);
        if (smp) {
#pragma unroll
            for (int ai = 0; ai < 2; ++ai)
#pragma unroll
                for (int m = 0; m < 4; ++m) rsv[ai][m] = rs_s[(row0 + ai * HALF + m * 16 - 16384) & 127]; }
#pragma unroll
        for (int ai = 0; ai < 2; ++ai)
#pragma unroll
            for (int m = 0; m < 4; ++m) {
                const int row = row0 + ai * HALF + m * 16; const float rs = rsv[ai][m];
                const float c1s = rs * -1.4426950408889634f, irs = frcp(rs * rs); const f32x2 c1 = {c1s, c1s}, ir = {irs, irs};
                const f32x4 ga = acc[ai][0][m][0], gb = acc[ai][0][m][1], ua = acc[ai][1][m][0], ub = acc[ai][1][m][1];
                const f32x2 q0 = silu_mul2((f32x2){ga.x, ga.y}, (f32x2){ua.x, ua.y}, c1, ir), q1 = silu_mul2((f32x2){ga.z, ga.w}, (f32x2){ua.z, ua.w}, c1, ir);
                const f32x2 q2 = silu_mul2((f32x2){gb.x, gb.y}, (f32x2){ub.x, ub.y}, c1, ir), q3 = silu_mul2((f32x2){gb.z, gb.w}, (f32x2){ub.z, ub.w}, c1, ir);
                const f32x4 h0 = {q0.x, q0.y, q1.x, q1.y}, h1 = {q2.x, q2.y, q3.x, q3.y};
                *(u32x4*)(H + (size_t)row * 2816 + col0) = pack8(h0, h1);
            }
    }
};

__device__ __forceinline__ float ublo(unsigned u) { return __builtin_bit_cast(float, u << 16); }
__device__ __forceinline__ float ubhi(unsigned u) { return __builtin_bit_cast(float, u & 0xffff0000u); }
struct EpiRes {
    static constexpr bool PERM = true, AFTER_DRAIN = true;
    bf16_t* Xb; float* SS; const float* bias; float scale;
    __device__ __forceinline__ void fused(f32x4 (&acc)[2][2][4][2], const Unit& u, int wr, int wc, int fr, int fq, PG8_LAS unsigned char* lds, int wid, int lane) const {
        PG8_LAS float* P = (PG8_LAS float*)lds;
        const int col0 = u.pn * BM + wc * 32 + 8 * fq;
        f32x4 bv[2][2];
#pragma unroll
        for (int bj = 0; bj < 2; ++bj) { bv[bj][0] = bias ? *(const f32x4*)(bias + col0 + bj * HALF) : (f32x4){0.f, 0.f, 0.f, 0.f}; bv[bj][1] = bias ? *(const f32x4*)(bias + col0 + bj * HALF + 4) : (f32x4){0.f, 0.f, 0.f, 0.f}; }
#pragma unroll
        for (int ai = 0; ai < 2; ++ai)
#pragma unroll
            for (int m = 0; m < 4; ++m) {
                const int rt = ai * HALF + wr * 64 + m * 16 + fr; const size_t row = (size_t)u.pm * BM + rt; float ssq = 0.f;
#pragma unroll
                for (int bj = 0; bj < 2; ++bj) {
                    bf16_t* xp = Xb + row * 1024 + col0 + bj * HALF; const u32x4 xw = *(const u32x4*)xp;
                    f32x4 x0 = (f32x4){ublo(xw.x), ubhi(xw.x), ublo(xw.y), ubhi(xw.y)}, x1 = (f32x4){ublo(xw.z), ubhi(xw.z), ublo(xw.w), ubhi(xw.w)};
                    x0 += acc[ai][bj][m][0] * scale + bv[bj][0]; x1 += acc[ai][bj][m][1] * scale + bv[bj][1];
                    *(u32x4*)xp = pack8(x0, x1);
                    ssq += (x0.x * x0.x + x0.y * x0.y) + (x0.z * x0.z + x0.w * x0.w) + (x1.x * x1.x + x1.y * x1.y) + (x1.z * x1.z + x1.w * x1.w);
                }
                ssq += shx(ssq, lane, 16); ssq += shx(ssq, lane, 32);
                if (fq == 0) P[rt * 4 + wc] = ssq;
            }
        asm volatile("s_waitcnt lgkmcnt(0)" ::: "memory"); __builtin_amdgcn_s_barrier(); asm volatile("" ::: "memory");
        const int t = wid * 64 + lane;
        if (t < 256) { const f32x4 p = *(const PG8_LAS f32x4*)(P + t * 4); SS[((size_t)u.pm * BM + t) * 4 + u.pn] = (p.x + p.y) + (p.z + p.w); }
    }
};

struct EpiRin {
    static constexpr bool PERM = true, AFTER_DRAIN = false;
    const float* SS; const float* bias; bf16_t* YB; bf16_t* XBR;
    __device__ __forceinline__ void operator()(const f32x4 (&acc)[2][2][4][2], const Unit& u, int wr, int wc, int fr, int fq) const {
        const int row0 = u.pm * BM + wr * 64 + fr, col0 = u.pn * BM + wc * 32 + 8 * fq; const bool isy = u.pn < 4;
        bf16_t* O = isy ? YB : XBR; const int oc0 = isy ? col0 : col0 - 1024;
        f32x4 bv[2][2];
#pragma unroll
        for (int bj = 0; bj < 2; ++bj) { bv[bj][0] = *(const f32x4*)(bias + col0 + bj * HALF); bv[bj][1] = *(const f32x4*)(bias + col0 + bj * HALF + 4); }
        float rsv[2][4];
#pragma unroll
        for (int ai = 0; ai < 2; ++ai)
#pragma unroll
            for (int m = 0; m < 4; ++m) rsv[ai][m] = row_rs(SS, row0 + ai * HALF + m * 16);
#pragma unroll
        for (int ai = 0; ai < 2; ++ai)
#pragma unroll
            for (int m = 0; m < 4; ++m) {
                const int row = row0 + ai * HALF + m * 16; const float rs = rsv[ai][m];
#pragma unroll
                for (int bj = 0; bj < 2; ++bj) {
                    f32x4 v0 = acc[ai][bj][m][0] * rs + bv[bj][0], v1 = acc[ai][bj][m][1] * rs + bv[bj][1];
                    if (isy) { const f32x2 q0 = gelu_tanh2((f32x2){v0.x, v0.y}), q1 = gelu_tanh2((f32x2){v0.z, v0.w}), q2 = gelu_tanh2((f32x2){v1.x, v1.y}), q3 = gelu_tanh2((f32x2){v1.z, v1.w});
                               v0 = (f32x4){q0.x, q0.y, q1.x, q1.y}; v1 = (f32x4){q2.x, q2.y, q3.x, q3.y}; }
                    *(u32x4*)(O + (size_t)row * 1024 + oc0 + bj * HALF) = pack8(v0, v1);
                }
            }
    }
};

__device__ __forceinline__ void rope4(f32x4& a, f32x4& b, const f32x4 t0, const f32x4 t1) {
    const f32x4 x1 = a, x2 = b;
    a.x = x1.x * t0.x - x2.x * t0.y; b.x = x2.x * t0.x + x1.x * t0.y;
    a.y = x1.y * t0.z - x2.y * t0.w; b.y = x2.y * t0.z + x1.y * t0.w;
    a.z = x1.z * t1.x - x2.z * t1.y; b.z = x2.z * t1.x + x1.z * t1.y;
    a.w = x1.w * t1.z - x2.w * t1.w; b.w = x2.w * t1.z + x1.w * t1.w;
}
__device__ __forceinline__ f32x4 rot2(const f32x4 t, const f32x4 r) { return (f32x4){t.x * r.x - t.y * r.y, t.y * r.x + t.x * r.y, t.z * r.z - t.w * r.w, t.w * r.z + t.z * r.w}; }
struct EpiQkv {
    static constexpr bool PERM = true, AFTER_DRAIN = false; static constexpr int NDEF = 0;
    const float* SS; const float* CS; bf16_t* QKV; float* out; int j; PG8_LAS unsigned char* stage0;
    __device__ __forceinline__ void operator()(const f32x4 (&acc)[2][2][4][2], const Unit& u, int wr, int wc, int fr, int fq) const {
        const int g = u.pn / 12, which = (u.pn % 12) >> 2, hq = u.pn & 3, head = hq * 4 + wc, dd0 = 8 * fq; PG8_LAS unsigned char* stage = stage0 + (wr * 4 + wc) * 2304;
        const int colbase = g * 3072 + which * 1024 + head * 64 + dd0;
        const int Wg = 128 << (2 * g); const size_t kvo = (g == 0 ? (size_t)17186816 : (g == 1 ? (size_t)18759680 : (size_t)23478272)) + (size_t)j * 2 * Wg * 2048; float* kvp = out + kvo;
        const int row0 = u.pm * BM + wr * 64 + fr, pos0 = row0 & 8191, b = row0 >> 13;
        const bool rope = which < 2; const float qs = which == 0 ? 0.125f * 1.4426950408889634f : 1.0f;
        float rsv[2][4];
#pragma unroll
        for (int ai = 0; ai < 2; ++ai)
#pragma unroll
            for (int m = 0; m < 4; ++m) rsv[ai][m] = row_rs(SS, row0 + ai * HALF + m * 16) * qs;
        const f32x4 one4 = {1.f, 1.f, 1.f, 1.f}, zero4 = {0.f, 0.f, 0.f, 0.f};
        f32x4 rc[2], rsn[2];
#pragma unroll
        for (int n = 0; n < 2; ++n) { rc[n] = rope ? *(const f32x4*)(CS + (size_t)16 * 64 + dd0 + 4 * n) : one4; rsn[n] = rope ? *(const f32x4*)(CS + (size_t)16 * 64 + 32 + dd0 + 4 * n) : zero4; }
        f32x4 tcn = rope ? *(const f32x4*)(CS + (size_t)pos0 * 64 + dd0) : one4, tsn = rope ? *(const f32x4*)(CS + (size_t)pos0 * 64 + 32 + dd0) : zero4;
#pragma unroll
        for (int ai = 0; ai < 2; ++ai) {
            u32x2 keepA[4], keepB[4];
#pragma unroll
            for (int n = 0; n < 2; ++n) {
                f32x4 tc = tcn, ts = tsn;
                if (!(ai == 1 && n == 1)) { const int pn_ = pos0 + (n == 1 ? (ai + 1) * HALF : ai * HALF), nn_ = 4 * (1 - n);
                    tcn = rope ? *(const f32x4*)(CS + (size_t)pn_ * 64 + dd0 + nn_) : one4; tsn = rope ? *(const f32x4*)(CS + (size_t)pn_ * 64 + 32 + dd0 + nn_) : zero4; }
#pragma unroll
                for (int m = 0; m < 4; ++m) {
                    const int row = row0 + ai * HALF + m * 16, pos = pos0 + ai * HALF + m * 16; const float rs = rsv[ai][m];
                    const f32x4 x1 = acc[ai][0][m][n] * rs, x2 = acc[ai][1][m][n] * rs;
                    const f32x4 a0 = x1 * tc - x2 * ts, b0 = x2 * tc + x1 * ts;
                    if (m < 3) { const f32x4 c2 = tc * rc[n] - ts * rsn[n]; ts = ts * rc[n] + tc * rsn[n]; tc = c2; }
                    if (which >= 1 && pos >= 8192 - Wg) {
                        float* kp = kvp + ((size_t)(b * Wg + pos - (8192 - Wg)) * 2 + (which - 1)) * 1024 + head * 64 + dd0 + 4 * n;
                        *(f32x4*)kp = a0; *(f32x4*)(kp + 32) = b0;
                    }
                    u32x2 pa, pb; pa.x = cvt_pk_bf16(a0.x, a0.y); pa.y = cvt_pk_bf16(a0.z, a0.w); pb.x = cvt_pk_bf16(b0.x, b0.y); pb.y = cvt_pk_bf16(b0.z, b0.w);
                    if (n == 0) { keepA[m] = pa; keepB[m] = pb; }
                    else {
                        PG8_LAS unsigned char* st = stage + fr * 144 + 16 * fq;
                        *(PG8_LAS u32x4*)st = (u32x4){keepA[m].x, keepA[m].y, pa.x, pa.y}; *(PG8_LAS u32x4*)(st + 64) = (u32x4){keepB[m].x, keepB[m].y, pb.x, pb.y};
                        asm volatile("s_waitcnt lgkmcnt(0)" ::: "memory");
                        const int l8 = (fq * 16 + fr) & 7, lr = (fq * 16 + fr) >> 3;
                        const u32x4 v0 = *(const PG8_LAS u32x4*)(stage + lr * 144 + 16 * l8), v1 = *(const PG8_LAS u32x4*)(stage + (lr + 8) * 144 + 16 * l8);
                        const int p0_ = pos - fr + lr, p1_ = p0_ + 8; const size_t hb = ((size_t)((g * 3 + which) * 2 + b) * 16 + head) * 8192;
                        bf16_t* o0 = QKV + (hb + ((p0_ & ((1 << (2 * g)) - 1)) << (13 - 2 * g)) + (p0_ >> (2 * g))) * 64 + 8 * l8;
                        bf16_t* o1 = QKV + (hb + ((p1_ & ((1 << (2 * g)) - 1)) << (13 - 2 * g)) + (p1_ >> (2 * g))) * 64 + 8 * l8;
                        asm volatile("s_waitcnt lgkmcnt(0)" ::: "memory");
                        *(u32x4*)o0 = v0; *(u32x4*)o1 = v1;
                    }
                }
            }
        }
    }
};

template <class Epi, class Sched, bool ALIGN_EPI = false, bool SP2 = false>
__device__ __forceinline__ unsigned long long gemm_phase(PG8_LAS unsigned char* lds, const Gemm g, const Sched& S, const Epi& E, int tid_in) {
    unsigned long long ts0_ = 0, tsr_ = 0;
#define PG8_TS(k) do { if (TPROBE == (k)) ts0_ = __builtin_amdgcn_s_memrealtime(); } while (0)
#define PG8_TE(k) do { if (TPROBE == (k)) tsr_ += __builtin_amdgcn_s_memrealtime() - ts0_; } while (0)
    PG8_TS(30);
    int tid_ = tid_in; asm volatile("" : "+v"(tid_));
    const int tid = tid_, wid = __builtin_amdgcn_readfirstlane(tid >> 6), lane = tid & 63, wr = wid >> 2, wc = wid & 3, fr = lane & 15, fq = lane >> 4;
    const int K = g.K, nt = K / BK;
    unsigned voffA[2], voffB[2];
#pragma unroll
    for (int i = 0; i < 2; ++i) { int R, C; stage_rc(tid * 16 + i * 8192, R, C); const int Rb = Epi::PERM ? ((R & ~31) + perm32(R & 31)) : R;
        voffA[i] = (unsigned)(R * K + C) * 2u; voffB[i] = (unsigned)(Rb * K + C) * 2u; }
    const size_t kstep = (size_t)(BK * 2);
    const size_t hstep = (size_t)HALF * K * 2;
    const size_t tstep = 2 * hstep;
    const unsigned ldsw = (unsigned)wid * 1024u;
    const int aoff = lds_byte(wr * 64 + fr, fq * 8), boff = lds_byte(wc * 32 + fr, fq * 8);
#define PG8_SA(b, h) (((b) * 2 + (h)) * HTB)
#define PG8_SB(b, h) ((4 + (b) * 2 + (h)) * HTB)
#define PG8_STAGE(bufoff, gbase, voff) do { _Pragma("unroll") for (int _i = 0; _i < 2; ++_i) \
        __builtin_amdgcn_global_load_lds((const unsigned*)((const char*)(gbase) + (voff)[_i]), (PG8_LAS unsigned*)(lds + (bufoff) + ldsw + _i * 8192), 16, 0, 0); } while (0)
#define PG8_LDA(dst, b, h) do { _Pragma("unroll") for (int m = 0; m < 4; ++m) _Pragma("unroll") for (int k = 0; k < 2; ++k) dst[m][k] = *(const PG8_LAS bf16x8*)(lds + PG8_SA(b, h) + aoff + m * 2048 + k * 1024); } while (0)
#define PG8_LDB(dst, b, h) do { _Pragma("unroll") for (int n = 0; n < 2; ++n) _Pragma("unroll") for (int k = 0; k < 2; ++k) dst[n][k] = *(const PG8_LAS bf16x8*)(lds + PG8_SB(b, h) + boff + n * 2048 + k * 1024); } while (0)
#define PG8_MMA(ai, bj, At, Bt) do { __builtin_amdgcn_s_setprio(1); _Pragma("unroll") for (int m = 0; m < 4; ++m) _Pragma("unroll") for (int n = 0; n < 2; ++n) _Pragma("unroll") for (int k = 0; k < 2; ++k) \
        acc[ai][bj][m][n] = __builtin_amdgcn_mfma_f32_16x16x32_bf16(Bt[n][k], At[m][k], acc[ai][bj][m][n], 0, 0, 0); __builtin_amdgcn_s_setprio(0); } while (0)
#define PG8_WAIT_V(n) asm volatile("s_waitcnt vmcnt(" #n ")" ::: "memory")
#define PG8_WAIT_L(n) asm volatile("s_waitcnt lgkmcnt(" #n ")" ::: "memory")
#define PG8_BAR __builtin_amdgcn_s_barrier()
#define PG8_SCHED __builtin_amdgcn_sched_barrier(0)
    Unit cur, nxt; int ui = 0;
    if (!S.next(0, cur)) return 0;
    f32x4 acc[2][2][4][2];
#pragma unroll
    for (int a = 0; a < 2; ++a)
#pragma unroll
        for (int b = 0; b < 2; ++b)
#pragma unroll
            for (int m = 0; m < 4; ++m)
#pragma unroll
                for (int n = 0; n < 2; ++n) acc[a][b][m][n] = (f32x4){0.f, 0.f, 0.f, 0.f};
    bf16x8 At[4][2], B0[2][2], B1[2][2];
    const char* cA = (const char*)g.A + (size_t)cur.pm * tstep; const char* cB = (const char*)g.Bt + (size_t)cur.pn * tstep;
    S.a_ready(cur);
    if constexpr (SP2) {
        PG8_STAGE(PG8_SB(0, 0), cB, voffB); PG8_STAGE(PG8_SB(0, 1), cB + hstep, voffB); PG8_STAGE(PG8_SA(0, 0), cA, voffA); PG8_STAGE(PG8_SA(0, 1), cA + hstep, voffA);
        if (wr == 1) PG8_BAR;
        PG8_WAIT_V(2); PG8_BAR;
        PG8_STAGE(PG8_SB(1, 0), cB + kstep, voffB); PG8_STAGE(PG8_SA(1, 0), cA + kstep, voffA); PG8_STAGE(PG8_SB(1, 1), cB + hstep + kstep, voffB);
        PG8_WAIT_V(6); PG8_BAR;
    } else {
        PG8_STAGE(PG8_SB(0, 0), cB, voffB); PG8_STAGE(PG8_SA(0, 0), cA, voffA); PG8_STAGE(PG8_SB(0, 1), cB + hstep, voffB); PG8_STAGE(PG8_SA(0, 1), cA + hstep, voffA);
        if (wr == 1) PG8_BAR;
        PG8_WAIT_V(4); PG8_BAR;
        PG8_STAGE(PG8_SB(1, 0), cB + kstep, voffB); PG8_STAGE(PG8_SA(1, 0), cA + kstep, voffA); PG8_STAGE(PG8_SB(1, 1), cB + hstep + kstep, voffB);
        PG8_WAIT_V(6); PG8_BAR;
    }
    PG8_TE(30); PG8_TS(31);
    for (;;) {
        const bool has_next = S.next(ui + 1, nxt);
        const char* nA = has_next ? (const char*)g.A + (size_t)nxt.pm * tstep : cA; const char* nB = has_next ? (const char*)g.Bt + (size_t)nxt.pn * tstep : cB;
        for (int t = 0; t < nt; t += 2) {
            const bool last = (t == nt - 2);
            const char* a1 = cA + (size_t)(t + 1) * kstep;
            const char* a2 = last ? nA : cA + (size_t)(t + 2) * kstep; const char* b2 = last ? nB : cB + (size_t)(t + 2) * kstep;
            const char* a3 = a2 + kstep; const char* b3 = b2 + kstep;
            if (last && has_next) S.a_ready(nxt);
            if constexpr (SP2) {
            PG8_LDB(B0, 0, 0); PG8_LDB(B1, 0, 1); PG8_SCHED; PG8_LDA(At, 0, 0); PG8_STAGE(PG8_SA(1, 1), a1 + hstep, voffA);
            PG8_WAIT_V(8); PG8_WAIT_L(0); PG8_BAR; PG8_MMA(0, 0, At, B0); PG8_MMA(0, 1, At, B1); PG8_BAR; PG8_SCHED;
            PG8_LDA(At, 0, 1); PG8_STAGE(PG8_SB(0, 0), b2, voffB); PG8_STAGE(PG8_SB(0, 1), b2 + hstep, voffB); PG8_STAGE(PG8_SA(0, 0), a2, voffA);
            PG8_WAIT_V(8); PG8_WAIT_L(0); PG8_BAR; PG8_MMA(1, 0, At, B0); PG8_MMA(1, 1, At, B1); PG8_BAR; PG8_SCHED;
            PG8_LDB(B0, 1, 0); PG8_LDB(B1, 1, 1); PG8_SCHED; PG8_LDA(At, 1, 0); PG8_STAGE(PG8_SA(0, 1), a2 + hstep, voffA);
            PG8_WAIT_V(8); PG8_WAIT_L(0); PG8_BAR; PG8_MMA(0, 0, At, B0); PG8_MMA(0, 1, At, B1); PG8_BAR; PG8_SCHED;
            PG8_LDA(At, 1, 1); PG8_STAGE(PG8_SB(1, 0), b3, voffB); PG8_STAGE(PG8_SB(1, 1), b3 + hstep, voffB); PG8_STAGE(PG8_SA(1, 0), a3, voffA);
            PG8_WAIT_V(8); PG8_WAIT_L(0); PG8_BAR; PG8_MMA(1, 0, At, B0); PG8_MMA(1, 1, At, B1); PG8_BAR; PG8_SCHED;
            } else {
            PG8_LDB(B0, 0, 0); PG8_SCHED; PG8_LDA(At, 0, 0); PG8_STAGE(PG8_SA(1, 1), a1 + hstep, voffA);
            PG8_WAIT_L(8); PG8_BAR; PG8_WAIT_L(0); PG8_MMA(0, 0, At, B0); PG8_BAR; PG8_SCHED;
            PG8_LDB(B1, 0, 1); PG8_STAGE(PG8_SB(0, 0), b2, voffB);
            PG8_BAR; PG8_WAIT_L(0); PG8_MMA(0, 1, At, B1); PG8_BAR;
            PG8_LDA(At, 0, 1); PG8_STAGE(PG8_SA(0, 0), a2, voffA);
            PG8_BAR; PG8_WAIT_L(0); PG8_MMA(1, 0, At, B0); PG8_BAR; PG8_SCHED;
            PG8_STAGE(PG8_SB(0, 1), b2 + hstep, voffB);
            PG8_WAIT_V(6); PG8_BAR; PG8_MMA(1, 1, At, B1); PG8_BAR;
            PG8_LDB(B0, 1, 0); PG8_SCHED; PG8_LDA(At, 1, 0); PG8_STAGE(PG8_SA(0, 1), a2 + hstep, voffA);
            PG8_WAIT_L(8); PG8_BAR; PG8_WAIT_L(0); PG8_MMA(0, 0, At, B0); PG8_BAR; PG8_SCHED;
            PG8_LDB(B1, 1, 1); PG8_STAGE(PG8_SB(1, 0), b3, voffB);
            PG8_BAR; PG8_WAIT_L(0); PG8_MMA(0, 1, At, B1); PG8_BAR;
            PG8_LDA(At, 1, 1); PG8_STAGE(PG8_SA(1, 0), a3, voffA);
            PG8_BAR; PG8_WAIT_L(0); PG8_MMA(1, 0, At, B0); PG8_BAR; PG8_SCHED;
            PG8_STAGE(PG8_SB(1, 1), b3 + hstep, voffB);
            PG8_WAIT_V(6); PG8_BAR; PG8_MMA(1, 1, At, B1); PG8_BAR;
            }
        }
        if constexpr (ALIGN_EPI) { if (wr == 0) PG8_BAR; }
        if constexpr (!Epi::AFTER_DRAIN) { unsigned long long te0_ = 0; if (TPROBE == 34) te0_ = __builtin_amdgcn_s_memrealtime(); E(acc, cur, wr, wc, fr, fq); S.done(cur); if (TPROBE == 34) tsr_ += __builtin_amdgcn_s_memrealtime() - te0_; }
        if (!has_next) break;
#pragma unroll
        for (int a = 0; a < 2; ++a)
#pragma unroll
            for (int b = 0; b < 2; ++b)
#pragma unroll
                for (int m = 0; m < 4; ++m)
#pragma unroll
                    for (int n = 0; n < 2; ++n) acc[a][b][m][n] = (f32x4){0.f, 0.f, 0.f, 0.f};
        cur = nxt; cA = nA; cB = nB; ++ui;
        if constexpr (ALIGN_EPI) { if (wr == 1) PG8_BAR; }
    }
    PG8_TE(31); PG8_TS(32);
    PG8_WAIT_V(0);
    if constexpr (!ALIGN_EPI) { if (wr == 0) PG8_BAR; }
    PG8_BAR;
    PG8_TE(32); PG8_TS(33);
    if constexpr (Epi::AFTER_DRAIN) { E.fused(acc, cur, wr, wc, fr, fq, lds, wid, lane); S.done(cur); }
    PG8_TE(33);
#undef PG8_SA
#undef PG8_SB
#undef PG8_STAGE
#undef PG8_LDA
#undef PG8_LDB
#undef PG8_MMA
#undef PG8_WAIT_V
#undef PG8_WAIT_L
#undef PG8_BAR
#undef PG8_SCHED
#undef PG8_TS
#undef PG8_TE
    return tsr_;
}
}

#define XB_TMO      128
#define XB_XCNT(j)  (256  + 64 * (j))
#define XB_XSUB(j)  (1280 + 64 * (j))
#define XB_XGEN(j)  (2304 + 64 * (j))
#define XB_TOP      3328
#define XB_TOPGEN   3392
#define XCD_BAR_WORDS 3456
#define XB_SPIN_CAP (1u << 18)

__device__ __forceinline__ unsigned xb_ld(unsigned* p)              { return __hip_atomic_load(p, __ATOMIC_RELAXED, __HIP_MEMORY_SCOPE_AGENT); }
__device__ __forceinline__ unsigned xb_add(unsigned* p, unsigned v) { return __hip_atomic_fetch_add(p, v, __ATOMIC_RELAXED, __HIP_MEMORY_SCOPE_AGENT); }
__device__ __forceinline__ unsigned xb_xcc_id() { return (unsigned)__builtin_amdgcn_s_getreg((3 << 11) | 20) & 0xFu; }
#define XB_SPIN(cond, bar) do { unsigned _sp = 0; while (cond) { __builtin_amdgcn_s_sleep(1); \
    if ((++_sp & 255u) == 0u) { if (xb_ld(&(bar)[XB_TMO])) break; if (_sp > XB_SPIN_CAP) { atomicAdd(&(bar)[XB_TMO], 1u); break; } } } } while (0)

struct XcdBarrier {
    unsigned* bar; unsigned x; bool lead;
    volatile LAS unsigned* st;
};

__device__ __forceinline__ XcdBarrier xcd_barrier_post(unsigned* bar, volatile LAS unsigned* st) {
    XcdBarrier b; b.bar = bar; b.x = xb_xcc_id(); b.st = st; b.lead = threadIdx.x == 0;
    if (threadIdx.x == 0) (void)xb_add(&bar[XB_XCNT(b.x)], 1u);
    return b;
}
__device__ __forceinline__ void xcd_barrier_complete(unsigned* bar, unsigned x, unsigned& nloc, unsigned& nx) {
    const unsigned G = gridDim.x * gridDim.y * gridDim.z;
    unsigned sum, cnt, mine, sp = 0u;
    for (;;) {
        sum = 0u; cnt = 0u; mine = 0u;
#pragma unroll
        for (unsigned j = 0; j < 16; ++j) { const unsigned c = xb_ld(&bar[XB_XCNT(j)]); sum += c; cnt += (c > 0u) ? 1u : 0u; mine = (j == x) ? c : mine; }
        if (sum == G) break;
        __builtin_amdgcn_s_sleep(1);
        if ((++sp & 255u) == 0u) { if (xb_ld(&bar[XB_TMO])) break; if (sp > XB_SPIN_CAP) { atomicAdd(&bar[XB_TMO], 1u); break; } }
    }
    nloc = mine > 0u ? mine : 1u; nx = cnt > 0u ? cnt : 1u;
}

__device__ __forceinline__ void xcd_barrier(const XcdBarrier& b) {
    asm volatile("s_waitcnt vmcnt(0)" ::: "memory");
    __syncthreads();
    if (b.lead) {
        unsigned* bar = b.bar;
        __builtin_amdgcn_s_waitcnt(0);
        unsigned nloc = b.st[0], nx = b.st[1];
        if (nloc == 0u) { xcd_barrier_complete(bar, b.x, nloc, nx); b.st[0] = nloc; b.st[1] = nx; }
        const unsigned old = xb_add(&bar[XB_XSUB(b.x)], 1u);
        const unsigned gen = old / nloc;
        if (old + 1u == (gen + 1u) * nloc) {
            __builtin_amdgcn_fence(__ATOMIC_RELEASE, "agent");
            asm volatile("s_waitcnt vmcnt(0)" ::: "memory");
            const unsigned og = xb_add(&bar[XB_TOP], 1u);
            const unsigned tg = og / nx;
            if (og + 1u == (tg + 1u) * nx) xb_add(&bar[XB_TOPGEN], 1u);
            else XB_SPIN(xb_ld(&bar[XB_TOPGEN]) == tg, bar);
            __builtin_amdgcn_fence(__ATOMIC_ACQUIRE, "agent");
            xb_add(&bar[XB_XGEN(b.x)], 1u);
            asm volatile("s_waitcnt vmcnt(0)" ::: "memory");
        } else {
            XB_SPIN(xb_ld(&bar[XB_XGEN(b.x)]) == gen, bar);
            __builtin_amdgcn_fence(__ATOMIC_ACQUIRE, "agent");
            asm volatile("s_waitcnt vmcnt(0)" ::: "memory");
        }
    }
    __syncthreads();
}

constexpr int D = 1024, DFF = 2816, NUP = 5632, SEQ = 8192, NBATCH = 2, MP = NBATCH * SEQ, NSQ = 32, TS = 4, MS = NSQ * TS, MT = MP + MS;
constexpr int NQKV = 9216, NH = 16, HD = 64, DEPTH = 4;
constexpr int NWAVES = 8, NTHR = NWAVES * 64;
typedef unsigned short bf16;
typedef float f32x4 __attribute__((ext_vector_type(4)));
typedef unsigned v4u __attribute__((ext_vector_type(4)));
typedef unsigned v2u __attribute__((ext_vector_type(2)));
typedef short bf16x8 __attribute__((ext_vector_type(8)));
#define LDS_WAIT() asm volatile("s_waitcnt lgkmcnt(0)" ::: "memory")

enum { I_XP = 0, I_XS, I_STH, I_STC, I_C128, I_C512, I_C2048, I_NF1, I_NMIX, I_NF2, I_WU1, I_WD1, I_WU2, I_WD2, I_WRIN, I_BRIN, I_WCONV, I_BCONV,
       I_WGA, I_BGA, I_WGX, I_BGX, I_LAM, I_WROUT, I_BROUT, I_WQKV, I_WO, I_NFIN, N_IN };
constexpr size_t O_Y = 0, O_HP = (size_t)MT * D, O_HS = O_HP + 2 * 2 * 1024, O_CP = O_HS + 2 * 32 * 1024, O_CS = O_CP + 2 * 2 * 3 * 1024, O_KV128P = O_CS + 2 * 32 * 3 * 1024,
    O_KV128S = O_KV128P + (size_t)2 * 2 * 128 * 2048, O_KV512P = O_KV128S + (size_t)2 * 32 * 4 * 2048, O_KV512S = O_KV512P + (size_t)2 * 2 * 512 * 2048,
    O_KV2048P = O_KV512S + (size_t)2 * 32 * 4 * 2048, O_KV2048S = O_KV2048P + (size_t)2 * 2 * 2048 * 2048, O_END = O_KV2048S + (size_t)2 * 32 * 4 * 2048;
static_assert(O_END == 40779776, "output size");

constexpr size_t MiB = 1u << 20;
constexpr size_t WS_CTL = 0, CTL_ZERO_BYTES = 1 * MiB;
constexpr size_t WS_CS = 1 * MiB;
constexpr size_t WS_SS = 4 * MiB;
constexpr size_t WS_SSS = 4 * MiB + 512 * 1024;
constexpr size_t WS_CARRY = 5 * MiB;
constexpr size_t WS_LSE = 6 * MiB;
constexpr size_t WS_W = 16 * MiB;
constexpr size_t SZ_WUP = (size_t)NUP * D * 2, SZ_WDN = (size_t)D * DFF * 2, SZ_WRIN = (size_t)2048 * D * 2, SZ_WSQ = (size_t)D * D * 2, SZ_WQKV = (size_t)NQKV * D * 2, SZ_WG = (size_t)8 * 128 * 128 * 2;
constexpr size_t WS_WUP = WS_W, WS_WDN = WS_WUP + 8 * SZ_WUP, WS_WRIN = WS_WDN + 8 * SZ_WDN, WS_WROUT = WS_WRIN + 2 * SZ_WRIN, WS_WQKV = WS_WROUT + 2 * SZ_WSQ, WS_WO = WS_WQKV + 2 * SZ_WQKV,
    WS_WG = WS_WO + 2 * SZ_WSQ, WS_WEND = WS_WG + 4 * SZ_WG;
static_assert(WS_WEND <= 208 * MiB, "weights");
constexpr int MTP = MP + 256;
constexpr size_t WS_XB = 273 * MiB;
constexpr size_t WS_HID = 306 * MiB;
constexpr size_t WS_YB = 396 * MiB, WS_XBR = 429 * MiB, WS_AOP = 462 * MiB;
constexpr size_t WS_QKV = 495 * MiB;
constexpr size_t WS_OG = 786 * MiB;
constexpr size_t WS_END = 884 * MiB;
static_assert(WS_WEND <= WS_XB && WS_XB + (size_t)MTP * D * 2 <= WS_HID && WS_HID + (size_t)MTP * DFF * 2 <= WS_YB && WS_YB + (size_t)MT * D * 2 <= WS_XBR && WS_XBR + (size_t)MT * D * 2 <= WS_AOP &&
              WS_AOP + (size_t)MT * D * 2 <= WS_QKV && WS_QKV + (size_t)MT * NQKV * 2 <= WS_OG && WS_OG + (size_t)3 * MT * D * 2 <= WS_END, "ws map");
constexpr int CW_BAR = 4096;
constexpr int LDS_BYTES = 155648, RING_BYTES = 131072, MISC_OFF = RING_BYTES + 320, RS_OFF = RING_BYTES + 1024, EPI_STAGE_OFF = RING_BYTES + 2048;

__device__ __forceinline__ unsigned f2bf(float f) { unsigned u = __builtin_bit_cast(unsigned, f); return (u + 0x7fffu + ((u >> 16) & 1u)) >> 16; }
__device__ __forceinline__ unsigned pk2(float lo, float hi) { return pg8::cvt_pk_bf16(lo, hi); }
__device__ __forceinline__ float bf2f(bf16 v) { return __builtin_bit_cast(float, (unsigned)v << 16); }
__device__ __forceinline__ float bflo(unsigned u) { return __builtin_bit_cast(float, u << 16); }
__device__ __forceinline__ float bfhi(unsigned u) { return __builtin_bit_cast(float, u & 0xffff0000u); }

struct Params { const float* in[N_IN]; float* out; unsigned char* ws; };

#define GAS __attribute__((address_space(1)))
struct Frame {
    LAS unsigned char* lds;
    int tid, lane, wave, wg, G;
    GAS float* out_g; GAS unsigned char* ws_g;
    __device__ __forceinline__ const float* in(int i) const { const __attribute__((address_space(4))) Params* kp = (const __attribute__((address_space(4))) Params*)__builtin_amdgcn_kernarg_segment_ptr(); asm volatile("" : "+s"(kp)); return (const float*)(const GAS float*)kp->in[i]; }
    __device__ __forceinline__ float* outp() const { return (float*)out_g; }
    template <class T> __device__ __forceinline__ T* W(size_t off) const { return (T*)(GAS T*)(ws_g + off); }
};
__device__ __forceinline__ int lane_now() { int l; asm volatile("v_mbcnt_lo_u32_b32 %0, -1, 0\n\tv_mbcnt_hi_u32_b32 %0, -1, %0" : "=v"(l)); return l; }
__device__ __forceinline__ Frame phase_frame(const Frame& F0) {
    Frame F = F0; int wv = F0.wave; asm volatile("" : "+s"(wv));
    int t = wv * 64 + lane_now(); F.tid = t; F.lane = t & 63; F.wave = wv;
    asm volatile("" : "+s"(F.ws_g), "+s"(F.out_g)); return F;
}
__device__ __forceinline__ void tr_item64(const float* W, int K, int N, int k0, int ns0, int sstride, bf16* WT, int nd0, const float* gain, LAS unsigned* scr, int lane) {
    const int kk = lane >> 4, nn = lane & 15; const float* src = W + (size_t)(k0 + 16 * kk) * N + ns0 + (nn >> 3) * sstride + 4 * (nn & 7);
    f32x4 v[16];
#pragma unroll
    for (int i = 0; i < 16; ++i) v[i] = *(const f32x4*)(src + (size_t)i * N);
    if (gain) {
#pragma unroll
        for (int i = 0; i < 16; ++i) v[i] *= gain[k0 + 16 * kk + i]; }
#pragma unroll
    for (int e = 0; e < 4; ++e) { v4u lo, hi;
        lo.x = pk2(v[0][e], v[1][e]); lo.y = pk2(v[2][e], v[3][e]); lo.z = pk2(v[4][e], v[5][e]); lo.w = pk2(v[6][e], v[7][e]);
        hi.x = pk2(v[8][e], v[9][e]); hi.y = pk2(v[10][e], v[11][e]); hi.z = pk2(v[12][e], v[13][e]); hi.w = pk2(v[14][e], v[15][e]);
        LAS v4u* d = (LAS v4u*)(scr + (4 * nn + e) * 36 + 8 * kk); d[0] = lo; d[1] = hi; }
    LDS_WAIT(); asm volatile("" ::: "memory");
    const int c = lane & 7, ns = lane >> 3;
#pragma unroll
    for (int q = 0; q < 8; ++q) { const int n = 8 * q + ns; const v4u o = *(const LAS v4u*)(scr + n * 36 + 4 * c); *(v4u*)(WT + (size_t)(nd0 + n) * K + k0 + 8 * c) = o; }
    LDS_WAIT(); asm volatile("" ::: "memory");
}
__device__ __forceinline__ void cs_entry(int pos, int i, float& c, float& s) {
    const float inv = exp2f(-(float)i * (13.287712379549449f / 32.0f));
    const float angf = (float)pos * inv; const double a = (double)angf;
    const double q = rint(a * 0.63661977236758134308); const double y = (a - q * 1.57079632679489655800) - q * 6.123233995736766e-17;
    const double y2 = y * y;
    const double sn = y * (1.0 + y2 * (-1.0 / 6 + y2 * (1.0 / 120 + y2 * (-1.0 / 5040 + y2 * (1.0 / 362880 + y2 * (-1.0 / 39916800 + y2 * (1.0 / 6227020800.0)))))));
    const double cn = 1.0 + y2 * (-0.5 + y2 * (1.0 / 24 + y2 * (-1.0 / 720 + y2 * (1.0 / 40320 + y2 * (-1.0 / 3628800 + y2 * (1.0 / 479001600.0 + y2 * (-1.0 / 87178291200.0)))))));
    const int qi = (int)((long long)q & 3);
    double cc, ss;
    if (qi == 0) { cc = cn; ss = sn; } else if (qi == 1) { cc = -sn; ss = cn; } else if (qi == 2) { cc = -cn; ss = -sn; } else { cc = sn; ss = -cn; }
    c = (float)cc; s = (float)ss;
}
using pg8::shfl_at; using pg8::shx;
__device__ __forceinline__ float wave_sum(float v, int lane) {
#pragma unroll
    for (int o = 1; o < 64; o <<= 1) v += shx(v, lane, o);
    return v;
}
constexpr int CV_PRO = 2112, CV_TOTAL = 23680;
__device__ __forceinline__ int cv_bound(int k) { return k <= 0 ? 2112 : k <= 1 ? 5362 : k <= 2 ? 8612 : k <= 3 ? 11862 : k <= 4 ? 14816 : k <= 5 ? 17770 : k <= 6 ? 20724 : 23680; }
__device__ __forceinline__ void cv_item(const Frame& F, int it, LAS unsigned* scr, int lane) {
    int r = it;
    if (r < 1408) { const int kb = r / 88, nb = r % 88, n0 = 64 * nb, pn = n0 >> 8, bj = (n0 >> 7) & 1, j0 = n0 & 127, ns0 = bj * DFF + 128 * pn + j0;
        tr_item64(F.in(I_WU1) + (size_t)0 * D * NUP, D, NUP, 64 * kb, ns0, 32, F.W<bf16>(WS_WUP + (size_t)0 * SZ_WUP), n0, F.in(I_NF1) + 0 * D, scr, lane); return; } r -= 1408;
    if (r < 704) { const int kb = r / 16, nb = r % 16;
        tr_item64(F.in(I_WD1) + (size_t)0 * DFF * D, DFF, D, 64 * kb, 64 * nb, 32, F.W<bf16>(WS_WDN + (size_t)0 * SZ_WDN), 64 * nb, nullptr, scr, lane); return; } r -= 704;
    if (r < 512) { const int kb = r / 32, nb = r % 32;
        tr_item64(F.in(I_WRIN) + (size_t)0 * D * 2048, D, 2048, 64 * kb, 64 * nb, 32, F.W<bf16>(WS_WRIN + (size_t)0 * SZ_WRIN), 64 * nb, F.in(I_NMIX) + 0 * D, scr, lane); return; } r -= 512;
    if (r < 64) { const int mb16 = r >> 2, q = r & 3, kb = q >> 1, nb = q & 1, ax = mb16 >> 3, blk = mb16 & 7, mb = (0 * 2 + ax) * 8 + blk;
        tr_item64(F.in(ax ? I_WGX : I_WGA) + (size_t)(0 * 8 + blk) * 16384, 128, 128, 64 * kb, 64 * nb, 32, F.W<bf16>(WS_WG + (size_t)mb * 32768), 64 * nb, nullptr, scr, lane); return; } r -= 64;
    if (r < 256) { const int kb = r / 16, nb = r % 16;
        tr_item64(F.in(I_WROUT) + (size_t)0 * D * D, D, D, 64 * kb, 64 * nb, 32, F.W<bf16>(WS_WROUT + (size_t)0 * SZ_WSQ), 64 * nb, nullptr, scr, lane); return; } r -= 256;
    if (r < 1408) { const int kb = r / 88, nb = r % 88, n0 = 64 * nb, pn = n0 >> 8, bj = (n0 >> 7) & 1, j0 = n0 & 127, ns0 = bj * DFF + 128 * pn + j0;
        tr_item64(F.in(I_WU2) + (size_t)0 * D * NUP, D, NUP, 64 * kb, ns0, 32, F.W<bf16>(WS_WUP + (size_t)1 * SZ_WUP), n0, F.in(I_NF2) + 0 * D, scr, lane); return; } r -= 1408;
    if (r < 704) { const int kb = r / 16, nb = r % 16;
        tr_item64(F.in(I_WD2) + (size_t)0 * DFF * D, DFF, D, 64 * kb, 64 * nb, 32, F.W<bf16>(WS_WDN + (size_t)1 * SZ_WDN), 64 * nb, nullptr, scr, lane); return; } r -= 704;
    if (r < 1408) { const int kb = r / 88, nb = r % 88, n0 = 64 * nb, pn = n0 >> 8, bj = (n0 >> 7) & 1, j0 = n0 & 127, ns0 = bj * DFF + 128 * pn + j0;
        tr_item64(F.in(I_WU1) + (size_t)1 * D * NUP, D, NUP, 64 * kb, ns0, 32, F.W<bf16>(WS_WUP + (size_t)2 * SZ_WUP), n0, F.in(I_NF1) + 1 * D, scr, lane); return; } r -= 1408;
    if (r < 704) { const int kb = r / 16, nb = r % 16;
        tr_item64(F.in(I_WD1) + (size_t)1 * DFF * D, DFF, D, 64 * kb, 64 * nb, 32, F.W<bf16>(WS_WDN + (size_t)2 * SZ_WDN), 64 * nb, nullptr, scr, lane); return; } r -= 704;
    if (r < 2304) { const int kb = r / 144, nb = r % 144, n0 = 64 * nb, pn = n0 >> 8, bj = (n0 >> 7) & 1, hh = (n0 >> 5) & 3, g = pn / 12, which = (pn % 12) >> 2, hq = pn & 3, ns0 = g * 3072 + which * 1024 + (4 * hq + hh) * 64 + 32 * bj;
        tr_item64(F.in(I_WQKV) + (size_t)0 * D * NQKV, D, NQKV, 64 * kb, ns0, 64, F.W<bf16>(WS_WQKV + (size_t)0 * SZ_WQKV), n0, F.in(I_NMIX) + 1 * D, scr, lane); return; } r -= 2304;
    if (r < 256) { const int kb = r / 16, nb = r % 16;
        tr_item64(F.in(I_WO) + (size_t)0 * D * D, D, D, 64 * kb, 64 * nb, 32, F.W<bf16>(WS_WO + (size_t)0 * SZ_WSQ), 64 * nb, nullptr, scr, lane); return; } r -= 256;
    if (r < 1408) { const int kb = r / 88, nb = r % 88, n0 = 64 * nb, pn = n0 >> 8, bj = (n0 >> 7) & 1, j0 = n0 & 127, ns0 = bj * DFF + 128 * pn + j0;
        tr_item64(F.in(I_WU2) + (size_t)1 * D * NUP, D, NUP, 64 * kb, ns0, 32, F.W<bf16>(WS_WUP + (size_t)3 * SZ_WUP), n0, F.in(I_NF2) + 1 * D, scr, lane); return; } r -= 1408;
    if (r < 704) { const int kb = r / 16, nb = r % 16;
        tr_item64(F.in(I_WD2) + (size_t)1 * DFF * D, DFF, D, 64 * kb, 64 * nb, 32, F.W<bf16>(WS_WDN + (size_t)3 * SZ_WDN), 64 * nb, nullptr, scr, lane); return; } r -= 704;
    if (r < 1408) { const int kb = r / 88, nb = r % 88, n0 = 64 * nb, pn = n0 >> 8, bj = (n0 >> 7) & 1, j0 = n0 & 127, ns0 = bj * DFF + 128 * pn + j0;
        tr_item64(F.in(I_WU1) + (size_t)2 * D * NUP, D, NUP, 64 * kb, ns0, 32, F.W<bf16>(WS_WUP + (size_t)4 * SZ_WUP), n0, F.in(I_NF1) + 2 * D, scr, lane); return; } r -= 1408;
    if (r < 704) { const int kb = r / 16, nb = r % 16;
        tr_item64(F.in(I_WD1) + (size_t)2 * DFF * D, DFF, D, 64 * kb, 64 * nb, 32, F.W<bf16>(WS_WDN + (size_t)4 * SZ_WDN), 64 * nb, nullptr, scr, lane); return; } r -= 704;
    if (r < 512) { const int kb = r / 32, nb = r % 32;
        tr_item64(F.in(I_WRIN) + (size_t)1 * D * 2048, D, 2048, 64 * kb, 64 * nb, 32, F.W<bf16>(WS_WRIN + (size_t)1 * SZ_WRIN), 64 * nb, F.in(I_NMIX) + 2 * D, scr, lane); return; } r -= 512;
    if (r < 64) { const int mb16 = r >> 2, q = r & 3, kb = q >> 1, nb = q & 1, ax = mb16 >> 3, blk = mb16 & 7, mb = (1 * 2 + ax) * 8 + blk;
        tr_item64(F.in(ax ? I_WGX : I_WGA) + (size_t)(1 * 8 + blk) * 16384, 128, 128, 64 * kb, 64 * nb, 32, F.W<bf16>(WS_WG + (size_t)mb * 32768), 64 * nb, nullptr, scr, lane); return; } r -= 64;
    if (r < 256) { const int kb = r / 16, nb = r % 16;
        tr_item64(F.in(I_WROUT) + (size_t)1 * D * D, D, D, 64 * kb, 64 * nb, 32, F.W<bf16>(WS_WROUT + (size_t)1 * SZ_WSQ), 64 * nb, nullptr, scr, lane); return; } r -= 256;
    if (r < 1408) { const int kb = r / 88, nb = r % 88, n0 = 64 * nb, pn = n0 >> 8, bj = (n0 >> 7) & 1, j0 = n0 & 127, ns0 = bj * DFF + 128 * pn + j0;
        tr_item64(F.in(I_WU2) + (size_t)2 * D * NUP, D, NUP, 64 * kb, ns0, 32, F.W<bf16>(WS_WUP + (size_t)5 * SZ_WUP), n0, F.in(I_NF2) + 2 * D, scr, lane); return; } r -= 1408;
    if (r < 704) { const int kb = r / 16, nb = r % 16;
        tr_item64(F.in(I_WD2) + (size_t)2 * DFF * D, DFF, D, 64 * kb, 64 * nb, 32, F.W<bf16>(WS_WDN + (size_t)5 * SZ_WDN), 64 * nb, nullptr, scr, lane); return; } r -= 704;
    if (r < 1408) { const int kb = r / 88, nb = r % 88, n0 = 64 * nb, pn = n0 >> 8, bj = (n0 >> 7) & 1, j0 = n0 & 127, ns0 = bj * DFF + 128 * pn + j0;
        tr_item64(F.in(I_WU1) + (size_t)3 * D * NUP, D, NUP, 64 * kb, ns0, 32, F.W<bf16>(WS_WUP + (size_t)6 * SZ_WUP), n0, F.in(I_NF1) + 3 * D, scr, lane); return; } r -= 1408;
    if (r < 704) { const int kb = r / 16, nb = r % 16;
        tr_item64(F.in(I_WD1) + (size_t)3 * DFF * D, DFF, D, 64 * kb, 64 * nb, 32, F.W<bf16>(WS_WDN + (size_t)6 * SZ_WDN), 64 * nb, nullptr, scr, lane); return; } r -= 704;
    if (r < 2304) { const int kb = r / 144, nb = r % 144, n0 = 64 * nb, pn = n0 >> 8, bj = (n0 >> 7) & 1, hh = (n0 >> 5) & 3, g = pn / 12, which = (pn % 12) >> 2, hq = pn & 3, ns0 = g * 3072 + which * 1024 + (4 * hq + hh) * 64 + 32 * bj;
        tr_item64(F.in(I_WQKV) + (size_t)1 * D * NQKV, D, NQKV, 64 * kb, ns0, 64, F.W<bf16>(WS_WQKV + (size_t)1 * SZ_WQKV), n0, F.in(I_NMIX) + 3 * D, scr, lane); return; } r -= 2304;
    if (r < 256) { const int kb = r / 16, nb = r % 16;
        tr_item64(F.in(I_WO) + (size_t)1 * D * D, D, D, 64 * kb, 64 * nb, 32, F.W<bf16>(WS_WO + (size_t)1 * SZ_WSQ), 64 * nb, nullptr, scr, lane); return; } r -= 256;
    if (r < 1408) { const int kb = r / 88, nb = r % 88, n0 = 64 * nb, pn = n0 >> 8, bj = (n0 >> 7) & 1, j0 = n0 & 127, ns0 = bj * DFF + 128 * pn + j0;
        tr_item64(F.in(I_WU2) + (size_t)3 * D * NUP, D, NUP, 64 * kb, ns0, 32, F.W<bf16>(WS_WUP + (size_t)7 * SZ_WUP), n0, F.in(I_NF2) + 3 * D, scr, lane); return; } r -= 1408;
    if (r < 704) { const int kb = r / 16, nb = r % 16;
        tr_item64(F.in(I_WD2) + (size_t)3 * DFF * D, DFF, D, 64 * kb, 64 * nb, 32, F.W<bf16>(WS_WDN + (size_t)7 * SZ_WDN), 64 * nb, nullptr, scr, lane); return; } r -= 704;
}
__device__ __forceinline__ void ph_prologue(const Frame& F0) { const Frame F = phase_frame(F0);
    LAS unsigned* scr = (LAS unsigned*)(F.lds + F.wave * 16384);
    const int gw = F.wg * NWAVES + F.wave, NGW = F.G * NWAVES, lane = F.lane;
    for (int it = gw; it < CV_PRO; it += NGW) cv_item(F, it, scr, lane);
    { float* CS = F.W<float>(WS_CS); const int gt = F.wg * NTHR + F.tid, NGT = F.G * NTHR;
      for (int e = gt; e < 8196 * 32; e += NGT) { float c, s; cs_entry(e >> 5, e & 31, c, s); CS[(size_t)(e >> 5) * 64 + (e & 31)] = c; CS[(size_t)(e >> 5) * 64 + 32 + (e & 31)] = s; } }
    { bf16* Xb = F.W<bf16>(WS_XB); float* SS = F.W<float>(WS_SS); float* SSS = F.W<float>(WS_SSS);
      for (int m0 = gw; m0 < MT; m0 += 4 * NGW) {
          f32x4 v[4][4];
#pragma unroll
          for (int q = 0; q < 4; ++q) { const int m = m0 + q * NGW; if (m < MT) { const float* src = m < MP ? F.in(I_XP) + (size_t)m * D : F.in(I_XS) + (size_t)(m - MP) * D;
#pragma unroll
              for (int j = 0; j < 4; ++j) v[q][j] = *((const f32x4*)src + lane + 64 * j); } }
#pragma unroll
          for (int q = 0; q < 4; ++q) { const int m = m0 + q * NGW; if (m < MT) { float s = 0.f;
#pragma unroll
              for (int j = 0; j < 4; ++j) { const f32x4 x = v[q][j]; v2u w; w.x = pk2(x.x, x.y); w.y = pk2(x.z, x.w); *((v2u*)(Xb + (size_t)m * D) + lane + 64 * j) = w; s += (x.x * x.x + x.y * x.y) + (x.z * x.z + x.w * x.w); }
              s = wave_sum(s, lane);
              if (m < MP) { if (lane < 4) SS[(size_t)m * 4 + lane] = lane == 0 ? s : 0.f; }
              else { if (lane < 32) SSS[(size_t)(m - MP) * 32 + lane] = lane == 0 ? s : 0.f; } } }
      } }
}

template <int RT, bool PAIR128, int K, class Epi>
__device__ __forceinline__ void sample_gemm(const Frame& F, const bf16* A, const bf16* Bt, int ncg, const Epi& epi) {
    __syncthreads();
    LAS f32x4* red = (LAS f32x4*)F.lds;
    const int lane = F.lane, fr = lane & 15, fq = lane >> 4, w = F.wave;
    constexpr int ksl = K / 8, nst = ksl / 32; const int np = ncg * (8 / RT);
    for (int p = F.wg; p < np; p += F.G) {
        const int cg = p / (8 / RT), rtg = p % (8 / RT);
        const int base0 = PAIR128 ? 256 * (cg >> 3) + 16 * (cg & 7) : 32 * cg, base1 = PAIR128 ? base0 + 128 : base0 + 16;
        const bf16* w0p = Bt + (size_t)(base0 + fr) * K + w * ksl + 8 * fq; const bf16* w1p = Bt + (size_t)(base1 + fr) * K + w * ksl + 8 * fq;
        const bf16* xp = A + (size_t)(16 * rtg * RT + fr) * K + w * ksl + 8 * fq;
        bf16x8 w0[nst], w1[nst], x[nst][RT];
#pragma unroll
        for (int s = 0; s < nst; ++s) { w0[s] = *(const bf16x8*)(w0p + 32 * s); w1[s] = *(const bf16x8*)(w1p + 32 * s);
#pragma unroll
            for (int r = 0; r < RT; ++r) x[s][r] = *(const bf16x8*)(xp + (size_t)(16 * r) * K + 32 * s); }
        typename Epi::Pre pre{}; if (w < RT) pre = epi.prefetch(16 * (rtg * RT + w) + fr, cg, fq);
        f32x4 acc[RT][2];
#pragma unroll
        for (int r = 0; r < RT; ++r) { acc[r][0] = (f32x4){0.f, 0.f, 0.f, 0.f}; acc[r][1] = (f32x4){0.f, 0.f, 0.f, 0.f}; }
#pragma unroll
        for (int s = 0; s < nst; ++s)
#pragma unroll
            for (int r = 0; r < RT; ++r) { acc[r][0] = __builtin_amdgcn_mfma_f32_16x16x32_bf16(w0[s], x[s][r], acc[r][0], 0, 0, 0); acc[r][1] = __builtin_amdgcn_mfma_f32_16x16x32_bf16(w1[s], x[s][r], acc[r][1], 0, 0, 0); }
#pragma unroll
        for (int r = 0; r < RT; ++r) { red[((w * RT + r) * 2 + 0) * 64 + lane] = acc[r][0]; red[((w * RT + r) * 2 + 1) * 64 + lane] = acc[r][1]; }
        __syncthreads();
        for (int r = w; r < RT; r += NWAVES) {
            f32x4 v0 = (f32x4){0.f, 0.f, 0.f, 0.f}, v1 = v0;
#pragma unroll
            for (int ww = 0; ww < NWAVES; ++ww) { v0 += red[((ww * RT + r) * 2 + 0) * 64 + lane]; v1 += red[((ww * RT + r) * 2 + 1) * 64 + lane]; }
            epi(16 * (rtg * RT + r) + fr, cg, fq, v0, v1, lane, pre);
        }
        __syncthreads();
    }
}
__device__ __forceinline__ LAS float* sample_rs(const Frame& F) {
    __syncthreads();
    LAS float* rs = (LAS float*)(F.lds + RS_OFF);
    if (F.tid < MS) { const f32x4* p = (const f32x4*)(F.W<float>(WS_SSS) + (size_t)F.tid * 32); float s = 0.f;
#pragma unroll
        for (int i = 0; i < 8; ++i) { const f32x4 v = p[i]; s += (v.x + v.y) + (v.z + v.w); }
        rs[F.tid] = rsqrtf(s * (1.f / 1024.f) + 1e-6f); }
    __syncthreads();
    return rs;
}
using pg8::silu_mul; using pg8::gelu_tanh;
struct SEpiRes { bf16* Xb; float* SSS; const float* bias; float scale;
    struct Pre { v2u w0, w1; };
    __device__ __forceinline__ Pre prefetch(int srow, int cg, int fq) const { const bf16* xb = Xb + (size_t)(MP + srow) * D + 32 * cg + 4 * fq; Pre p; p.w0 = *(const v2u*)xb; p.w1 = *(const v2u*)(xb + 16); return p; }
    __device__ __forceinline__ void operator()(int srow, int cg, int fq, f32x4 v0, f32x4 v1, int lane, const Pre& pre) const {
        const int c = 32 * cg + 4 * fq; bf16* xb = Xb + (size_t)(MP + srow) * D + c;
        const v2u w0 = pre.w0, w1 = pre.w1;
        f32x4 x0 = (f32x4){bflo(w0.x), bfhi(w0.x), bflo(w0.y), bfhi(w0.y)}, x1 = (f32x4){bflo(w1.x), bfhi(w1.x), bflo(w1.y), bfhi(w1.y)};
        if (bias) { x0 += *(const f32x4*)(bias + c); x1 += *(const f32x4*)(bias + c + 16); }
        x0 += v0 * scale; x1 += v1 * scale;
        v2u a; a.x = pk2(x0.x, x0.y); a.y = pk2(x0.z, x0.w); *(v2u*)xb = a; a.x = pk2(x1.x, x1.y); a.y = pk2(x1.z, x1.w); *(v2u*)(xb + 16) = a;
        float ssq = (x0.x * x0.x + x0.y * x0.y) + (x0.z * x0.z + x0.w * x0.w) + (x1.x * x1.x + x1.y * x1.y) + (x1.z * x1.z + x1.w * x1.w);
        ssq += shx(ssq, lane, 16); ssq += shx(ssq, lane, 32);
        if (fq == 0) SSS[(size_t)srow * 32 + cg] = ssq; } };
struct SEpiRin { LAS float* rs; const float* bias; bf16* YB; bf16* XBR;
    struct Pre { int dummy; };
    __device__ __forceinline__ Pre prefetch(int, int, int) const { return Pre{0}; }
    __device__ __forceinline__ void operator()(int srow, int cg, int fq, f32x4 v0, f32x4 v1, int lane, const Pre& pre) const {
        const float r = rs[srow]; const int c = 32 * cg + 4 * fq;
        v0 = v0 * r + *(const f32x4*)(bias + c); v1 = v1 * r + *(const f32x4*)(bias + c + 16);
        const bool isy = c < 1024;
        if (isy) { v0.x = gelu_tanh(v0.x); v0.y = gelu_tanh(v0.y); v0.z = gelu_tanh(v0.z); v0.w = gelu_tanh(v0.w); v1.x = gelu_tanh(v1.x); v1.y = gelu_tanh(v1.y); v1.z = gelu_tanh(v1.z); v1.w = gelu_tanh(v1.w); }
        bf16* o = (isy ? YB : XBR) + (size_t)(MP + srow) * D + (isy ? c : c - 1024);
        v2u a; a.x = pk2(v0.x, v0.y); a.y = pk2(v0.z, v0.w); *(v2u*)o = a; a.x = pk2(v1.x, v1.y); a.y = pk2(v1.z, v1.w); *(v2u*)(o + 16) = a; } };
struct SEpiQkv { LAS float* rs; const float* CS; bf16* QKV; float* out; int j;
    struct Pre { int dummy; };
    __device__ __forceinline__ Pre prefetch(int, int, int) const { return Pre{0}; }
    __device__ __forceinline__ void operator()(int srow, int cg, int fq, f32x4 v0, f32x4 v1, int lane, const Pre& pre) const {
        const int pn = cg >> 3, sub = cg & 7, g = pn / 12, which = (pn % 12) >> 2, hq = pn & 3, head = 4 * hq + (sub >> 1), dd = 16 * (sub & 1) + 4 * fq;
        const float r = rs[srow]; v0 *= r; v1 *= r;
        if (which < 2) { const int pos = SEQ + (srow & 3); const f32x4 c4 = *(const f32x4*)(CS + (size_t)pos * 64 + dd), s4 = *(const f32x4*)(CS + (size_t)pos * 64 + 32 + dd); const f32x4 x1 = v0, x2 = v1; v0 = x1 * c4 - x2 * s4; v1 = x2 * c4 + x1 * s4;
            if (which == 0) { v0 *= 0.125f; v1 *= 0.125f; } }
        bf16* o = QKV + (size_t)(MP + srow) * NQKV + g * 3072 + which * 1024 + head * 64 + dd;
        v2u a; a.x = pk2(v0.x, v0.y); a.y = pk2(v0.z, v0.w); *(v2u*)o = a; a.x = pk2(v1.x, v1.y); a.y = pk2(v1.z, v1.w); *(v2u*)(o + 32) = a;
        if (which >= 1) { float* kp = out + (g == 0 ? O_KV128S : (g == 1 ? O_KV512S : O_KV2048S)) + (size_t)j * 32 * 4 * 2048 + ((size_t)srow * 2 + (which - 1)) * 1024 + head * 64 + dd; *(f32x4*)kp = v0; *(f32x4*)(kp + 32) = v1; } } };

#ifndef ATT_SPLIT
#define ATT_SPLIT 1
#endif
#define SUBT(id, ...) do { unsigned long long s0_ = 0; if (TPROBE == (id)) s0_ = __builtin_amdgcn_s_memrealtime(); __VA_ARGS__; if (TPROBE == (id)) tsub += __builtin_amdgcn_s_memrealtime() - s0_; } while (0)
#ifndef TAMP
#define TAMP 8
#endif
#define GEMM_SP2 true
__device__ __forceinline__ unsigned long long ph_up(const Frame& F0, int l, int f) { const Frame F = phase_frame(F0); unsigned long long tsub = 0;
    const int mat = l * 2 + f; const bf16* Bt = F.W<bf16>(WS_WUP + mat * SZ_WUP);
    LAS float* rs = sample_rs(F);
    pg8::Gemm g{F.W<bf16>(WS_XB), Bt, MTP, NUP, D}; pg8::StaticOrder S; S.init(MTP, NUP, F.G, F.wg);
    pg8::EpiUp E{F.W<float>(WS_SS), F.W<bf16>(WS_HID), rs};
    SUBT(22, if (F.wg >= 150 && mat < 7) { LAS unsigned* scr = (LAS unsigned*)(F.lds + F.wave * 16384); const int lo = cv_bound(mat), hi = cv_bound(mat + 1);
        for (int it = lo + (F.wg - 150) * NWAVES + F.wave; it < hi; it += 106 * NWAVES) cv_item(F, it, scr, F.lane);
        __syncthreads(); });
    SUBT(23, if (TPROBE_PH == 1) tsub += pg8::gemm_phase<pg8::EpiUp, pg8::StaticOrder, true, GEMM_SP2>(F.lds, g, S, E, F.tid); else (void)pg8::gemm_phase<pg8::EpiUp, pg8::StaticOrder, true, GEMM_SP2>(F.lds, g, S, E, F.tid));
    return tsub;
}
__device__ __forceinline__ unsigned long long ph_res(const Frame& F0, const bf16* A, const bf16* Bt, int K, const float* bias, float scale) { const Frame F = phase_frame(F0); unsigned long long tsub = 0;
    { pg8::Gemm g{A, Bt, MP, D, K}; pg8::StaticOrder S; S.init(MP, D, F.G, F.wg);
      pg8::EpiRes E{F.W<bf16>(WS_XB), F.W<float>(WS_SS), bias, scale};
      SUBT(20, if (TPROBE_PH == 2) tsub += pg8::gemm_phase<pg8::EpiRes, pg8::StaticOrder, false, GEMM_SP2>(F.lds, g, S, E, F.tid); else (void)pg8::gemm_phase<pg8::EpiRes, pg8::StaticOrder, false, GEMM_SP2>(F.lds, g, S, E, F.tid)); }
    { SEpiRes E{F.W<bf16>(WS_XB), F.W<float>(WS_SSS), bias, scale};
      SUBT(21, if (K == D) sample_gemm<1, false, D, SEpiRes>(F, A + (size_t)MP * D, Bt, D / 32, E); else sample_gemm<1, false, DFF, SEpiRes>(F, A + (size_t)MP * DFF, Bt, D / 32, E)); }
    return tsub;
}
__device__ __forceinline__ void ph_rin(const Frame& F0, int j) { const Frame F = phase_frame(F0);
    const bf16* Bt = F.W<bf16>(WS_WRIN + j * SZ_WRIN); const float* bias = F.in(I_BRIN) + j * 2048;
    { pg8::Gemm g{F.W<bf16>(WS_XB), Bt, MP, 2048, D}; pg8::StaticOrder S; S.init(MP, 2048, F.G, F.wg);
      pg8::EpiRin E{F.W<float>(WS_SS), bias, F.W<bf16>(WS_YB), F.W<bf16>(WS_XBR)};
      pg8::gemm_phase<pg8::EpiRin, pg8::StaticOrder, true, GEMM_SP2>(F.lds, g, S, E, F.tid); }
    { LAS float* rs = sample_rs(F); SEpiRin E{rs, bias, F.W<bf16>(WS_YB), F.W<bf16>(WS_XBR)};
      sample_gemm<2, false, D, SEpiRin>(F, F.W<bf16>(WS_XB) + (size_t)MP * D, Bt, 2048 / 32, E); }
}
__device__ __forceinline__ unsigned long long ph_qkv(const Frame& F0, int j) { const Frame F = phase_frame(F0); unsigned long long tq_ = 0;
    const bf16* Bt = F.W<bf16>(WS_WQKV + j * SZ_WQKV);
    { pg8::Gemm g{F.W<bf16>(WS_XB), Bt, MP, NQKV, D}; pg8::StaticOrder S; S.init(MP, NQKV, F.G, F.wg);
      static_assert(O_KV128P == 17186816 && O_KV512P == 18759680 && O_KV2048P == 23478272, "EpiQkv offsets");
      pg8::EpiQkv E{F.W<float>(WS_SS), F.W<float>(WS_CS), F.W<bf16>(WS_QKV), F.outp(), j, F.lds + EPI_STAGE_OFF};
      if (TPROBE_PH == 7) tq_ = pg8::gemm_phase<pg8::EpiQkv, pg8::StaticOrder, true, GEMM_SP2>(F.lds, g, S, E, F.tid); else (void)pg8::gemm_phase<pg8::EpiQkv, pg8::StaticOrder, true, GEMM_SP2>(F.lds, g, S, E, F.tid); }
    { LAS float* rs = sample_rs(F);
      SEpiQkv E{rs, F.W<float>(WS_CS), F.W<bf16>(WS_QKV), F.outp(), j};
      sample_gemm<8, true, D, SEpiQkv>(F, F.W<bf16>(WS_XB) + (size_t)MP * D, Bt, NQKV / 32, E); }
    return tq_;
}

__device__ __forceinline__ void ph_merge(const Frame& F0) { const Frame F = phase_frame(F0);
    const bf16* OG = F.W<bf16>(WS_OG); const float* LSE = F.W<float>(WS_LSE); bf16* OM = F.W<bf16>(WS_AOP);
    for (int idx = F.wg * NTHR + F.tid; idx < MT * 128; idx += F.G * NTHR) {
        const size_t row = idx >> 7; const int c8 = idx & 127, head = c8 >> 3; const size_t off = row * D + 8 * c8;
        const v4u a0 = *(const v4u*)(OG + off), a1 = *(const v4u*)(OG + (size_t)MT * D + off), a2 = *(const v4u*)(OG + 2 * (size_t)MT * D + off);
        const float l0 = LSE[row * 16 + head], l1 = LSE[((size_t)MT + row) * 16 + head], l2 = LSE[(2 * (size_t)MT + row) * 16 + head];
        const float mx = fmaxf(l0, fmaxf(l1, l2)); float w0 = __expf(l0 - mx), w1 = __expf(l1 - mx), w2 = __expf(l2 - mx); const float inv = 1.f / (w0 + w1 + w2); w0 *= inv; w1 *= inv; w2 *= inv;
        v4u o;
        o.x = pg8::cvt_pk_bf16(w0 * bflo(a0.x) + w1 * bflo(a1.x) + w2 * bflo(a2.x), w0 * bfhi(a0.x) + w1 * bfhi(a1.x) + w2 * bfhi(a2.x));
        o.y = pg8::cvt_pk_bf16(w0 * bflo(a0.y) + w1 * bflo(a1.y) + w2 * bflo(a2.y), w0 * bfhi(a0.y) + w1 * bfhi(a1.y) + w2 * bfhi(a2.y));
        o.z = pg8::cvt_pk_bf16(w0 * bflo(a0.z) + w1 * bflo(a1.z) + w2 * bflo(a2.z), w0 * bfhi(a0.z) + w1 * bfhi(a1.z) + w2 * bfhi(a2.z));
        o.w = pg8::cvt_pk_bf16(w0 * bflo(a0.w) + w1 * bflo(a1.w) + w2 * bflo(a2.w), w0 * bfhi(a0.w) + w1 * bfhi(a1.w) + w2 * bfhi(a2.w));
        *(v4u*)(OM + off) = o;
    }
}
__device__ __forceinline__ void ph_final(const Frame& F0) { const Frame F = phase_frame(F0);
    const bf16* Xb = F.W<bf16>(WS_XB); const float* SS = F.W<float>(WS_SS); const float* SSS = F.W<float>(WS_SSS); const float* gf = F.in(I_NFIN);
    const int gw = F.wg * NWAVES + F.wave, NGW = F.G * NWAVES, lane = F.lane;
    for (int m = gw; m < MT; m += NGW) {
        float s;
        if (m < MP) { const f32x4 v = *(const f32x4*)(SS + (size_t)m * 4); s = (v.x + v.y) + (v.z + v.w); }
        else { const float v = lane < 32 ? SSS[(size_t)(m - MP) * 32 + lane] : 0.f; s = wave_sum(v, lane); }
        const float rs = rsqrtf(s * (1.f / 1024.f) + 1e-6f);
#pragma unroll
        for (int jj = 0; jj < 4; ++jj) { const v2u xw = *((const v2u*)(Xb + (size_t)m * D) + lane + 64 * jj); const f32x4 v = (f32x4){bflo(xw.x), bfhi(xw.x), bflo(xw.y), bfhi(xw.y)}; const f32x4 gg = *((const f32x4*)gf + lane + 64 * jj);
            *((f32x4*)(F.outp() + O_Y + (size_t)m * D) + lane + 64 * jj) = v * rs * gg; }
    }
}

constexpr int XP = 132, YP = 136;
constexpr int SC_XC = 0, SC_Y = 64 * XP * 4;
struct ScanW { bf16x8 wa[4], wx[4]; float ba, bx, m8sp; };
__device__ __forceinline__ float sigm(float x) { return __builtin_amdgcn_rcpf(1.f + __builtin_amdgcn_exp2f(-1.4426950408889634f * x)); }
__device__ __forceinline__ void scan_load_w(const Frame& F, int j, int blk, int w, int fr, int fq, ScanW& W) {
    const bf16* wa = F.W<bf16>(WS_WG + (size_t)((j * 2 + 0) * 8 + blk) * 32768) + (size_t)(16 * w + fr) * 128 + 8 * fq;
    const bf16* wx = F.W<bf16>(WS_WG + (size_t)((j * 2 + 1) * 8 + blk) * 32768) + (size_t)(16 * w + fr) * 128 + 8 * fq;
#pragma unroll
    for (int ks = 0; ks < 4; ++ks) { W.wa[ks] = *(const bf16x8*)(wa + 32 * ks); W.wx[ks] = *(const bf16x8*)(wx + 32 * ks); }
    const int ch = j * D + blk * 128 + 16 * w + fr;
    W.ba = F.in(I_BGA)[ch]; W.bx = F.in(I_BGX)[ch]; W.m8sp = -8.0f * 1.4426950408889634f * log1pf(expf(-F.in(I_LAM)[ch]));
}
__device__ __forceinline__ void scan_rowtile(const LAS float* xc, const LAS bf16* xb, const ScanW& W, int fr, int fq, int cl, float (&a)[4], float (&b)[4]) {
    f32x4 da = (f32x4){0.f, 0.f, 0.f, 0.f}, dx = da;
#pragma unroll
    for (int ks = 0; ks < 4; ++ks) {
        const bf16x8 af = *(const LAS bf16x8*)(xb + fr * YP + 32 * ks + 8 * fq);
        da = __builtin_amdgcn_mfma_f32_16x16x32_bf16(af, W.wa[ks], da, 0, 0, 0); dx = __builtin_amdgcn_mfma_f32_16x16x32_bf16(af, W.wx[ks], dx, 0, 0, 0);
    }
#pragma unroll
    for (int i = 0; i < 4; ++i) {
        const float xcv = xc[(4 * fq + i) * XP + cl]; const float ga = sigm(da[i] + W.ba), gx = sigm(dx[i] + W.bx);
        const float ai = __builtin_amdgcn_exp2f(W.m8sp * ga); a[i] = ai; b[i] = __builtin_amdgcn_sqrtf(fmaxf(1.f - ai * ai, 0.f)) * gx * xcv;
    }
}
constexpr int SC_P = SC_Y + 64 * YP * 2, SC_XB = SC_P + 64 * YP * 2;
__device__ __forceinline__ void ph_scan(const Frame& F0, int j) { const Frame F = phase_frame(F0);
    __syncthreads();
    const int wg = F.wg, b = wg >> 7, blk = (wg >> 4) & 7, span = wg & 15;
    const int lane = F.lane, fr = lane & 15, fq = lane >> 4, w = F.wave, cl = 16 * w + fr, ch = blk * 128 + cl;
    LAS float* xc = (LAS float*)(F.lds + SC_XC); LAS bf16* yt = (LAS bf16*)(F.lds + SC_Y); LAS bf16* pt = (LAS bf16*)(F.lds + SC_P); LAS bf16* xbt = (LAS bf16*)(F.lds + SC_XB);
    const bf16* XBR = F.W<bf16>(WS_XBR); bf16* YB = F.W<bf16>(WS_YB); bf16* HY = F.W<bf16>(WS_AOP);
    float2* CARRY = F.W<float2>(WS_CARRY);
    const int c4 = F.tid & 31, tq = F.tid >> 5;
    if (wg < 256) {
    ScanW W; scan_load_w(F, j, blk, w, fr, fq, W);
    f32x4 cw[4], cb;
#pragma unroll
    for (int k = 0; k < 4; ++k) cw[k] = *(const f32x4*)(F.in(I_WCONV) + (size_t)(j * 4 + k) * D + blk * 128 + 4 * c4);
    cb = *(const f32x4*)(F.in(I_BCONV) + (size_t)j * D + blk * 128 + 4 * c4);
    float h = 0.f, ptot = 1.f;
    const int t0 = span * 512; const size_t rowb = (size_t)b * SEQ + t0;
    v2u xr[7], yr[4];
#define SCAN_LOAD(k) do { _Pragma("unroll") for (int rr = 0; rr < 7; ++rr) { const int tt = t0 + 64 * (k) + 4 * tq - 3 + rr; \
        const v2u xl_ = *(const v2u*)(XBR + ((size_t)b * SEQ + (tt < 0 ? 0 : tt)) * D + blk * 128 + 4 * c4); xr[rr].x = tt >= 0 ? xl_.x : 0u; xr[rr].y = tt >= 0 ? xl_.y : 0u; } \
        _Pragma("unroll") for (int i = 0; i < 4; ++i) yr[i] = *(const v2u*)(YB + (rowb + 64 * (k) + 4 * tq + i) * D + blk * 128 + 4 * c4); } while (0)
    SCAN_LOAD(0);
    for (int k = 0; k < 8; ++k) {
#pragma unroll
        for (int i = 0; i < 4; ++i) { f32x4 o = cb;
#pragma unroll
            for (int kk = 0; kk < 4; ++kk) { const v2u x = xr[i + kk]; o += cw[kk] * (f32x4){bflo(x.x), bfhi(x.x), bflo(x.y), bfhi(x.y)}; }
            *(LAS f32x4*)(xc + (4 * tq + i) * XP + 4 * c4) = o; { v2u ob; ob.x = pk2(o.x, o.y); ob.y = pk2(o.z, o.w); *(LAS v2u*)(xbt + (4 * tq + i) * YP + 4 * c4) = ob; }
            *(LAS v2u*)(yt + (4 * tq + i) * YP + 4 * c4) = yr[i]; }
        __syncthreads();
        if (k + 1 < 8) SCAN_LOAD(k + 1);
        float a[4][4], bb[4][4], A4[4], B4[4];
#pragma unroll
        for (int rt = 0; rt < 4; ++rt) { scan_rowtile(xc + 16 * rt * XP, xbt + 16 * rt * YP, W, fr, fq, cl, a[rt], bb[rt]);
            A4[rt] = (a[rt][0] * a[rt][1]) * (a[rt][2] * a[rt][3]); B4[rt] = ((bb[rt][0] * a[rt][1] + bb[rt][1]) * a[rt][2] + bb[rt][2]) * a[rt][3] + bb[rt][3]; }
        float As[4][4], Bs[4][4];
#pragma unroll
        for (int rt = 0; rt < 4; ++rt)
#pragma unroll
            for (int q = 0; q < 4; ++q) { As[rt][q] = shfl_at(A4[rt], fr + 16 * q); Bs[rt][q] = shfl_at(B4[rt], fr + 16 * q); }
#pragma unroll
        for (int rt = 0; rt < 4; ++rt) {
            const float h1 = As[rt][0] * h + Bs[rt][0], h2 = As[rt][1] * h1 + Bs[rt][1], h3 = As[rt][2] * h2 + Bs[rt][2], h4 = As[rt][3] * h3 + Bs[rt][3];
            const float p1 = As[rt][0] * ptot, p2 = As[rt][1] * p1, p3 = As[rt][2] * p2, p4 = As[rt][3] * p3;
            float hh = fq == 0 ? h : (fq == 1 ? h1 : (fq == 2 ? h2 : h3)), pp = fq == 0 ? ptot : (fq == 1 ? p1 : (fq == 2 ? p2 : p3));
#pragma unroll
            for (int i = 0; i < 4; ++i) { hh = a[rt][i] * hh + bb[rt][i]; pp *= a[rt][i]; const int o = (16 * rt + 4 * fq + i) * YP + cl; const float yv = bf2f(yt[o]); yt[o] = (bf16)f2bf(hh * yv); pt[o] = (bf16)f2bf(pp * yv); }
            h = h4; ptot = p4;
        }
        __syncthreads();
        { const int r = F.tid >> 3, sg = F.tid & 7; const size_t go = (rowb + 64 * k + r) * D + blk * 128 + 16 * sg;
          const LAS v4u* s = (const LAS v4u*)(yt + r * YP + 16 * sg); v4u* d = (v4u*)(HY + go); d[0] = s[0]; d[1] = s[1];
          const LAS v4u* s2 = (const LAS v4u*)(pt + r * YP + 16 * sg); v4u* d2 = (v4u*)(YB + go); d2[0] = s2[0]; d2[1] = s2[1]; }
        __syncthreads();
    }
#undef SCAN_LOAD
    if (fq == 0) CARRY[(size_t)(b * 16 + span) * D + ch] = make_float2(ptot, h);
    if (span == 15 && F.tid < 384) { const int i = F.tid >> 7, c = F.tid & 127; F.outp()[O_CP + ((size_t)(j * 2 + b) * 3 + i) * D + blk * 128 + c] = bf2f(XBR[((size_t)b * SEQ + SEQ - 3 + i) * D + blk * 128 + c]); }
    }
    if (wg < 64) {
        __syncthreads();
        const int rt8 = wg >> 3, sblk = wg & 7, sch = sblk * 128 + cl;
        ScanW W; scan_load_w(F, j, sblk, w, fr, fq, W);
        { const int tok = tq, n = 4 * rt8 + (tok >> 2), t = tok & 3; f32x4 o = *(const f32x4*)(F.in(I_BCONV) + (size_t)j * D + sblk * 128 + 4 * c4);
#pragma unroll
          for (int kk = 0; kk < 4; ++kk) { const int tt = t + kk - 3; f32x4 xv;
              if (tt >= 0) { const v2u x = *(const v2u*)(XBR + ((size_t)MP + 4 * n + tt) * D + sblk * 128 + 4 * c4); xv = (f32x4){bflo(x.x), bfhi(x.x), bflo(x.y), bfhi(x.y)}; }
              else xv = *(const f32x4*)(F.in(I_STC) + ((size_t)(j * NSQ + n) * 3 + (tt + 3)) * D + sblk * 128 + 4 * c4);
              o += *(const f32x4*)(F.in(I_WCONV) + (size_t)(j * 4 + kk) * D + sblk * 128 + 4 * c4) * xv; }
          *(LAS f32x4*)(xc + tok * XP + 4 * c4) = o; { v2u ob; ob.x = pk2(o.x, o.y); ob.y = pk2(o.z, o.w); *(LAS v2u*)(xbt + tok * YP + 4 * c4) = ob; }
          *(LAS v2u*)(yt + tok * YP + 4 * c4) = *(const v2u*)(YB + ((size_t)MP + 4 * n + t) * D + sblk * 128 + 4 * c4); }
        __syncthreads();
        { float a[4], bb[4]; scan_rowtile(xc, xbt, W, fr, fq, cl, a, bb);
          const int n = 4 * rt8 + fq; float hh = F.in(I_STH)[(size_t)(j * NSQ + n) * D + sch];
#pragma unroll
          for (int i = 0; i < 4; ++i) { hh = a[i] * hh + bb[i]; LAS bf16* yp = yt + (4 * fq + i) * YP + cl; *yp = (bf16)f2bf(hh * bf2f(*yp)); }
          F.outp()[O_HS + (size_t)(j * NSQ + n) * D + sch] = hh; }
        __syncthreads();
        if (F.tid < 128) { const int r = F.tid >> 3, sg = F.tid & 7; const LAS v4u* s = (const LAS v4u*)(yt + r * YP + 16 * sg); v4u* d = (v4u*)(HY + ((size_t)MP + 16 * rt8 + r) * D + sblk * 128 + 16 * sg); d[0] = s[0]; d[1] = s[1]; }
        for (int e = F.tid; e < 4 * 3 * 128; e += NTHR) { const int c = e & 127, i = (e >> 7) % 3, sq = e / 384, n = 4 * rt8 + sq;
            F.outp()[O_CS + ((size_t)(j * NSQ + n) * 3 + i) * D + sblk * 128 + c] = bf2f(XBR[((size_t)MP + 4 * n + 1 + i) * D + sblk * 128 + c]); }
    }
}

__device__ __forceinline__ void ph_scan_fix(const Frame& F0, int j) { const Frame F = phase_frame(F0);
    __syncthreads();
    const int wg = F.wg, b = wg >> 7, blk = (wg >> 4) & 7, span = wg & 15;
    if (span == 0) return;
    LAS float* hin = (LAS float*)F.lds;
    const float2* CARRY = F.W<float2>(WS_CARRY); const bf16* PY = F.W<bf16>(WS_YB); bf16* HY = F.W<bf16>(WS_AOP);
    if (F.tid < 128) { const int ch = blk * 128 + F.tid; float h = 0.f;
        for (int s = 0; s < span; ++s) { const float2 cv = CARRY[(size_t)(b * 16 + s) * D + ch]; h = cv.x * h + cv.y; }
        hin[F.tid] = h;
        if (span == 15) { const float2 cv = CARRY[(size_t)(b * 16 + 15) * D + ch]; F.outp()[O_HP + (size_t)(j * 2 + b) * D + ch] = cv.x * h + cv.y; } }
    __syncthreads();
    const int c8 = F.tid & 15, r = F.tid >> 4; float hv[8];
#pragma unroll
    for (int e = 0; e < 8; ++e) hv[e] = hin[8 * c8 + e];
    const size_t rowb = (size_t)b * SEQ + span * 512;
#pragma unroll 4
    for (int it = 0; it < 16; ++it) { const size_t go = (rowb + 32 * it + r) * D + blk * 128 + 8 * c8;
        const v4u hl = *(const v4u*)(HY + go), pv = *(const v4u*)(PY + go); v4u o;
        o.x = pk2(bflo(hl.x) + bflo(pv.x) * hv[0], bfhi(hl.x) + bfhi(pv.x) * hv[1]); o.y = pk2(bflo(hl.y) + bflo(pv.y) * hv[2], bfhi(hl.y) + bfhi(pv.y) * hv[3]);
        o.z = pk2(bflo(hl.z) + bflo(pv.z) * hv[4], bfhi(hl.z) + bfhi(pv.z) * hv[5]); o.w = pk2(bflo(hl.w) + bflo(pv.w) * hv[6], bfhi(hl.w) + bfhi(pv.w) * hv[7]);
        *(v4u*)(HY + go) = o; }
}

constexpr int KP = 72;
constexpr int AT_HALF = 128 * KP * 2, AT_K = 0, AT_V = 2 * AT_HALF;
typedef short s16x4 __attribute__((ext_vector_type(4)));
typedef short v4i16_t __attribute__((ext_vector_type(4)));
__device__ __forceinline__ s16x4 vtr(const LAS unsigned char* p) { return __builtin_bit_cast(s16x4, __builtin_amdgcn_ds_read_tr16_b64_v4i16((LAS v4i16_t*)p)); }
__device__ __forceinline__ void attn_decode(int u, int& g, int& b, int& head, int& r, int& nb) { const int combo = u >> 6, idx = u & 63; g = combo >> 5; b = (combo >> 4) & 1; head = combo & 15; r = idx >> (6 - 2 * g); nb = idx & ((64 >> (2 * g)) - 1); }
template <bool LAST>
__device__ __forceinline__ void ph_attn(const Frame& F0, int j, int ulo, int uhi) { const Frame F = phase_frame(F0);
    if (ulo >= uhi) return;
    __syncthreads();
    const int lane = F.lane, fr = lane & 15, fq = lane >> 4, w = F.wave, tid = F.tid;
    const bf16* QKV = F.W<bf16>(WS_QKV); bf16* OG = F.W<bf16>(WS_OG); float* LSE = F.W<float>(WS_LSE); bf16* OM = F.W<bf16>(WS_AOP);
    LAS unsigned char* lds = F.lds;
    constexpr int UPW = LAST ? 8 : 16; const int ubase = LAST ? 4096 + F.wg * UPW : F.wg * UPW;
#define AT_GLOAD(dst, g_, b_, head_, r_, blk_) do { _Pragma("unroll") for (int i = 0; i < 4; ++i) { const int c = tid + 512 * i, wh = c >> 10, row = (c >> 3) & 127, sg = c & 7; \
        dst[i] = (blk_) < 0 ? (v4u){0u, 0u, 0u, 0u} : *(const v4u*)(QKV + ((((size_t)((g_) * 3 + 1 + wh) * 2 + (b_)) * 16 + (head_)) * 8192 + ((r_) << (13 - 2 * (g_))) + (blk_) * 128 + row) * 64 + 8 * sg); } } while (0)
#define AT_LSTORE(src, blk_) do { _Pragma("unroll") for (int i = 0; i < 4; ++i) { const int c = tid + 512 * i, wh = c >> 10, row = (c >> 3) & 127, sg = c & 7; \
        *(LAS v4u*)(lds + wh * AT_V + ((blk_) & 1) * AT_HALF + (row * KP + 8 * sg) * 2) = src[i]; } } while (0)
    v4u ncur[4], nprev[4]; bf16x8 qn[2];
#define AT_QLOAD(g_, b_, head_, r_, nb_) do { const bf16* qp_ = QKV + ((((size_t)((g_) * 3) * 2 + (b_)) * 16 + (head_)) * 8192 + ((r_) << (13 - 2 * (g_))) + (nb_) * 128 + 16 * w + fr) * 64 + 8 * fq; qn[0] = *(const bf16x8*)qp_; qn[1] = *(const bf16x8*)(qp_ + 32); } while (0)
    int g, b, head, r, nb; attn_decode(ubase + ulo, g, b, head, r, nb);
    AT_GLOAD(ncur, g, b, head, r, nb); AT_GLOAD(nprev, g, b, head, r, nb - 1); AT_QLOAD(g, b, head, r, nb);
    bool need_prev = true;
    for (int ui = ulo; ui < uhi; ++ui) {
        AT_LSTORE(ncur, nb); if (need_prev) AT_LSTORE(nprev, nb - 1);
        bf16x8 qf[2]; qf[0] = qn[0]; qf[1] = qn[1];
        __syncthreads();
        const size_t qrow = (size_t)b * SEQ + (((nb * 128 + 16 * w + fr) << (2 * g)) + r);
        int g2 = g, b2 = b, head2 = head, r2 = r, nb2 = nb; bool np2 = false;
        if (ui + 1 < uhi) { attn_decode(ubase + ui + 1, g2, b2, head2, r2, nb2); np2 = !(g2 == g && b2 == b && head2 == head && r2 == r && nb2 == nb + 1);
            AT_GLOAD(ncur, g2, b2, head2, r2, nb2); if (np2) AT_GLOAD(nprev, g2, b2, head2, r2, nb2 - 1); AT_QLOAD(g2, b2, head2, r2, nb2); }
        const int lr = lane >> 3, l8 = lane & 7;
        const size_t orow0 = (size_t)b * SEQ + (((nb * 128 + 16 * w + lr) << (2 * g)) + r), orow1 = orow0 + ((size_t)8 << (2 * g));
        v4u ma0[2], ma1[2]; float ml0[2] = {0.f, 0.f}, ml1[2] = {0.f, 0.f};
        if (LAST) { ma0[0] = *(const v4u*)(OG + orow0 * D + head * 64 + 8 * l8); ma0[1] = *(const v4u*)(OG + orow1 * D + head * 64 + 8 * l8);
            ma1[0] = *(const v4u*)(OG + ((size_t)MT + orow0) * D + head * 64 + 8 * l8); ma1[1] = *(const v4u*)(OG + ((size_t)MT + orow1) * D + head * 64 + 8 * l8);
            ml0[0] = LSE[orow0 * 16 + head]; ml0[1] = LSE[orow1 * 16 + head]; ml1[0] = LSE[((size_t)MT + orow0) * 16 + head]; ml1[1] = LSE[((size_t)MT + orow1) * 16 + head]; }
        f32x4 sacc[9];
        { bf16x8 kf[9][2];
#pragma unroll
          for (int jj = 0; jj < 9; ++jj) { const int kt = w + jj; const int blk = kt < 8 ? nb - 1 : nb;
              const LAS unsigned char* kp = lds + AT_K + (blk & 1) * AT_HALF + (((kt & 7) * 16 + fr) * KP + 8 * fq) * 2;
              kf[jj][0] = *(const LAS bf16x8*)kp; kf[jj][1] = *(const LAS bf16x8*)(kp + 64); }
          __builtin_amdgcn_sched_barrier(0);
#pragma unroll
          for (int jj = 0; jj < 9; ++jj) { f32x4 s = (f32x4){0.f, 0.f, 0.f, 0.f};
              s = __builtin_amdgcn_mfma_f32_16x16x32_bf16(kf[jj][0], qf[0], s, 0, 0, 0); s = __builtin_amdgcn_mfma_f32_16x16x32_bf16(kf[jj][1], qf[1], s, 0, 0, 0); sacc[jj] = s; } }
        const float NEG = -1e30f; float mx = NEG;
#pragma unroll
        for (int i = 0; i < 4; ++i) { if (4 * fq + i < fr) sacc[0][i] = NEG; if (4 * fq + i > fr) sacc[8][i] = NEG; }
        if (nb == 0) {
#pragma unroll
            for (int jj = 0; jj < 8; ++jj) if (w + jj < 8) sacc[jj] = (f32x4){NEG, NEG, NEG, NEG}; }
#pragma unroll
        for (int jj = 0; jj < 9; ++jj) mx = fmaxf(mx, fmaxf(fmaxf(sacc[jj][0], sacc[jj][1]), fmaxf(sacc[jj][2], sacc[jj][3])));
        mx = fmaxf(mx, shx(mx, lane, 16)); mx = fmaxf(mx, shx(mx, lane, 32));
        float sum = 0.f;
#pragma unroll
        for (int jj = 0; jj < 9; ++jj)
#pragma unroll
            for (int i = 0; i < 4; ++i) { const float p = __builtin_amdgcn_exp2f(sacc[jj][i] - mx); sacc[jj][i] = p; sum += p; }
        sum += shx(sum, lane, 16); sum += shx(sum, lane, 32);
        f32x4 oacc[4];
#pragma unroll
        for (int dt = 0; dt < 4; ++dt) oacc[dt] = (f32x4){0.f, 0.f, 0.f, 0.f};
#pragma unroll
        for (int hb = 0; hb < 2; ++hb) {
            bf16x8 vfr[3][4];
#pragma unroll
            for (int q3 = 0; q3 < 3; ++q3) { const int pp = 3 * hb + q3; if (pp < 5) { const int j0 = 2 * pp, j1 = pp < 4 ? 2 * pp + 1 : 2 * pp; const int kt0 = w + j0, kt1 = w + j1;
                const LAS unsigned char* v0p = lds + AT_V + (((kt0 < 8 ? nb - 1 : nb) & 1) * AT_HALF) + (((kt0 & 7) * 16 + 4 * fq + (fr >> 2)) * KP + 4 * (fr & 3)) * 2;
                const LAS unsigned char* v1p = lds + AT_V + (((kt1 < 8 ? nb - 1 : nb) & 1) * AT_HALF) + (((kt1 & 7) * 16 + 4 * fq + (fr >> 2)) * KP + 4 * (fr & 3)) * 2;
#pragma unroll
                for (int dt = 0; dt < 4; ++dt) { const s16x4 a = vtr(v0p + 32 * dt), c = vtr(v1p + 32 * dt); vfr[q3][dt] = (bf16x8){a[0], a[1], a[2], a[3], c[0], c[1], c[2], c[3]}; } } }
            __builtin_amdgcn_sched_barrier(0);
#pragma unroll
            for (int q3 = 0; q3 < 3; ++q3) { const int pp = 3 * hb + q3; if (pp < 5) { const int j0 = 2 * pp, j1 = pp < 4 ? 2 * pp + 1 : 2 * pp;
                const f32x4 p0 = sacc[j0], p1 = pp < 4 ? sacc[j1] : (f32x4){0.f, 0.f, 0.f, 0.f};
                const v4u pk = pg8::pack8(p0, p1); const bf16x8 pf = __builtin_bit_cast(bf16x8, pk);
#pragma unroll
                for (int dt = 0; dt < 4; ++dt) oacc[dt] = __builtin_amdgcn_mfma_f32_16x16x32_bf16(vfr[q3][dt], pf, oacc[dt], 0, 0, 0); } }
        }
        { LAS unsigned char* stg = lds + EPI_STAGE_OFF + w * 2304; const float inv = 1.f / sum;
#pragma unroll
          for (int dt = 0; dt < 4; ++dt) { const f32x4 o = oacc[dt] * inv; v2u pw; pw.x = pg8::cvt_pk_bf16(o.x, o.y); pw.y = pg8::cvt_pk_bf16(o.z, o.w); *(LAS v2u*)(stg + fr * 144 + (16 * dt + 4 * fq) * 2) = pw; }
          if (fq == 0) *(LAS float*)(stg + fr * 144 + 128) = mx + __builtin_amdgcn_logf(sum);
          asm volatile("s_waitcnt lgkmcnt(0)" ::: "memory");
#pragma unroll
          for (int h2 = 0; h2 < 2; ++h2) { const int row = lr + 8 * h2; const size_t orow = h2 ? orow1 : orow0;
              const v4u v = *(const LAS v4u*)(stg + row * 144 + 16 * l8); const float ml2 = *(const LAS float*)(stg + row * 144 + 128);
              if (!LAST) { *(v4u*)(OG + ((size_t)g * MT + orow) * D + head * 64 + 8 * l8) = v; if (l8 == 0) LSE[((size_t)g * MT + orow) * 16 + head] = ml2; }
              else { const float mm = fmaxf(ml0[h2], fmaxf(ml1[h2], ml2)); float w0 = __builtin_amdgcn_exp2f(ml0[h2] - mm), w1 = __builtin_amdgcn_exp2f(ml1[h2] - mm), w2 = __builtin_amdgcn_exp2f(ml2 - mm);
                  const float wi = 1.f / (w0 + w1 + w2); w0 *= wi; w1 *= wi; w2 *= wi; const v4u x0 = ma0[h2], x1 = ma1[h2]; v4u o;
                  o.x = pg8::cvt_pk_bf16(w0 * bflo(x0.x) + w1 * bflo(x1.x) + w2 * bflo(v.x), w0 * bfhi(x0.x) + w1 * bfhi(x1.x) + w2 * bfhi(v.x));
                  o.y = pg8::cvt_pk_bf16(w0 * bflo(x0.y) + w1 * bflo(x1.y) + w2 * bflo(v.y), w0 * bfhi(x0.y) + w1 * bfhi(x1.y) + w2 * bfhi(v.y));
                  o.z = pg8::cvt_pk_bf16(w0 * bflo(x0.z) + w1 * bflo(x1.z) + w2 * bflo(v.z), w0 * bfhi(x0.z) + w1 * bfhi(x1.z) + w2 * bfhi(v.z));
                  o.w = pg8::cvt_pk_bf16(w0 * bflo(x0.w) + w1 * bflo(x1.w) + w2 * bflo(v.w), w0 * bfhi(x0.w) + w1 * bfhi(x1.w) + w2 * bfhi(v.w));
                  *(v4u*)(OM + orow * D + head * 64 + 8 * l8) = o; } } }
        __syncthreads();
        g = g2; b = b2; head = head2; r = r2; nb = nb2; need_prev = np2;
    }
#undef AT_GLOAD
#undef AT_LSTORE
#undef AT_QLOAD
}
template <bool LAST>
__device__ __forceinline__ void ph_attn_sample(const Frame& F0, int j) { const Frame F = phase_frame(F0);
    const int lane = F.lane, w = F.wave;
    const bf16* QKV = F.W<bf16>(WS_QKV); bf16* OG = F.W<bf16>(WS_OG); float* LSE = F.W<float>(WS_LSE); bf16* OM = F.W<bf16>(WS_AOP);
    const float* c0 = F.in(I_C128); const float* c1 = F.in(I_C512); const float* c2 = F.in(I_C2048);
    for (int it3 = LAST ? 2 : 0; it3 < (LAST ? 3 : 2); ++it3) {
        const int vwg = (F.wg & 7) * 32 + (F.wg >> 3);
        const int id = it3 * 2048 + vwg * NWAVES + w;
        const int sg = id >> 11, srow = (id >> 4) & 127, shead = id & 15, n = srow >> 2, t = srow & 3, dil = 1 << (2 * sg), Wg = 128 << (2 * sg), ks = lane >> 4, d4 = lane & 15;
        const float* cache = (sg == 0 ? c0 : (sg == 1 ? c1 : c2)) + (size_t)(j * NSQ + n) * Wg * 2048 + shead * 64 + 4 * d4;
        const bf16* nk = QKV + (size_t)(MP + 4 * n) * NQKV + sg * 3072 + 1024 + shead * 64 + 4 * d4;
        f32x4 q4; { const v2u x = *(const v2u*)(QKV + (size_t)(MP + srow) * NQKV + sg * 3072 + shead * 64 + 4 * d4); q4 = (f32x4){bflo(x.x), bfhi(x.x), bflo(x.y), bfhi(x.y)}; }
        float sc[33];
#define AT_SKEY(it_, which_, dst_) do { const int k_ = 4 * (it_) + ks; const int p_ = SEQ + t - dil * k_; dst_ = (f32x4){0.f, 0.f, 0.f, 0.f}; \
            if (k_ <= 128) { if (p_ >= SEQ) { const v2u a_ = *(const v2u*)(nk + (size_t)(p_ - SEQ) * NQKV + (which_) * 1024); dst_ = (f32x4){bflo(a_.x), bfhi(a_.x), bflo(a_.y), bfhi(a_.y)}; } \
                             else dst_ = *(const f32x4*)(cache + (size_t)(p_ - (SEQ - Wg)) * 2048 + (which_) * 1024); } } while (0)
#pragma unroll
        for (int c3 = 0; c3 < 3; ++c3) { f32x4 kk[11];
#pragma unroll
            for (int i = 0; i < 11; ++i) AT_SKEY(11 * c3 + i, 0, kk[i]);
#pragma unroll
            for (int i = 0; i < 11; ++i) { float s = (q4.x * kk[i].x + q4.y * kk[i].y) + (q4.z * kk[i].z + q4.w * kk[i].w);
                s += shx(s, lane, 1); s += shx(s, lane, 2); s += shx(s, lane, 4); s += shx(s, lane, 8); sc[11 * c3 + i] = (4 * (11 * c3 + i) + ks <= 128) ? s : -1e30f; } }
        float m = -1e30f;
#pragma unroll
        for (int i = 0; i < 33; ++i) m = fmaxf(m, sc[i]);
        float l = 0.f;
#pragma unroll
        for (int i = 0; i < 33; ++i) { sc[i] = __expf(sc[i] - m); l += sc[i]; }
        f32x4 o4 = (f32x4){0.f, 0.f, 0.f, 0.f};
#pragma unroll
        for (int c3 = 0; c3 < 3; ++c3) { f32x4 vv[11];
#pragma unroll
            for (int i = 0; i < 11; ++i) AT_SKEY(11 * c3 + i, 1, vv[i]);
#pragma unroll
            for (int i = 0; i < 11; ++i) o4 += vv[i] * sc[11 * c3 + i]; }
#undef AT_SKEY
#pragma unroll
        for (int off = 16; off <= 32; off <<= 1) {
            const float m2 = shx(m, lane, off), l2 = shx(l, lane, off); f32x4 o2; o2.x = shx(o4.x, lane, off); o2.y = shx(o4.y, lane, off); o2.z = shx(o4.z, lane, off); o2.w = shx(o4.w, lane, off);
            const float mn = fmaxf(m, m2), e1 = __expf(m - mn), e2 = __expf(m2 - mn); l = l * e1 + l2 * e2; o4 = o4 * e1 + o2 * e2; m = mn;
        }
        if (ks == 0) {
            if (!LAST) { const f32x4 o = o4 * (1.f / l); v2u pw; pw.x = pg8::cvt_pk_bf16(o.x, o.y); pw.y = pg8::cvt_pk_bf16(o.z, o.w); *(v2u*)(OG + ((size_t)sg * MT + MP + srow) * D + shead * 64 + 4 * d4) = pw; if (d4 == 0) LSE[((size_t)sg * MT + MP + srow) * 16 + shead] = m + __logf(l); }
            else { const size_t orow = (size_t)MP + srow; const v2u a0 = *(const v2u*)(OG + orow * D + shead * 64 + 4 * d4), a1 = *(const v2u*)(OG + ((size_t)MT + orow) * D + shead * 64 + 4 * d4);
                const float l0 = LSE[orow * 16 + shead], l1 = LSE[((size_t)MT + orow) * 16 + shead], l2 = m + __logf(l), mm = fmaxf(l0, fmaxf(l1, l2)); float w0 = __expf(l0 - mm), w1 = __expf(l1 - mm), w2 = __expf(l2 - mm);
                const float wi = 1.f / (w0 + w1 + w2); w0 *= wi; w1 *= wi; w2 *= wi / l; v2u pw;
                pw.x = pg8::cvt_pk_bf16(w0 * bflo(a0.x) + w1 * bflo(a1.x) + w2 * o4.x, w0 * bfhi(a0.x) + w1 * bfhi(a1.x) + w2 * o4.y); pw.y = pg8::cvt_pk_bf16(w0 * bflo(a0.y) + w1 * bflo(a1.y) + w2 * o4.z, w0 * bfhi(a0.y) + w1 * bfhi(a1.y) + w2 * o4.w);
                *(v2u*)(OM + orow * D + shead * 64 + 4 * d4) = pw; }
        }
    }
}

__global__ void __launch_bounds__(NTHR, 2) mega_fwd(Params p) {
    extern __shared__ __attribute__((aligned(16))) unsigned char lds_raw[];
    Frame F;
    F.lds = (LAS unsigned char*)lds_raw; F.tid = threadIdx.x; F.lane = F.tid & 63; F.wave = __builtin_amdgcn_readfirstlane(F.tid >> 6); F.wg = blockIdx.x; F.G = gridDim.x;
    F.out_g = (GAS float*)p.out; F.ws_g = (GAS unsigned char*)p.ws;
    for (int u = F.tid; u < (LDS_BYTES - RING_BYTES) / 4; u += NTHR) ((LAS unsigned*)(F.lds + RING_BYTES))[u] = 0u;
    __syncthreads();
    XcdBarrier bar = xcd_barrier_post((unsigned*)(p.ws + WS_CTL) + CW_BAR, (volatile LAS unsigned*)(F.lds + MISC_OFF) + 8);
#define GRID_BAR() do { XcdBarrier bb_ = bar; bb_.x = xb_xcc_id(); asm volatile("" : "+s"(bb_.bar), "+s"(bb_.x)); bb_.lead = (F.wave == 0) && (lane_now() == 0); xcd_barrier(bb_); } while (0)
    unsigned long long tacc = 0;
#define PHASE(id, ...) do { unsigned long long t0_ = 0; if (TPROBE == (id)) t0_ = __builtin_amdgcn_s_memrealtime(); __VA_ARGS__; if (TPROBE == (id)) tacc += __builtin_amdgcn_s_memrealtime() - t0_; } while (0)
    PHASE(0, ph_prologue(F); GRID_BAR());
    for (int l = 0; l < DEPTH; ++l) {
        const int j = l >> 1;
        for (int f = 0; f < 2; ++f) {
            PHASE(1, tacc += ph_up(F, l, f); GRID_BAR());
            PHASE(2, tacc += ph_res(F, F.W<bf16>(WS_HID), F.W<bf16>(WS_WDN + (size_t)(l * 2 + f) * SZ_WDN), DFF, nullptr, 0.5f); GRID_BAR());
            if (f == 0) {
                if ((l & 1) == 0) {
                    PHASE(3, ph_rin(F, j); GRID_BAR());
                    PHASE(4, ph_scan(F, j); GRID_BAR());
                    PHASE(5, ph_scan_fix(F, j); GRID_BAR());
                    PHASE(6, tacc += ph_res(F, F.W<bf16>(WS_AOP), F.W<bf16>(WS_WROUT + (size_t)j * SZ_WSQ), D, F.in(I_BROUT) + j * D, 1.0f); GRID_BAR());
                } else {
                    PHASE(7, tacc += ph_qkv(F, j); GRID_BAR());
                    { const int k4 = (F.wg >> 3) & 3, sa = ATT_SPLIT ? k4 * 5 + k4 / 3 : 0, sb = ATT_SPLIT ? k4 * 3 - k4 / 3 : 0;
                      PHASE(14, ph_attn<false>(F, j, 0, sa); ph_attn_sample<false>(F, j); ph_attn<false>(F, j, sa, 16); GRID_BAR());
                      PHASE(15, ph_attn<true>(F, j, 0, sb); ph_attn_sample<true>(F, j); ph_attn<true>(F, j, sb, 8); GRID_BAR()); }
                    PHASE(10, tacc += ph_res(F, F.W<bf16>(WS_AOP), F.W<bf16>(WS_WO + (size_t)j * SZ_WSQ), D, nullptr, 1.0f); GRID_BAR());
                }
            }
        }
    }
    PHASE(11, ph_final(F));
    if (TPROBE >= 0) { const unsigned long long tend = __builtin_amdgcn_s_memrealtime() + (unsigned long long)TAMP * tacc; while (__builtin_amdgcn_s_memrealtime() < tend) __builtin_amdgcn_s_sleep(64); }
}

extern "C" void kernel_launch(void* const* d_in, const int* in_sizes, int n_in, void* d_out, int out_size, void* d_ws, size_t ws_size, hipStream_t stream) {
    static int grid = 0;
    if (grid == 0) {
        if (n_in != N_IN || (size_t)out_size != O_END || ws_size < WS_END) { fprintf(stderr, "kernel_launch: unexpected shapes (n_in %d, out %d, ws %zu); nothing launched\n", n_in, out_size, ws_size); grid = -1; return; }
        int dev = 0, cus = 0, per_cu = 0;
        if (hipGetDevice(&dev) != hipSuccess || hipDeviceGetAttribute(&cus, hipDeviceAttributeMultiprocessorCount, dev) != hipSuccess) { grid = -1; return; }
        if (hipFuncSetAttribute((const void*)mega_fwd, hipFuncAttributeMaxDynamicSharedMemorySize, LDS_BYTES) != hipSuccess) { grid = -1; return; }
        if (hipOccupancyMaxActiveBlocksPerMultiprocessor(&per_cu, (const void*)mega_fwd, NTHR, LDS_BYTES) != hipSuccess || per_cu < 1) { fprintf(stderr, "kernel_launch: occupancy query says %d blocks per CU\n", per_cu); }
        (void)hipGetLastError();
        if (cus != 256) { fprintf(stderr, "kernel_launch: built for 256 CUs, device has %d; nothing launched\n", cus); grid = -1; return; }
        grid = cus;
    }
    if (grid < 0) return;
    if (hipMemsetAsync((char*)d_ws + WS_CTL, 0, CTL_ZERO_BYTES, stream) != hipSuccess) return;
    Params p{};
    for (int i = 0; i < N_IN; ++i) p.in[i] = (const float*)d_in[i];
    p.out = (float*)d_out; p.ws = (unsigned char*)d_ws;
    hipLaunchKernelGGL(mega_fwd, dim3(grid), dim3(NTHR), LDS_BYTES, stream, p);
}
```

```cpp
#include <hip/hip_runtime.h>
#include <cstdio>
#include <cstdint>
#include <cmath>
#define LAS __attribute__((address_space(3)))
#ifndef TPROBE
#define TPROBE -1
#endif
#ifndef TPROBE_PH
#define TPROBE_PH 0
#endif
namespace pg8 {
#define PG8_LAS __attribute__((address_space(3)))
typedef unsigned short bf16_t;
typedef short bf16x8 __attribute__((ext_vector_type(8)));
typedef float f32x4 __attribute__((ext_vector_type(4)));
typedef unsigned u32x4 __attribute__((ext_vector_type(4)));
constexpr int BM = 256, BK = 64, HALF = 128, HTB = HALF * BK * 2  , STAGE_BYTES = 8 * HTB, NXCD = 8, WGM = 8;

__host__ __device__ __forceinline__ int lds_byte(int r, int c) { const int st = (r >> 4) * 2 + (c >> 5), rr = r & 15, cc = c & 31, ob = rr * 64 + cc * 2; return st * 1024 + (ob ^ (((ob >> 9) & 1) << 5)); }
__host__ __device__ __forceinline__ void stage_rc(int b, int& R, int& C) { const int st = b / 1024, sb = b % 1024, swz = sb ^ (((sb >> 9) & 1) << 5); R = (st >> 1) * 16 + swz / 64; C = (st & 1) * 32 + (swz % 64) / 2; }
__host__ __device__ __forceinline__ int perm32(int rho) { const int n = rho >> 4, i = rho & 15; return 8 * (i >> 2) + 4 * n + (i & 3); }

struct Unit { int pm, pn; };
struct Gemm { const bf16_t* A; const bf16_t* Bt; int M, N, K; };

struct StaticOrder {
    int nM, nN, nwg, G, c;
    __host__ __device__ void init(int M, int N, int G_, int c_) { nM = M / BM; nN = N / BM; nwg = nM * nN; G = G_; c = c_; }
    __host__ __device__ bool next(int i, Unit& u) const {
        const long L = (long)i * G + c; if (L >= nwg) return false;
        int wgid = (int)L; { const int q = nwg / NXCD, r = nwg % NXCD, xcd = wgid % NXCD, off = wgid / NXCD; wgid = (xcd < r ? xcd * (q + 1) : r * (q + 1) + (xcd - r) * q) + off; }
        const int nig = WGM * nN, gid = wgid / nig, fm = gid * WGM, gsz = (nM - fm) < WGM ? (nM - fm) : WGM;
        u.pm = fm + ((wgid % nig) % gsz); u.pn = (wgid % nig) / gsz; return true;
    }
    __device__ __forceinline__ void a_ready(const Unit&) const {}
    __device__ __forceinline__ void done(const Unit&) const {}
};

typedef float f32x2_cv __attribute__((ext_vector_type(2))); typedef __bf16 bf16x2_cv __attribute__((ext_vector_type(2)));
__device__ __forceinline__ unsigned cvt_pk_bf16(float lo, float hi) { const f32x2_cv v = {lo, hi}; const bf16x2_cv b = __builtin_convertvector(v, bf16x2_cv); return __builtin_bit_cast(unsigned, b); }
typedef float f32x2 __attribute__((ext_vector_type(2)));
__device__ __forceinline__ float shfl_at(float v, int srclane) { return __builtin_bit_cast(float, __builtin_amdgcn_ds_bpermute(srclane << 2, __builtin_bit_cast(int, v))); }
__device__ __forceinline__ float shx(float v, int lane, int k) { return shfl_at(v, lane ^ k); }
typedef unsigned u32x2 __attribute__((ext_vector_type(2)));
__device__ __forceinline__ float frcp(float x) { return __builtin_amdgcn_rcpf(x); }
__device__ __forceinline__ float silu_mul(float g, float u) { return g * u * frcp(1.f + __expf(-g)); }
__device__ __forceinline__ f32x2 silu_mul2(const f32x2 g, const f32x2 u, const f32x2 c1, const f32x2 ir) { const f32x2 t = g * c1; f32x2 e; e.x = __builtin_amdgcn_exp2f(t.x); e.y = __builtin_amdgcn_exp2f(t.y);
    const f32x2 d = e * ir + ir; f32x2 r; r.x = frcp(d.x); r.y = frcp(d.y); return (g * u) * r; }
__device__ __forceinline__ f32x2 gelu_tanh2(const f32x2 x) { const f32x2 x2 = x * x; const f32x2 u = (x * -2.3022082f) * (x2 * 0.044715f + 1.0f); f32x2 e; e.x = __builtin_amdgcn_exp2f(u.x); e.y = __builtin_amdgcn_exp2f(u.y);
    const f32x2 d = e + 1.0f; f32x2 r; r.x = frcp(d.x); r.y = frcp(d.y); return x * r; }
__device__ __forceinline__ float gelu_tanh(float x) { const float uu = 1.5957691216057308f * (x + 0.044715f * x * x * x); return x * frcp(1.f + __expf(-uu)); }
__device__ __forceinline__ float row_rs(const float* SS, int row) { const f32x4 s4 = *(const f32x4*)(SS + (size_t)row * 4); return rsqrtf(((s4.x + s4.y) + (s4.z + s4.w)) * (1.f / 1024.f) + 1e-6f); }
__device__ __forceinline__ u32x4 pack8(const f32x4& a, const f32x4& b) { u32x4 w; w.x = cvt_pk_bf16(a.x, a.y); w.y = cvt_pk_bf16(a.z, a.w); w.z = cvt_pk_bf16(b.x, b.y); w.w = cvt_pk_bf16(b.z, b.w); return w; }

struct EpiUp {
    static constexpr bool PERM = true, AFTER_DRAIN = false;
    const float* SS; bf16_t* H; const PG8_LAS float* rs_s;
    __device__ __forceinline__ void operator()(const f32x4 (&acc)[2][2][4][2], const Unit& u, int wr, int wc, int fr, int fq) const {
        const int row0 = u.pm * BM + wr * 64 + fr, col0 = u.pn * 128 + wc * 32 + 8 * fq; const bool smp = u.pm >= 64;
        float rsv[2][4];
#pragma unroll
        for (int ai = 0; ai < 2; ++ai)
#pragma unroll
            for (int m = 0; m < 4; ++m) rsv[ai][m] = row_rs(SS, smp ? 0 : row0 + ai * HALF + m * 16);
        if (smp) {
#pragma unroll
            for (int ai = 0; ai < 2; ++ai)
#pragma unroll
                for (int m = 0; m < 4; ++m) rsv[ai][m] = rs_s[(row0 + ai * HALF + m * 16 - 16384) & 127]; }
#pragma unroll
        for (int ai = 0; ai < 2; ++ai)
#pragma unroll
            for (int m = 0; m < 4; ++m) {
                const int row = row0 + ai * HALF + m * 16; const float rs = rsv[ai][m];
                const float c1s = rs * -1.4426950408889634f, irs = frcp(rs * rs); const f32x2 c1 = {c1s, c1s}, ir = {irs, irs};
                const f32x4 ga = acc[ai][0][m][0], gb = acc[ai][0][m][1], ua = acc[ai][1][m][0], ub = acc[ai][1][m][1];
                const f32x2 q0 = silu_mul2((f32x2){ga.x, ga.y}, (f32x2){ua.x, ua.y}, c1, ir), q1 = silu_mul2((f32x2){ga.z, ga.w}, (f32x2){ua.z, ua.w}, c1, ir);
                const f32x2 q2 = silu_mul2((f32x2){gb.x, gb.y}, (f32x2){ub.x, ub.y}, c1, ir), q3 = silu_mul2((f32x2){gb.z, gb.w}, (f32x2){ub.z, ub.w}, c1, ir);
                const f32x4 h0 = {q0.x, q0.y, q1.x, q1.y}, h1 = {q2.x, q2.y, q3.x, q3.y};
                *(u32x4*)(H + (size_t)row * 2816 + col0) = pack8(h0, h1);
            }
    }
};

__device__ __forceinline__ float ublo(unsigned u) { return __builtin_bit_cast(float, u << 16); }
__device__ __forceinline__ float ubhi(unsigned u) { return __builtin_bit_cast(float, u & 0xffff0000u); }
struct EpiRes {
    static constexpr bool PERM = true, AFTER_DRAIN = true;
    bf16_t* Xb; float* SS; const float* bias; float scale;
    __device__ __forceinline__ void fused(f32x4 (&acc)[2][2][4][2], const Unit& u, int wr, int wc, int fr, int fq, PG8_LAS unsigned char* lds, int wid, int lane) const {
        PG8_LAS float* P = (PG8_LAS float*)lds;
        const int col0 = u.pn * BM + wc * 32 + 8 * fq;
        f32x4 bv[2][2];
#pragma unroll
        for (int bj = 0; bj < 2; ++bj) { bv[bj][0] = bias ? *(const f32x4*)(bias + col0 + bj * HALF) : (f32x4){0.f, 0.f, 0.f, 0.f}; bv[bj][1] = bias ? *(const f32x4*)(bias + col0 + bj * HALF + 4) : (f32x4){0.f, 0.f, 0.f, 0.f}; }
#pragma unroll
        for (int ai = 0; ai < 2; ++ai)
#pragma unroll
            for (int m = 0; m < 4; ++m) {
                const int rt = ai * HALF + wr * 64 + m * 16 + fr; const size_t row = (size_t)u.pm * BM + rt; float ssq = 0.f;
#pragma unroll
                for (int bj = 0; bj < 2; ++bj) {
                    bf16_t* xp = Xb + row * 1024 + col0 + bj * HALF; const u32x4 xw = *(const u32x4*)xp;
                    f32x4 x0 = (f32x4){ublo(xw.x), ubhi(xw.x), ublo(xw.y), ubhi(xw.y)}, x1 = (f32x4){ublo(xw.z), ubhi(xw.z), ublo(xw.w), ubhi(xw.w)};
                    x0 += acc[ai][bj][m][0] * scale + bv[bj][0]; x1 += acc[ai][bj][m][1] * scale + bv[bj][1];
                    *(u32x4*)xp = pack8(x0, x1);
                    ssq += (x0.x * x0.x + x0.y * x0.y) + (x0.z * x0.z + x0.w * x0.w) + (x1.x * x1.x + x1.y * x1.y) + (x1.z * x1.z + x1.w * x1.w);
                }
                ssq += shx(ssq, lane, 16); ssq += shx(ssq, lane, 32);
                if (fq == 0) P[rt * 4 + wc] = ssq;
            }
        asm volatile("s_waitcnt lgkmcnt(0)" ::: "memory"); __builtin_amdgcn_s_barrier(); asm volatile("" ::: "memory");
        const int t = wid * 64 + lane;
        if (t < 256) { const f32x4 p = *(const PG8_LAS f32x4*)(P + t * 4); SS[((size_t)u.pm * BM + t) * 4 + u.pn] = (p.x + p.y) + (p.z + p.w); }
    }
};

struct EpiRin {
    static constexpr bool PERM = true, AFTER_DRAIN = false;
    const float* SS; const float* bias; bf16_t* YB; bf16_t* XBR;
    __device__ __forceinline__ void operator()(const f32x4 (&acc)[2][2][4][2], const Unit& u, int wr, int wc, int fr, int fq) const {
        const int row0 = u.pm * BM + wr * 64 + fr, col0 = u.pn * BM + wc * 32 + 8 * fq; const bool isy = u.pn < 4;
        bf16_t* O = isy ? YB : XBR; const int oc0 = isy ? col0 : col0 - 1024;
        f32x4 bv[2][2];
#pragma unroll
        for (int bj = 0; bj < 2; ++bj) { bv[bj][0] = *(const f32x4*)(bias + col0 + bj * HALF); bv[bj][1] = *(const f32x4*)(bias + col0 + bj * HALF + 4); }
        float rsv[2][4];
#pragma unroll
        for (int ai = 0; ai < 2; ++ai)
#pragma unroll
            for (int m = 0; m < 4; ++m) rsv[ai][m] = row_rs(SS, row0 + ai * HALF + m * 16);
#pragma unroll
        for (int ai = 0; ai < 2; ++ai)
#pragma unroll
            for (int m = 0; m < 4; ++m) {
                const int row = row0 + ai * HALF + m * 16; const float rs = rsv[ai][m];
#pragma unroll
                for (int bj = 0; bj < 2; ++bj) {
                    f32x4 v0 = acc[ai][bj][m][0] * rs + bv[bj][0], v1 = acc[ai][bj][m][1] * rs + bv[bj][1];
                    if (isy) { const f32x2 q0 = gelu_tanh2((f32x2){v0.x, v0.y}), q1 = gelu_tanh2((f32x2){v0.z, v0.w}), q2 = gelu_tanh2((f32x2){v1.x, v1.y}), q3 = gelu_tanh2((f32x2){v1.z, v1.w});
                               v0 = (f32x4){q0.x, q0.y, q1.x, q1.y}; v1 = (f32x4){q2.x, q2.y, q3.x, q3.y}; }
                    *(u32x4*)(O + (size_t)row * 1024 + oc0 + bj * HALF) = pack8(v0, v1);
                }
            }
    }
};

__device__ __forceinline__ void rope4(f32x4& a, f32x4& b, const f32x4 t0, const f32x4 t1) {
    const f32x4 x1 = a, x2 = b;
    a.x = x1.x * t0.x - x2.x * t0.y; b.x = x2.x * t0.x + x1.x * t0.y;
    a.y = x1.y * t0.z - x2.y * t0.w; b.y = x2.y * t0.z + x1.y * t0.w;
    a.z = x1.z * t1.x - x2.z * t1.y; b.z = x2.z * t1.x + x1.z * t1.y;
    a.w = x1.w * t1.z - x2.w * t1.w; b.w = x2.w * t1.z + x1.w * t1.w;
}
__device__ __forceinline__ f32x4 rot2(const f32x4 t, const f32x4 r) { return (f32x4){t.x * r.x - t.y * r.y, t.y * r.x + t.x * r.y, t.z * r.z - t.w * r.w, t.w * r.z + t.z * r.w}; }
struct EpiQkv {
    static constexpr bool PERM = true, AFTER_DRAIN = false; static constexpr int NDEF = 0;
    const float* SS; const float* CS; bf16_t* QKV; float* out; int j; PG8_LAS unsigned char* stage0;
    __device__ __forceinline__ void operator()(const f32x4 (&acc)[2][2][4][2], const Unit& u, int wr, int wc, int fr, int fq) const {
        const int g = u.pn / 12, which = (u.pn % 12) >> 2, hq = u.pn & 3, head = hq * 4 + wc, dd0 = 8 * fq; PG8_LAS unsigned char* stage = stage0 + (wr * 4 + wc) * 2304;
        const int colbase = g * 3072 + which * 1024 + head * 64 + dd0;
        const int Wg = 128 << (2 * g); const size_t kvo = (g == 0 ? (size_t)17186816 : (g == 1 ? (size_t)18759680 : (size_t)23478272)) + (size_t)j * 2 * Wg * 2048; float* kvp = out + kvo;
        const int row0 = u.pm * BM + wr * 64 + fr, pos0 = row0 & 8191, b = row0 >> 13;
        const bool rope = which < 2; const float qs = which == 0 ? 0.125f * 1.4426950408889634f : 1.0f;
        float rsv[2][4];
#pragma unroll
        for (int ai = 0; ai < 2; ++ai)
#pragma unroll
            for (int m = 0; m < 4; ++m) rsv[ai][m] = row_rs(SS, row0 + ai * HALF + m * 16) * qs;
        const f32x4 one4 = {1.f, 1.f, 1.f, 1.f}, zero4 = {0.f, 0.f, 0.f, 0.f};
        f32x4 rc[2], rsn[2];
#pragma unroll
        for (int n = 0; n < 2; ++n) { rc[n] = rope ? *(const f32x4*)(CS + (size_t)16 * 64 + dd0 + 4 * n) : one4; rsn[n] = rope ? *(const f32x4*)(CS + (size_t)16 * 64 + 32 + dd0 + 4 * n) : zero4; }
        f32x4 tcn = rope ? *(const f32x4*)(CS + (size_t)pos0 * 64 + dd0) : one4, tsn = rope ? *(const f32x4*)(CS + (size_t)pos0 * 64 + 32 + dd0) : zero4;
#pragma unroll
        for (int ai = 0; ai < 2; ++ai) {
            u32x2 keepA[4], keepB[4];
#pragma unroll
            for (int n = 0; n < 2; ++n) {
                f32x4 tc = tcn, ts = tsn;
                if (!(ai == 1 && n == 1)) { const int pn_ = pos0 + (n == 1 ? (ai + 1) * HALF : ai * HALF), nn_ = 4 * (1 - n);
                    tcn = rope ? *(const f32x4*)(CS + (size_t)pn_ * 64 + dd0 + nn_) : one4; tsn = rope ? *(const f32x4*)(CS + (size_t)pn_ * 64 + 32 + dd0 + nn_) : zero4; }
#pragma unroll
                for (int m = 0; m < 4; ++m) {
                    const int row = row0 + ai * HALF + m * 16, pos = pos0 + ai * HALF + m * 16; const float rs = rsv[ai][m];
                    const f32x4 x1 = acc[ai][0][m][n] * rs, x2 = acc[ai][1][m][n] * rs;
                    const f32x4 a0 = x1 * tc - x2 * ts, b0 = x2 * tc + x1 * ts;
                    if (m < 3) { const f32x4 c2 = tc * rc[n] - ts * rsn[n]; ts = ts * rc[n] + tc * rsn[n]; tc = c2; }
                    if (which >= 1 && pos >= 8192 - Wg) {
                        float* kp = kvp + ((size_t)(b * Wg + pos - (8192 - Wg)) * 2 + (which - 1)) * 1024 + head * 64 + dd0 + 4 * n;
                        __builtin_nontemporal_store(a0, (f32x4*)kp); __builtin_nontemporal_store(b0, (f32x4*)(kp + 32));
                    }
                    u32x2 pa, pb; pa.x = cvt_pk_bf16(a0.x, a0.y); pa.y = cvt_pk_bf16(a0.z, a0.w); pb.x = cvt_pk_bf16(b0.x, b0.y); pb.y = cvt_pk_bf16(b0.z, b0.w);
                    if (n == 0) { keepA[m] = pa; keepB[m] = pb; }
                    else {
                        PG8_LAS unsigned char* st = stage + fr * 144 + 16 * fq;
                        *(PG8_LAS u32x4*)st = (u32x4){keepA[m].x, keepA[m].y, pa.x, pa.y}; *(PG8_LAS u32x4*)(st + 64) = (u32x4){keepB[m].x, keepB[m].y, pb.x, pb.y};
                        asm volatile("s_waitcnt lgkmcnt(0)" ::: "memory");
                        const int l8 = (fq * 16 + fr) & 7, lr = (fq * 16 + fr) >> 3;
                        const u32x4 v0 = *(const PG8_LAS u32x4*)(stage + lr * 144 + 16 * l8), v1 = *(const PG8_LAS u32x4*)(stage + (lr + 8) * 144 + 16 * l8);
                        const int p0_ = pos - fr + lr, p1_ = p0_ + 8; const size_t hb = ((size_t)((g * 3 + which) * 2 + b) * 16 + head) * 8192;
                        bf16_t* o0 = QKV + (hb + ((p0_ & ((1 << (2 * g)) - 1)) << (13 - 2 * g)) + (p0_ >> (2 * g))) * 64 + 8 * l8;
                        bf16_t* o1 = QKV + (hb + ((p1_ & ((1 << (2 * g)) - 1)) << (13 - 2 * g)) + (p1_ >> (2 * g))) * 64 + 8 * l8;
                        asm volatile("s_waitcnt lgkmcnt(0)" ::: "memory");
                        *(u32x4*)o0 = v0; *(u32x4*)o1 = v1;
                    }
                }
            }
        }
    }
};

template <class Epi, class Sched, bool ALIGN_EPI = false, bool SP2 = false>
__device__ __forceinline__ unsigned long long gemm_phase(PG8_LAS unsigned char* lds, const Gemm g, const Sched& S, const Epi& E, int tid_in) {
    unsigned long long ts0_ = 0, tsr_ = 0;
#define PG8_TS(k) do { if (TPROBE == (k)) ts0_ = __builtin_amdgcn_s_memrealtime(); } while (0)
#define PG8_TE(k) do { if (TPROBE == (k)) tsr_ += __builtin_amdgcn_s_memrealtime() - ts0_; } while (0)
    PG8_TS(30);
    int tid_ = tid_in; asm volatile("" : "+v"(tid_));
    const int tid = tid_, wid = __builtin_amdgcn_readfirstlane(tid >> 6), lane = tid & 63, wr = wid >> 2, wc = wid & 3, fr = lane & 15, fq = lane >> 4;
    const int K = g.K, nt = K / BK;
    unsigned voffA[2], voffB[2];
#pragma unroll
    for (int i = 0; i < 2; ++i) { int R, C; stage_rc(tid * 16 + i * 8192, R, C); const int Rb = Epi::PERM ? ((R & ~31) + perm32(R & 31)) : R;
        voffA[i] = (unsigned)(R * K + C) * 2u; voffB[i] = (unsigned)(Rb * K + C) * 2u; }
    const size_t kstep = (size_t)(BK * 2);
    const size_t hstep = (size_t)HALF * K * 2;
    const size_t tstep = 2 * hstep;
    const unsigned ldsw = (unsigned)wid * 1024u;
    const int aoff = lds_byte(wr * 64 + fr, fq * 8), boff = lds_byte(wc * 32 + fr, fq * 8);
#define PG8_SA(b, h) (((b) * 2 + (h)) * HTB)
#define PG8_SB(b, h) ((4 + (b) * 2 + (h)) * HTB)
#define PG8_STAGE(bufoff, gbase, voff) do { _Pragma("unroll") for (int _i = 0; _i < 2; ++_i) \
        __builtin_amdgcn_global_load_lds((const unsigned*)((const char*)(gbase) + (voff)[_i]), (PG8_LAS unsigned*)(lds + (bufoff) + ldsw + _i * 8192), 16, 0, 0); } while (0)
#define PG8_LDA(dst, b, h) do { _Pragma("unroll") for (int m = 0; m < 4; ++m) _Pragma("unroll") for (int k = 0; k < 2; ++k) dst[m][k] = *(const PG8_LAS bf16x8*)(lds + PG8_SA(b, h) + aoff + m * 2048 + k * 1024); } while (0)
#define PG8_LDB(dst, b, h) do { _Pragma("unroll") for (int n = 0; n < 2; ++n) _Pragma("unroll") for (int k = 0; k < 2; ++k) dst[n][k] = *(const PG8_LAS bf16x8*)(lds + PG8_SB(b, h) + boff + n * 2048 + k * 1024); } while (0)
#define PG8_MMA(ai, bj, At, Bt) do { __builtin_amdgcn_s_setprio(1); _Pragma("unroll") for (int m = 0; m < 4; ++m) _Pragma("unroll") for (int n = 0; n < 2; ++n) _Pragma("unroll") for (int k = 0; k < 2; ++k) \
        acc[ai][bj][m][n] = __builtin_amdgcn_mfma_f32_16x16x32_bf16(Bt[n][k], At[m][k], acc[ai][bj][m][n], 0, 0, 0); __builtin_amdgcn_s_setprio(0); } while (0)
#define PG8_WAIT_V(n) asm volatile("s_waitcnt vmcnt(" #n ")" ::: "memory")
#define PG8_WAIT_L(n) asm volatile("s_waitcnt lgkmcnt(" #n ")" ::: "memory")
#define PG8_BAR __builtin_amdgcn_s_barrier()
#define PG8_SCHED __builtin_amdgcn_sched_barrier(0)
    Unit cur, nxt; int ui = 0;
    if (!S.next(0, cur)) return 0;
    f32x4 acc[2][2][4][2];
#pragma unroll
    for (int a = 0; a < 2; ++a)
#pragma unroll
        for (int b = 0; b < 2; ++b)
#pragma unroll
            for (int m = 0; m < 4; ++m)
#pragma unroll
                for (int n = 0; n < 2; ++n) acc[a][b][m][n] = (f32x4){0.f, 0.f, 0.f, 0.f};
    bf16x8 At[4][2], B0[2][2], B1[2][2];
    const char* cA = (const char*)g.A + (size_t)cur.pm * tstep; const char* cB = (const char*)g.Bt + (size_t)cur.pn * tstep;
    S.a_ready(cur);
    if constexpr (SP2) {
        PG8_STAGE(PG8_SB(0, 0), cB, voffB); PG8_STAGE(PG8_SB(0, 1), cB + hstep, voffB); PG8_STAGE(PG8_SA(0, 0), cA, voffA); PG8_STAGE(PG8_SA(0, 1), cA + hstep, voffA);
        if (wr == 1) PG8_BAR;
        PG8_WAIT_V(2); PG8_BAR;
        PG8_STAGE(PG8_SB(1, 0), cB + kstep, voffB); PG8_STAGE(PG8_SA(1, 0), cA + kstep, voffA); PG8_STAGE(PG8_SB(1, 1), cB + hstep + kstep, voffB);
        PG8_WAIT_V(6); PG8_BAR;
    } else {
        PG8_STAGE(PG8_SB(0, 0), cB, voffB); PG8_STAGE(PG8_SA(0, 0), cA, voffA); PG8_STAGE(PG8_SB(0, 1), cB + hstep, voffB); PG8_STAGE(PG8_SA(0, 1), cA + hstep, voffA);
        if (wr == 1) PG8_BAR;
        PG8_WAIT_V(4); PG8_BAR;
        PG8_STAGE(PG8_SB(1, 0), cB + kstep, voffB); PG8_STAGE(PG8_SA(1, 0), cA + kstep, voffA); PG8_STAGE(PG8_SB(1, 1), cB + hstep + kstep, voffB);
        PG8_WAIT_V(6); PG8_BAR;
    }
    PG8_TE(30); PG8_TS(31);
    for (;;) {
        const bool has_next = S.next(ui + 1, nxt);
        const char* nA = has_next ? (const char*)g.A + (size_t)nxt.pm * tstep : cA; const char* nB = has_next ? (const char*)g.Bt + (size_t)nxt.pn * tstep : cB;
        for (int t = 0; t < nt; t += 2) {
            const bool last = (t == nt - 2);
            const char* a1 = cA + (size_t)(t + 1) * kstep;
            const char* a2 = last ? nA : cA + (size_t)(t + 2) * kstep; const char* b2 = last ? nB : cB + (size_t)(t + 2) * kstep;
            const char* a3 = a2 + kstep; const char* b3 = b2 + kstep;
            if (last && has_next) S.a_ready(nxt);
            if constexpr (SP2) {
            PG8_LDB(B0, 0, 0); PG8_LDB(B1, 0, 1); PG8_SCHED; PG8_LDA(At, 0, 0); PG8_STAGE(PG8_SA(1, 1), a1 + hstep, voffA);
            PG8_WAIT_V(8); PG8_WAIT_L(0); PG8_BAR; PG8_MMA(0, 0, At, B0); PG8_MMA(0, 1, At, B1); PG8_BAR; PG8_SCHED;
            PG8_LDA(At, 0, 1); PG8_STAGE(PG8_SB(0, 0), b2, voffB); PG8_STAGE(PG8_SB(0, 1), b2 + hstep, voffB); PG8_STAGE(PG8_SA(0, 0), a2, voffA);
            PG8_WAIT_V(8); PG8_WAIT_L(0); PG8_BAR; PG8_MMA(1, 0, At, B0); PG8_MMA(1, 1, At, B1); PG8_BAR; PG8_SCHED;
            PG8_LDB(B0, 1, 0); PG8_LDB(B1, 1, 1); PG8_SCHED; PG8_LDA(At, 1, 0); PG8_STAGE(PG8_SA(0, 1), a2 + hstep, voffA);
            PG8_WAIT_V(8); PG8_WAIT_L(0); PG8_BAR; PG8_MMA(0, 0, At, B0); PG8_MMA(0, 1, At, B1); PG8_BAR; PG8_SCHED;
            PG8_LDA(At, 1, 1); PG8_STAGE(PG8_SB(1, 0), b3, voffB); PG8_STAGE(PG8_SB(1, 1), b3 + hstep, voffB); PG8_STAGE(PG8_SA(1, 0), a3, voffA);
            PG8_WAIT_V(8); PG8_WAIT_L(0); PG8_BAR; PG8_MMA(1, 0, At, B0); PG8_MMA(1, 1, At, B1); PG8_BAR; PG8_SCHED;
            } else {
            PG8_LDB(B0, 0, 0); PG8_SCHED; PG8_LDA(At, 0, 0); PG8_STAGE(PG8_SA(1, 1), a1 + hstep, voffA);
            PG8_WAIT_L(8); PG8_BAR; PG8_WAIT_L(0); PG8_MMA(0, 0, At, B0); PG8_BAR; PG8_SCHED;
            PG8_LDB(B1, 0, 1); PG8_STAGE(PG8_SB(0, 0), b2, voffB);
            PG8_BAR; PG8_WAIT_L(0); PG8_MMA(0, 1, At, B1); PG8_BAR;
            PG8_LDA(At, 0, 1); PG8_STAGE(PG8_SA(0, 0), a2, voffA);
            PG8_BAR; PG8_WAIT_L(0); PG8_MMA(1, 0, At, B0); PG8_BAR; PG8_SCHED;
            PG8_STAGE(PG8_SB(0, 1), b2 + hstep, voffB);
            PG8_WAIT_V(6); PG8_BAR; PG8_MMA(1, 1, At, B1); PG8_BAR;
            PG8_LDB(B0, 1, 0); PG8_SCHED; PG8_LDA(At, 1, 0); PG8_STAGE(PG8_SA(0, 1), a2 + hstep, voffA);
            PG8_WAIT_L(8); PG8_BAR; PG8_WAIT_L(0); PG8_MMA(0, 0, At, B0); PG8_BAR; PG8_SCHED;
            PG8_LDB(B1, 1, 1); PG8_STAGE(PG8_SB(1, 0), b3, voffB);
            PG8_BAR; PG8_WAIT_L(0); PG8_MMA(0, 1, At, B1); PG8_BAR;
            PG8_LDA(At, 1, 1); PG8_STAGE(PG8_SA(1, 0), a3, voffA);
            PG8_BAR; PG8_WAIT_L(0); PG8_MMA(1, 0, At, B0); PG8_BAR; PG8_SCHED;
            PG8_STAGE(PG8_SB(1, 1), b3 + hstep, voffB);
            PG8_WAIT_V(6); PG8_BAR; PG8_MMA(1, 1, At, B1); PG8_BAR;
            }
        }
        if constexpr (ALIGN_EPI) { if (wr == 0) PG8_BAR; }
        if constexpr (!Epi::AFTER_DRAIN) { unsigned long long te0_ = 0; if (TPROBE == 34) te0_ = __builtin_amdgcn_s_memrealtime(); E(acc, cur, wr, wc, fr, fq); S.done(cur); if (TPROBE == 34) tsr_ += __builtin_amdgcn_s_memrealtime() - te0_; }
        if (!has_next) break;
#pragma unroll
        for (int a = 0; a < 2; ++a)
#pragma unroll
            for (int b = 0; b < 2; ++b)
#pragma unroll
                for (int m = 0; m < 4; ++m)
#pragma unroll
                    for (int n = 0; n < 2; ++n) acc[a][b][m][n] = (f32x4){0.f, 0.f, 0.f, 0.f};
        cur = nxt; cA = nA; cB = nB; ++ui;
        if constexpr (ALIGN_EPI) { if (wr == 1) PG8_BAR; }
    }
    PG8_TE(31); PG8_TS(32);
    PG8_WAIT_V(0);
    if constexpr (!ALIGN_EPI) { if (wr == 0) PG8_BAR; }
    PG8_BAR;
    PG8_TE(32); PG8_TS(33);
    if constexpr (Epi::AFTER_DRAIN) { E.fused(acc, cur, wr, wc, fr, fq, lds, wid, lane); S.done(cur); }
    PG8_TE(33);
#undef PG8_SA
#undef PG8_SB
#undef PG8_STAGE
#undef PG8_LDA
#undef PG8_LDB
#undef PG8_MMA
#undef PG8_WAIT_V
#undef PG8_WAIT_L
#undef PG8_BAR
#undef PG8_SCHED
#undef PG8_TS
#undef PG8_TE
    return tsr_;
}
}

#define XB_TMO      128
#define XB_XCNT(j)  (256  + 64 * (j))
#define XB_XSUB(j)  (1280 + 64 * (j))
#define XB_XGEN(j)  (2304 + 64 * (j))
#define XB_TOP      3328
#define XB_TOPGEN   3392
#define XCD_BAR_WORDS 3456
#define XB_SPIN_CAP (1u << 18)

__device__ __forceinline__ unsigned xb_ld(unsigned* p)              { return __hip_atomic_load(p, __ATOMIC_RELAXED, __HIP_MEMORY_SCOPE_AGENT); }
__device__ __forceinline__ unsigned xb_add(unsigned* p, unsigned v) { return __hip_atomic_fetch_add(p, v, __ATOMIC_RELAXED, __HIP_MEMORY_SCOPE_AGENT); }
__device__ __forceinline__ unsigned xb_xcc_id() { return (unsigned)__builtin_amdgcn_s_getreg((3 << 11) | 20) & 0xFu; }
#define XB_SPIN(cond, bar) do { unsigned _sp = 0; while (cond) { __builtin_amdgcn_s_sleep(1); \
    if ((++_sp & 255u) == 0u) { if (xb_ld(&(bar)[XB_TMO])) break; if (_sp > XB_SPIN_CAP) { atomicAdd(&(bar)[XB_TMO], 1u); break; } } } } while (0)

struct XcdBarrier {
    unsigned* bar; unsigned x; bool lead;
    volatile LAS unsigned* st;
};

__device__ __forceinline__ XcdBarrier xcd_barrier_post(unsigned* bar, volatile LAS unsigned* st) {
    XcdBarrier b; b.bar = bar; b.x = xb_xcc_id(); b.st = st; b.lead = threadIdx.x == 0;
    if (threadIdx.x == 0) (void)xb_add(&bar[XB_XCNT(b.x)], 1u);
    return b;
}
__device__ __forceinline__ void xcd_barrier_complete(unsigned* bar, unsigned x, unsigned& nloc, unsigned& nx) {
    const unsigned G = gridDim.x * gridDim.y * gridDim.z;
    unsigned sum, cnt, mine, sp = 0u;
    for (;;) {
        sum = 0u; cnt = 0u; mine = 0u;
#pragma unroll
        for (unsigned j = 0; j < 16; ++j) { const unsigned c = xb_ld(&bar[XB_XCNT(j)]); sum += c; cnt += (c > 0u) ? 1u : 0u; mine = (j == x) ? c : mine; }
        if (sum == G) break;
        __builtin_amdgcn_s_sleep(1);
        if ((++sp & 255u) == 0u) { if (xb_ld(&bar[XB_TMO])) break; if (sp > XB_SPIN_CAP) { atomicAdd(&bar[XB_TMO], 1u); break; } }
    }
    nloc = mine > 0u ? mine : 1u; nx = cnt > 0u ? cnt : 1u;
}

__device__ __forceinline__ void xcd_barrier(const XcdBarrier& b) {
    asm volatile("s_waitcnt vmcnt(0)" ::: "memory");
    __syncthreads();
    if (b.lead) {
        unsigned* bar = b.bar;
        __builtin_amdgcn_s_waitcnt(0);
        unsigned nloc = b.st[0], nx = b.st[1];
        if (nloc == 0u) { xcd_barrier_complete(bar, b.x, nloc, nx); b.st[0] = nloc; b.st[1] = nx; }
        const unsigned old = xb_add(&bar[XB_XSUB(b.x)], 1u);
        const unsigned gen = old / nloc;
        if (old + 1u == (gen + 1u) * nloc) {
            __builtin_amdgcn_fence(__ATOMIC_RELEASE, "agent");
            asm volatile("s_waitcnt vmcnt(0)" ::: "memory");
            const unsigned og = xb_add(&bar[XB_TOP], 1u);
            const unsigned tg = og / nx;
            if (og + 1u == (tg + 1u) * nx) xb_add(&bar[XB_TOPGEN], 1u);
            else XB_SPIN(xb_ld(&bar[XB_TOPGEN]) == tg, bar);
            __builtin_amdgcn_fence(__ATOMIC_ACQUIRE, "agent");
            xb_add(&bar[XB_XGEN(b.x)], 1u);
            asm volatile("s_waitcnt vmcnt(0)" ::: "memory");
        } else {
            asm volatile("buffer_inv sc1" ::: "memory");
            XB_SPIN(xb_ld(&bar[XB_XGEN(b.x)]) == gen, bar);
            asm volatile("s_waitcnt vmcnt(0)" ::: "memory");
        }
    }
    __syncthreads();
}

#ifndef NT_CACHE
#define NT_CACHE 1
#endif
#ifndef NT_WCONV
#define NT_WCONV 1
#endif
#ifndef SAMPLE_ALT
#define SAMPLE_ALT 1
#endif
#ifndef NT_OUT
#define NT_OUT 1
#endif
constexpr int D = 1024, DFF = 2816, NUP = 5632, SEQ = 8192, NBATCH = 2, MP = NBATCH * SEQ, NSQ = 32, TS = 4, MS = NSQ * TS, MT = MP + MS;
constexpr int NQKV = 9216, NH = 16, HD = 64, DEPTH = 4;
constexpr int NWAVES = 8, NTHR = NWAVES * 64;
typedef unsigned short bf16;
typedef float f32x4 __attribute__((ext_vector_type(4)));
typedef unsigned v4u __attribute__((ext_vector_type(4)));
typedef unsigned v2u __attribute__((ext_vector_type(2)));
typedef short bf16x8 __attribute__((ext_vector_type(8)));
#define LDS_WAIT() asm volatile("s_waitcnt lgkmcnt(0)" ::: "memory")

enum { I_XP = 0, I_XS, I_STH, I_STC, I_C128, I_C512, I_C2048, I_NF1, I_NMIX, I_NF2, I_WU1, I_WD1, I_WU2, I_WD2, I_WRIN, I_BRIN, I_WCONV, I_BCONV,
       I_WGA, I_BGA, I_WGX, I_BGX, I_LAM, I_WROUT, I_BROUT, I_WQKV, I_WO, I_NFIN, N_IN };
constexpr size_t O_Y = 0, O_HP = (size_t)MT * D, O_HS = O_HP + 2 * 2 * 1024, O_CP = O_HS + 2 * 32 * 1024, O_CS = O_CP + 2 * 2 * 3 * 1024, O_KV128P = O_CS + 2 * 32 * 3 * 1024,
    O_KV128S = O_KV128P + (size_t)2 * 2 * 128 * 2048, O_KV512P = O_KV128S + (size_t)2 * 32 * 4 * 2048, O_KV512S = O_KV512P + (size_t)2 * 2 * 512 * 2048,
    O_KV2048P = O_KV512S + (size_t)2 * 32 * 4 * 2048, O_KV2048S = O_KV2048P + (size_t)2 * 2 * 2048 * 2048, O_END = O_KV2048S + (size_t)2 * 32 * 4 * 2048;
static_assert(O_END == 40779776, "output size");

constexpr size_t MiB = 1u << 20;
constexpr size_t WS_CTL = 0, CTL_ZERO_BYTES = 1 * MiB;
constexpr size_t WS_CS = 1 * MiB;
constexpr size_t WS_SS = 4 * MiB;
constexpr size_t WS_SSS = 4 * MiB + 512 * 1024;
constexpr size_t WS_CARRY = 5 * MiB;
constexpr size_t WS_LSE = 6 * MiB;
constexpr size_t WS_W = 16 * MiB;
constexpr size_t SZ_WUP = (size_t)NUP * D * 2, SZ_WDN = (size_t)D * DFF * 2, SZ_WRIN = (size_t)2048 * D * 2, SZ_WSQ = (size_t)D * D * 2, SZ_WQKV = (size_t)NQKV * D * 2, SZ_WG = (size_t)8 * 128 * 128 * 2;
constexpr size_t WS_WUP = WS_W, WS_WDN = WS_WUP + 8 * SZ_WUP, WS_WRIN = WS_WDN + 8 * SZ_WDN, WS_WROUT = WS_WRIN + 2 * SZ_WRIN, WS_WQKV = WS_WROUT + 2 * SZ_WSQ, WS_WO = WS_WQKV + 2 * SZ_WQKV,
    WS_WG = WS_WO + 2 * SZ_WSQ, WS_WEND = WS_WG + 4 * SZ_WG;
static_assert(WS_WEND <= 208 * MiB, "weights");
constexpr int MTP = MP + 256;
constexpr size_t WS_XB = 273 * MiB;
constexpr size_t WS_HID = 306 * MiB;
constexpr size_t WS_YB = 396 * MiB, WS_XBR = 429 * MiB, WS_AOP = 462 * MiB;
constexpr size_t WS_QKV = 495 * MiB;
constexpr size_t WS_OG = 786 * MiB;
constexpr size_t WS_END = 884 * MiB;
static_assert(WS_WEND <= WS_XB && WS_XB + (size_t)MTP * D * 2 <= WS_HID && WS_HID + (size_t)MTP * DFF * 2 <= WS_YB && WS_YB + (size_t)MT * D * 2 <= WS_XBR && WS_XBR + (size_t)MT * D * 2 <= WS_AOP &&
              WS_AOP + (size_t)MT * D * 2 <= WS_QKV && WS_QKV + (size_t)MT * NQKV * 2 <= WS_OG && WS_OG + (size_t)3 * MT * D * 2 <= WS_END, "ws map");
constexpr int CW_BAR = 4096;
constexpr int LDS_BYTES = 155648, RING_BYTES = 131072, MISC_OFF = RING_BYTES + 320, RS_OFF = RING_BYTES + 1024, EPI_STAGE_OFF = RING_BYTES + 2048;

__device__ __forceinline__ unsigned f2bf(float f) { unsigned u = __builtin_bit_cast(unsigned, f); return (u + 0x7fffu + ((u >> 16) & 1u)) >> 16; }
__device__ __forceinline__ unsigned pk2(float lo, float hi) { return pg8::cvt_pk_bf16(lo, hi); }
__device__ __forceinline__ float bf2f(bf16 v) { return __builtin_bit_cast(float, (unsigned)v << 16); }
__device__ __forceinline__ float bflo(unsigned u) { return __builtin_bit_cast(float, u << 16); }
__device__ __forceinline__ float bfhi(unsigned u) { return __builtin_bit_cast(float, u & 0xffff0000u); }

struct Params { const float* in[N_IN]; float* out; unsigned char* ws; };

#define GAS __attribute__((address_space(1)))
struct Frame {
    LAS unsigned char* lds;
    int tid, lane, wave, wg, G;
    GAS float* out_g; GAS unsigned char* ws_g;
    __device__ __forceinline__ const float* in(int i) const { const __attribute__((address_space(4))) Params* kp = (const __attribute__((address_space(4))) Params*)__builtin_amdgcn_kernarg_segment_ptr(); asm volatile("" : "+s"(kp)); return (const float*)(const GAS float*)kp->in[i]; }
    __device__ __forceinline__ float* outp() const { return (float*)out_g; }
    template <class T> __device__ __forceinline__ T* W(size_t off) const { return (T*)(GAS T*)(ws_g + off); }
};
__device__ __forceinline__ int lane_now() { int l; asm volatile("v_mbcnt_lo_u32_b32 %0, -1, 0\n\tv_mbcnt_hi_u32_b32 %0, -1, %0" : "=v"(l)); return l; }
__device__ __forceinline__ Frame phase_frame(const Frame& F0) {
    Frame F = F0; int wv = F0.wave; asm volatile("" : "+s"(wv));
    int t = wv * 64 + lane_now(); F.tid = t; F.lane = t & 63; F.wave = wv;
    asm volatile("" : "+s"(F.ws_g), "+s"(F.out_g)); return F;
}
__device__ __forceinline__ void tr_item64(const float* W, int K, int N, int k0, int ns0, int sstride, bf16* WT, int nd0, const float* gain, LAS unsigned* scr, int lane) {
    const int kk = lane >> 4, nn = lane & 15; const float* src = W + (size_t)(k0 + 16 * kk) * N + ns0 + (nn >> 3) * sstride + 4 * (nn & 7);
    f32x4 v[16];
#pragma unroll
    for (int i = 0; i < 16; ++i) v[i] = NT_WCONV ? __builtin_nontemporal_load((const f32x4*)(src + (size_t)i * N)) : *(const f32x4*)(src + (size_t)i * N);
    if (gain) {
#pragma unroll
        for (int i = 0; i < 16; ++i) v[i] *= gain[k0 + 16 * kk + i]; }
#pragma unroll
    for (int e = 0; e < 4; ++e) { v4u lo, hi;
        lo.x = pk2(v[0][e], v[1][e]); lo.y = pk2(v[2][e], v[3][e]); lo.z = pk2(v[4][e], v[5][e]); lo.w = pk2(v[6][e], v[7][e]);
        hi.x = pk2(v[8][e], v[9][e]); hi.y = pk2(v[10][e], v[11][e]); hi.z = pk2(v[12][e], v[13][e]); hi.w = pk2(v[14][e], v[15][e]);
        LAS v4u* d = (LAS v4u*)(scr + (4 * nn + e) * 36 + 8 * kk); d[0] = lo; d[1] = hi; }
    LDS_WAIT(); asm volatile("" ::: "memory");
    const int c = lane & 7, ns = lane >> 3;
#pragma unroll
    for (int q = 0; q < 8; ++q) { const int n = 8 * q + ns; const v4u o = *(const LAS v4u*)(scr + n * 36 + 4 * c); *(v4u*)(WT + (size_t)(nd0 + n) * K + k0 + 8 * c) = o; }
    LDS_WAIT(); asm volatile("" ::: "memory");
}
__device__ __forceinline__ void cs_entry(int pos, int i, float& c, float& s) {
    const float inv = exp2f(-(float)i * (13.287712379549449f / 32.0f));
    const float angf = (float)pos * inv; const double a = (double)angf;
    const double q = rint(a * 0.63661977236758134308); const double y = (a - q * 1.57079632679489655800) - q * 6.123233995736766e-17;
    const double y2 = y * y;
    const double sn = y * (1.0 + y2 * (-1.0 / 6 + y2 * (1.0 / 120 + y2 * (-1.0 / 5040 + y2 * (1.0 / 362880 + y2 * (-1.0 / 39916800 + y2 * (1.0 / 6227020800.0)))))));
    const double cn = 1.0 + y2 * (-0.5 + y2 * (1.0 / 24 + y2 * (-1.0 / 720 + y2 * (1.0 / 40320 + y2 * (-1.0 / 3628800 + y2 * (1.0 / 479001600.0 + y2 * (-1.0 / 87178291200.0)))))));
    const int qi = (int)((long long)q & 3);
    double cc, ss;
    if (qi == 0) { cc = cn; ss = sn; } else if (qi == 1) { cc = -sn; ss = cn; } else if (qi == 2) { cc = -cn; ss = -sn; } else { cc = sn; ss = -cn; }
    c = (float)cc; s = (float)ss;
}
using pg8::shfl_at; using pg8::shx;
__device__ __forceinline__ float wave_sum(float v, int lane) {
#pragma unroll
    for (int o = 1; o < 64; o <<= 1) v += shx(v, lane, o);
    return v;
}
constexpr int CV_PRO = 2112, CV_TOTAL = 23680;
__device__ __forceinline__ int cv_bound(int k) { return k <= 0 ? 2112 : k <= 1 ? 5362 : k <= 2 ? 8612 : k <= 3 ? 11862 : k <= 4 ? 14816 : k <= 5 ? 17770 : k <= 6 ? 20724 : 23680; }
__device__ __forceinline__ void cv_item(const Frame& F, int it, LAS unsigned* scr, int lane) {
    int r = it;
    if (r < 1408) { const int kb = r / 88, nb = r % 88, n0 = 64 * nb, pn = n0 >> 8, bj = (n0 >> 7) & 1, j0 = n0 & 127, ns0 = bj * DFF + 128 * pn + j0;
        tr_item64(F.in(I_WU1) + (size_t)0 * D * NUP, D, NUP, 64 * kb, ns0, 32, F.W<bf16>(WS_WUP + (size_t)0 * SZ_WUP), n0, F.in(I_NF1) + 0 * D, scr, lane); return; } r -= 1408;
    if (r < 704) { const int kb = r / 16, nb = r % 16;
        tr_item64(F.in(I_WD1) + (size_t)0 * DFF * D, DFF, D, 64 * kb, 64 * nb, 32, F.W<bf16>(WS_WDN + (size_t)0 * SZ_WDN), 64 * nb, nullptr, scr, lane); return; } r -= 704;
    if (r < 512) { const int kb = r / 32, nb = r % 32;
        tr_item64(F.in(I_WRIN) + (size_t)0 * D * 2048, D, 2048, 64 * kb, 64 * nb, 32, F.W<bf16>(WS_WRIN + (size_t)0 * SZ_WRIN), 64 * nb, F.in(I_NMIX) + 0 * D, scr, lane); return; } r -= 512;
    if (r < 64) { const int mb16 = r >> 2, q = r & 3, kb = q >> 1, nb = q & 1, ax = mb16 >> 3, blk = mb16 & 7, mb = (0 * 2 + ax) * 8 + blk;
        tr_item64(F.in(ax ? I_WGX : I_WGA) + (size_t)(0 * 8 + blk) * 16384, 128, 128, 64 * kb, 64 * nb, 32, F.W<bf16>(WS_WG + (size_t)mb * 32768), 64 * nb, nullptr, scr, lane); return; } r -= 64;
    if (r < 256) { const int kb = r / 16, nb = r % 16;
        tr_item64(F.in(I_WROUT) + (size_t)0 * D * D, D, D, 64 * kb, 64 * nb, 32, F.W<bf16>(WS_WROUT + (size_t)0 * SZ_WSQ), 64 * nb, nullptr, scr, lane); return; } r -= 256;
    if (r < 1408) { const int kb = r / 88, nb = r % 88, n0 = 64 * nb, pn = n0 >> 8, bj = (n0 >> 7) & 1, j0 = n0 & 127, ns0 = bj * DFF + 128 * pn + j0;
        tr_item64(F.in(I_WU2) + (size_t)0 * D * NUP, D, NUP, 64 * kb, ns0, 32, F.W<bf16>(WS_WUP + (size_t)1 * SZ_WUP), n0, F.in(I_NF2) + 0 * D, scr, lane); return; } r -= 1408;
    if (r < 704) { const int kb = r / 16, nb = r % 16;
        tr_item64(F.in(I_WD2) + (size_t)0 * DFF * D, DFF, D, 64 * kb, 64 * nb, 32, F.W<bf16>(WS_WDN + (size_t)1 * SZ_WDN), 64 * nb, nullptr, scr, lane); return; } r -= 704;
    if (r < 1408) { const int kb = r / 88, nb = r % 88, n0 = 64 * nb, pn = n0 >> 8, bj = (n0 >> 7) & 1, j0 = n0 & 127, ns0 = bj * DFF + 128 * pn + j0;
        tr_item64(F.in(I_WU1) + (size_t)1 * D * NUP, D, NUP, 64 * kb, ns0, 32, F.W<bf16>(WS_WUP + (size_t)2 * SZ_WUP), n0, F.in(I_NF1) + 1 * D, scr, lane); return; } r -= 1408;
    if (r < 704) { const int kb = r / 16, nb = r % 16;
        tr_item64(F.in(I_WD1) + (size_t)1 * DFF * D, DFF, D, 64 * kb, 64 * nb, 32, F.W<bf16>(WS_WDN + (size_t)2 * SZ_WDN), 64 * nb, nullptr, scr, lane); return; } r -= 704;
    if (r < 2304) { const int kb = r / 144, nb = r % 144, n0 = 64 * nb, pn = n0 >> 8, bj = (n0 >> 7) & 1, hh = (n0 >> 5) & 3, g = pn / 12, which = (pn % 12) >> 2, hq = pn & 3, ns0 = g * 3072 + which * 1024 + (4 * hq + hh) * 64 + 32 * bj;
        tr_item64(F.in(I_WQKV) + (size_t)0 * D * NQKV, D, NQKV, 64 * kb, ns0, 64, F.W<bf16>(WS_WQKV + (size_t)0 * SZ_WQKV), n0, F.in(I_NMIX) + 1 * D, scr, lane); return; } r -= 2304;
    if (r < 256) { const int kb = r / 16, nb = r % 16;
        tr_item64(F.in(I_WO) + (size_t)0 * D * D, D, D, 64 * kb, 64 * nb, 32, F.W<bf16>(WS_WO + (size_t)0 * SZ_WSQ), 64 * nb, nullptr, scr, lane); return; } r -= 256;
    if (r < 1408) { const int kb = r / 88, nb = r % 88, n0 = 64 * nb, pn = n0 >> 8, bj = (n0 >> 7) & 1, j0 = n0 & 127, ns0 = bj * DFF + 128 * pn + j0;
        tr_item64(F.in(I_WU2) + (size_t)1 * D * NUP, D, NUP, 64 * kb, ns0, 32, F.W<bf16>(WS_WUP + (size_t)3 * SZ_WUP), n0, F.in(I_NF2) + 1 * D, scr, lane); return; } r -= 1408;
    if (r < 704) { const int kb = r / 16, nb = r % 16;
        tr_item64(F.in(I_WD2) + (size_t)1 * DFF * D, DFF, D, 64 * kb, 64 * nb, 32, F.W<bf16>(WS_WDN + (size_t)3 * SZ_WDN), 64 * nb, nullptr, scr, lane); return; } r -= 704;
    if (r < 1408) { const int kb = r / 88, nb = r % 88, n0 = 64 * nb, pn = n0 >> 8, bj = (n0 >> 7) & 1, j0 = n0 & 127, ns0 = bj * DFF + 128 * pn + j0;
        tr_item64(F.in(I_WU1) + (size_t)2 * D * NUP, D, NUP, 64 * kb, ns0, 32, F.W<bf16>(WS_WUP + (size_t)4 * SZ_WUP), n0, F.in(I_NF1) + 2 * D, scr, lane); return; } r -= 1408;
    if (r < 704) { const int kb = r / 16, nb = r % 16;
        tr_item64(F.in(I_WD1) + (size_t)2 * DFF * D, DFF, D, 64 * kb, 64 * nb, 32, F.W<bf16>(WS_WDN + (size_t)4 * SZ_WDN), 64 * nb, nullptr, scr, lane); return; } r -= 704;
    if (r < 512) { const int kb = r / 32, nb = r % 32;
        tr_item64(F.in(I_WRIN) + (size_t)1 * D * 2048, D, 2048, 64 * kb, 64 * nb, 32, F.W<bf16>(WS_WRIN + (size_t)1 * SZ_WRIN), 64 * nb, F.in(I_NMIX) + 2 * D, scr, lane); return; } r -= 512;
    if (r < 64) { const int mb16 = r >> 2, q = r & 3, kb = q >> 1, nb = q & 1, ax = mb16 >> 3, blk = mb16 & 7, mb = (1 * 2 + ax) * 8 + blk;
        tr_item64(F.in(ax ? I_WGX : I_WGA) + (size_t)(1 * 8 + blk) * 16384, 128, 128, 64 * kb, 64 * nb, 32, F.W<bf16>(WS_WG + (size_t)mb * 32768), 64 * nb, nullptr, scr, lane); return; } r -= 64;
    if (r < 256) { const int kb = r / 16, nb = r % 16;
        tr_item64(F.in(I_WROUT) + (size_t)1 * D * D, D, D, 64 * kb, 64 * nb, 32, F.W<bf16>(WS_WROUT + (size_t)1 * SZ_WSQ), 64 * nb, nullptr, scr, lane); return; } r -= 256;
    if (r < 1408) { const int kb = r / 88, nb = r % 88, n0 = 64 * nb, pn = n0 >> 8, bj = (n0 >> 7) & 1, j0 = n0 & 127, ns0 = bj * DFF + 128 * pn + j0;
        tr_item64(F.in(I_WU2) + (size_t)2 * D * NUP, D, NUP, 64 * kb, ns0, 32, F.W<bf16>(WS_WUP + (size_t)5 * SZ_WUP), n0, F.in(I_NF2) + 2 * D, scr, lane); return; } r -= 1408;
    if (r < 704) { const int kb = r / 16, nb = r % 16;
        tr_item64(F.in(I_WD2) + (size_t)2 * DFF * D, DFF, D, 64 * kb, 64 * nb, 32, F.W<bf16>(WS_WDN + (size_t)5 * SZ_WDN), 64 * nb, nullptr, scr, lane); return; } r -= 704;
    if (r < 1408) { const int kb = r / 88, nb = r % 88, n0 = 64 * nb, pn = n0 >> 8, bj = (n0 >> 7) & 1, j0 = n0 & 127, ns0 = bj * DFF + 128 * pn + j0;
        tr_item64(F.in(I_WU1) + (size_t)3 * D * NUP, D, NUP, 64 * kb, ns0, 32, F.W<bf16>(WS_WUP + (size_t)6 * SZ_WUP), n0, F.in(I_NF1) + 3 * D, scr, lane); return; } r -= 1408;
    if (r < 704) { const int kb = r / 16, nb = r % 16;
        tr_item64(F.in(I_WD1) + (size_t)3 * DFF * D, DFF, D, 64 * kb, 64 * nb, 32, F.W<bf16>(WS_WDN + (size_t)6 * SZ_WDN), 64 * nb, nullptr, scr, lane); return; } r -= 704;
    if (r < 2304) { const int kb = r / 144, nb = r % 144, n0 = 64 * nb, pn = n0 >> 8, bj = (n0 >> 7) & 1, hh = (n0 >> 5) & 3, g = pn / 12, which = (pn % 12) >> 2, hq = pn & 3, ns0 = g * 3072 + which * 1024 + (4 * hq + hh) * 64 + 32 * bj;
        tr_item64(F.in(I_WQKV) + (size_t)1 * D * NQKV, D, NQKV, 64 * kb, ns0, 64, F.W<bf16>(WS_WQKV + (size_t)1 * SZ_WQKV), n0, F.in(I_NMIX) + 3 * D, scr, lane); return; } r -= 2304;
    if (r < 256) { const int kb = r / 16, nb = r % 16;
        tr_item64(F.in(I_WO) + (size_t)1 * D * D, D, D, 64 * kb, 64 * nb, 32, F.W<bf16>(WS_WO + (size_t)1 * SZ_WSQ), 64 * nb, nullptr, scr, lane); return; } r -= 256;
    if (r < 1408) { const int kb = r / 88, nb = r % 88, n0 = 64 * nb, pn = n0 >> 8, bj = (n0 >> 7) & 1, j0 = n0 & 127, ns0 = bj * DFF + 128 * pn + j0;
        tr_item64(F.in(I_WU2) + (size_t)3 * D * NUP, D, NUP, 64 * kb, ns0, 32, F.W<bf16>(WS_WUP + (size_t)7 * SZ_WUP), n0, F.in(I_NF2) + 3 * D, scr, lane); return; } r -= 1408;
    if (r < 704) { const int kb = r / 16, nb = r % 16;
        tr_item64(F.in(I_WD2) + (size_t)3 * DFF * D, DFF, D, 64 * kb, 64 * nb, 32, F.W<bf16>(WS_WDN + (size_t)7 * SZ_WDN), 64 * nb, nullptr, scr, lane); return; } r -= 704;
}
__device__ __forceinline__ void ph_prologue(const Frame& F0) { const Frame F = phase_frame(F0);
    LAS unsigned* scr = (LAS unsigned*)(F.lds + F.wave * 16384);
    const int gw = F.wg * NWAVES + F.wave, NGW = F.G * NWAVES, lane = F.lane;
    for (int it = gw; it < CV_PRO; it += NGW) cv_item(F, it, scr, lane);
    { float* CS = F.W<float>(WS_CS); const int gt = F.wg * NTHR + F.tid, NGT = F.G * NTHR;
      for (int e = gt; e < 8196 * 32; e += NGT) { float c, s; cs_entry(e >> 5, e & 31, c, s); CS[(size_t)(e >> 5) * 64 + (e & 31)] = c; CS[(size_t)(e >> 5) * 64 + 32 + (e & 31)] = s; } }
    { bf16* Xb = F.W<bf16>(WS_XB); float* SS = F.W<float>(WS_SS); float* SSS = F.W<float>(WS_SSS);
      for (int m0 = gw; m0 < MT; m0 += 4 * NGW) {
          f32x4 v[4][4];
#pragma unroll
          for (int q = 0; q < 4; ++q) { const int m = m0 + q * NGW; if (m < MT) { const float* src = m < MP ? F.in(I_XP) + (size_t)m * D : F.in(I_XS) + (size_t)(m - MP) * D;
#pragma unroll
              for (int j = 0; j < 4; ++j) v[q][j] = NT_WCONV ? __builtin_nontemporal_load((const f32x4*)src + lane + 64 * j) : *((const f32x4*)src + lane + 64 * j); } }
#pragma unroll
          for (int q = 0; q < 4; ++q) { const int m = m0 + q * NGW; if (m < MT) { float s = 0.f;
#pragma unroll
              for (int j = 0; j < 4; ++j) { const f32x4 x = v[q][j]; v2u w; w.x = pk2(x.x, x.y); w.y = pk2(x.z, x.w); *((v2u*)(Xb + (size_t)m * D) + lane + 64 * j) = w; s += (x.x * x.x + x.y * x.y) + (x.z * x.z + x.w * x.w); }
              s = wave_sum(s, lane);
              if (m < MP) { if (lane < 4) SS[(size_t)m * 4 + lane] = lane == 0 ? s : 0.f; }
              else { if (lane < 32) SSS[(size_t)(m - MP) * 32 + lane] = lane == 0 ? s : 0.f; } } }
      } }
}

template <int RT, bool PAIR128, int K, class Epi>
__device__ __forceinline__ void sample_gemm(const Frame& F, const bf16* A, const bf16* Bt, int ncg, const Epi& epi) {
    __syncthreads();
    LAS f32x4* red = (LAS f32x4*)F.lds;
    const int lane = F.lane, fr = lane & 15, fq = lane >> 4, w = F.wave;
    constexpr int ksl = K / 8, nst = ksl / 32; const int np = ncg * (8 / RT);
    for (int p = F.wg; p < np; p += F.G) {
        const int cg = p / (8 / RT), rtg = p % (8 / RT);
        const int base0 = PAIR128 ? 256 * (cg >> 3) + 16 * (cg & 7) : 32 * cg, base1 = PAIR128 ? base0 + 128 : base0 + 16;
        const bf16* w0p = Bt + (size_t)(base0 + fr) * K + w * ksl + 8 * fq; const bf16* w1p = Bt + (size_t)(base1 + fr) * K + w * ksl + 8 * fq;
        const bf16* xp = A + (size_t)(16 * rtg * RT + fr) * K + w * ksl + 8 * fq;
        bf16x8 w0[nst], w1[nst], x[nst][RT];
#pragma unroll
        for (int s = 0; s < nst; ++s) { w0[s] = *(const bf16x8*)(w0p + 32 * s); w1[s] = *(const bf16x8*)(w1p + 32 * s);
#pragma unroll
            for (int r = 0; r < RT; ++r) x[s][r] = *(const bf16x8*)(xp + (size_t)(16 * r) * K + 32 * s); }
        typename Epi::Pre pre{}; if (w < RT) pre = epi.prefetch(16 * (rtg * RT + w) + fr, cg, fq);
        f32x4 acc[RT][2];
#pragma unroll
        for (int r = 0; r < RT; ++r) { acc[r][0] = (f32x4){0.f, 0.f, 0.f, 0.f}; acc[r][1] = (f32x4){0.f, 0.f, 0.f, 0.f}; }
#pragma unroll
        for (int s = 0; s < nst; ++s)
#pragma unroll
            for (int r = 0; r < RT; ++r) { acc[r][0] = __builtin_amdgcn_mfma_f32_16x16x32_bf16(w0[s], x[s][r], acc[r][0], 0, 0, 0); acc[r][1] = __builtin_amdgcn_mfma_f32_16x16x32_bf16(w1[s], x[s][r], acc[r][1], 0, 0, 0); }
#pragma unroll
        for (int r = 0; r < RT; ++r) { red[((w * RT + r) * 2 + 0) * 64 + lane] = acc[r][0]; red[((w * RT + r) * 2 + 1) * 64 + lane] = acc[r][1]; }
        __syncthreads();
        for (int r = w; r < RT; r += NWAVES) {
            f32x4 v0 = (f32x4){0.f, 0.f, 0.f, 0.f}, v1 = v0;
#pragma unroll
            for (int ww = 0; ww < NWAVES; ++ww) { v0 += red[((ww * RT + r) * 2 + 0) * 64 + lane]; v1 += red[((ww * RT + r) * 2 + 1) * 64 + lane]; }
            epi(16 * (rtg * RT + r) + fr, cg, fq, v0, v1, lane, pre);
        }
        __syncthreads();
    }
}
__device__ __forceinline__ LAS float* sample_rs(const Frame& F) {
    __syncthreads();
    LAS float* rs = (LAS float*)(F.lds + RS_OFF);
    if (F.tid < MS) { const f32x4* p = (const f32x4*)(F.W<float>(WS_SSS) + (size_t)F.tid * 32); float s = 0.f;
#pragma unroll
        for (int i = 0; i < 8; ++i) { const f32x4 v = p[i]; s += (v.x + v.y) + (v.z + v.w); }
        rs[F.tid] = rsqrtf(s * (1.f / 1024.f) + 1e-6f); }
    __syncthreads();
    return rs;
}
using pg8::silu_mul; using pg8::gelu_tanh;
struct SEpiRes { bf16* Xb; float* SSS; const float* bias; float scale;
    struct Pre { v2u w0, w1; };
    __device__ __forceinline__ Pre prefetch(int srow, int cg, int fq) const { const bf16* xb = Xb + (size_t)(MP + srow) * D + 32 * cg + 4 * fq; Pre p; p.w0 = *(const v2u*)xb; p.w1 = *(const v2u*)(xb + 16); return p; }
    __device__ __forceinline__ void operator()(int srow, int cg, int fq, f32x4 v0, f32x4 v1, int lane, const Pre& pre) const {
        const int c = 32 * cg + 4 * fq; bf16* xb = Xb + (size_t)(MP + srow) * D + c;
        const v2u w0 = pre.w0, w1 = pre.w1;
        f32x4 x0 = (f32x4){bflo(w0.x), bfhi(w0.x), bflo(w0.y), bfhi(w0.y)}, x1 = (f32x4){bflo(w1.x), bfhi(w1.x), bflo(w1.y), bfhi(w1.y)};
        if (bias) { x0 += *(const f32x4*)(bias + c); x1 += *(const f32x4*)(bias + c + 16); }
        x0 += v0 * scale; x1 += v1 * scale;
        v2u a; a.x = pk2(x0.x, x0.y); a.y = pk2(x0.z, x0.w); *(v2u*)xb = a; a.x = pk2(x1.x, x1.y); a.y = pk2(x1.z, x1.w); *(v2u*)(xb + 16) = a;
        float ssq = (x0.x * x0.x + x0.y * x0.y) + (x0.z * x0.z + x0.w * x0.w) + (x1.x * x1.x + x1.y * x1.y) + (x1.z * x1.z + x1.w * x1.w);
        ssq += shx(ssq, lane, 16); ssq += shx(ssq, lane, 32);
        if (fq == 0) SSS[(size_t)srow * 32 + cg] = ssq; } };
struct SEpiRin { LAS float* rs; const float* bias; bf16* YB; bf16* XBR;
    struct Pre { int dummy; };
    __device__ __forceinline__ Pre prefetch(int, int, int) const { return Pre{0}; }
    __device__ __forceinline__ void operator()(int srow, int cg, int fq, f32x4 v0, f32x4 v1, int lane, const Pre& pre) const {
        const float r = rs[srow]; const int c = 32 * cg + 4 * fq;
        v0 = v0 * r + *(const f32x4*)(bias + c); v1 = v1 * r + *(const f32x4*)(bias + c + 16);
        const bool isy = c < 1024;
        if (isy) { v0.x = gelu_tanh(v0.x); v0.y = gelu_tanh(v0.y); v0.z = gelu_tanh(v0.z); v0.w = gelu_tanh(v0.w); v1.x = gelu_tanh(v1.x); v1.y = gelu_tanh(v1.y); v1.z = gelu_tanh(v1.z); v1.w = gelu_tanh(v1.w); }
        bf16* o = (isy ? YB : XBR) + (size_t)(MP + srow) * D + (isy ? c : c - 1024);
        v2u a; a.x = pk2(v0.x, v0.y); a.y = pk2(v0.z, v0.w); *(v2u*)o = a; a.x = pk2(v1.x, v1.y); a.y = pk2(v1.z, v1.w); *(v2u*)(o + 16) = a; } };
struct SEpiQkv { LAS float* rs; const float* CS; bf16* QKV; float* out; int j;
    struct Pre { int dummy; };
    __device__ __forceinline__ Pre prefetch(int, int, int) const { return Pre{0}; }
    __device__ __forceinline__ void operator()(int srow, int cg, int fq, f32x4 v0, f32x4 v1, int lane, const Pre& pre) const {
        const int pn = cg >> 3, sub = cg & 7, g = pn / 12, which = (pn % 12) >> 2, hq = pn & 3, head = 4 * hq + (sub >> 1), dd = 16 * (sub & 1) + 4 * fq;
        const float r = rs[srow]; v0 *= r; v1 *= r;
        if (which < 2) { const int pos = SEQ + (srow & 3); const f32x4 c4 = *(const f32x4*)(CS + (size_t)pos * 64 + dd), s4 = *(const f32x4*)(CS + (size_t)pos * 64 + 32 + dd); const f32x4 x1 = v0, x2 = v1; v0 = x1 * c4 - x2 * s4; v1 = x2 * c4 + x1 * s4;
            if (which == 0) { v0 *= 0.125f; v1 *= 0.125f; } }
        bf16* o = QKV + (size_t)(MP + srow) * NQKV + g * 3072 + which * 1024 + head * 64 + dd;
        v2u a; a.x = pk2(v0.x, v0.y); a.y = pk2(v0.z, v0.w); *(v2u*)o = a; a.x = pk2(v1.x, v1.y); a.y = pk2(v1.z, v1.w); *(v2u*)(o + 32) = a;
        if (which >= 1) { float* kp = out + (g == 0 ? O_KV128S : (g == 1 ? O_KV512S : O_KV2048S)) + (size_t)j * 32 * 4 * 2048 + ((size_t)srow * 2 + (which - 1)) * 1024 + head * 64 + dd; *(f32x4*)kp = v0; *(f32x4*)(kp + 32) = v1; } } };

#ifndef ATT_SPLIT
#define ATT_SPLIT 1
#endif
#define SUBT(id, ...) do { unsigned long long s0_ = 0; if (TPROBE == (id)) s0_ = __builtin_amdgcn_s_memrealtime(); __VA_ARGS__; if (TPROBE == (id)) tsub += __builtin_amdgcn_s_memrealtime() - s0_; } while (0)
#ifndef TAMP
#define TAMP 8
#endif
#define GEMM_SP2 true
__device__ __forceinline__ unsigned long long ph_up(const Frame& F0, int l, int f) { const Frame F = phase_frame(F0); unsigned long long tsub = 0;
    const int mat = l * 2 + f; const bf16* Bt = F.W<bf16>(WS_WUP + mat * SZ_WUP);
    LAS float* rs = sample_rs(F);
    pg8::Gemm g{F.W<bf16>(WS_XB), Bt, MTP, NUP, D}; pg8::StaticOrder S; S.init(MTP, NUP, F.G, F.wg);
    pg8::EpiUp E{F.W<float>(WS_SS), F.W<bf16>(WS_HID), rs};
    SUBT(22, if (F.wg >= 150 && mat < 7) { LAS unsigned* scr = (LAS unsigned*)(F.lds + F.wave * 16384); const int lo = cv_bound(mat), hi = cv_bound(mat + 1);
        for (int it = lo + (F.wg - 150) * NWAVES + F.wave; it < hi; it += 106 * NWAVES) cv_item(F, it, scr, F.lane);
        __syncthreads(); });
    SUBT(23, if (TPROBE_PH == 1) tsub += pg8::gemm_phase<pg8::EpiUp, pg8::StaticOrder, true, GEMM_SP2>(F.lds, g, S, E, F.tid); else (void)pg8::gemm_phase<pg8::EpiUp, pg8::StaticOrder, true, GEMM_SP2>(F.lds, g, S, E, F.tid));
    return tsub;
}
__device__ __forceinline__ unsigned long long ph_res(const Frame& F0, const bf16* A, const bf16* Bt, int K, const float* bias, float scale) { const Frame F = phase_frame(F0); unsigned long long tsub = 0;
    const bool sfirst = SAMPLE_ALT && ((F.wg >> 3) & 1);
    if (sfirst) { SEpiRes E{F.W<bf16>(WS_XB), F.W<float>(WS_SSS), bias, scale};
      SUBT(21, if (K == D) sample_gemm<1, false, D, SEpiRes>(F, A + (size_t)MP * D, Bt, D / 32, E); else sample_gemm<1, false, DFF, SEpiRes>(F, A + (size_t)MP * DFF, Bt, D / 32, E)); }
    { pg8::Gemm g{A, Bt, MP, D, K}; pg8::StaticOrder S; S.init(MP, D, F.G, F.wg);
      pg8::EpiRes E{F.W<bf16>(WS_XB), F.W<float>(WS_SS), bias, scale};
      SUBT(20, if (TPROBE_PH == 2) tsub += pg8::gemm_phase<pg8::EpiRes, pg8::StaticOrder, false, GEMM_SP2>(F.lds, g, S, E, F.tid); else (void)pg8::gemm_phase<pg8::EpiRes, pg8::StaticOrder, false, GEMM_SP2>(F.lds, g, S, E, F.tid)); }
    if (!sfirst) { SEpiRes E{F.W<bf16>(WS_XB), F.W<float>(WS_SSS), bias, scale};
      SUBT(21, if (K == D) sample_gemm<1, false, D, SEpiRes>(F, A + (size_t)MP * D, Bt, D / 32, E); else sample_gemm<1, false, DFF, SEpiRes>(F, A + (size_t)MP * DFF, Bt, D / 32, E)); }
    return tsub;
}
__device__ __forceinline__ void ph_rin(const Frame& F0, int j) { const Frame F = phase_frame(F0);
    const bf16* Bt = F.W<bf16>(WS_WRIN + j * SZ_WRIN); const float* bias = F.in(I_BRIN) + j * 2048;
    const bool sfirst = SAMPLE_ALT && ((F.wg >> 3) & 1);
    if (sfirst) { LAS float* rs = sample_rs(F); SEpiRin E{rs, bias, F.W<bf16>(WS_YB), F.W<bf16>(WS_XBR)};
      sample_gemm<2, false, D, SEpiRin>(F, F.W<bf16>(WS_XB) + (size_t)MP * D, Bt, 2048 / 32, E); }
    { pg8::Gemm g{F.W<bf16>(WS_XB), Bt, MP, 2048, D}; pg8::StaticOrder S; S.init(MP, 2048, F.G, F.wg);
      pg8::EpiRin E{F.W<float>(WS_SS), bias, F.W<bf16>(WS_YB), F.W<bf16>(WS_XBR)};
      pg8::gemm_phase<pg8::EpiRin, pg8::StaticOrder, true, GEMM_SP2>(F.lds, g, S, E, F.tid); }
    if (!sfirst) { LAS float* rs = sample_rs(F); SEpiRin E{rs, bias, F.W<bf16>(WS_YB), F.W<bf16>(WS_XBR)};
      sample_gemm<2, false, D, SEpiRin>(F, F.W<bf16>(WS_XB) + (size_t)MP * D, Bt, 2048 / 32, E); }
}
__device__ __forceinline__ unsigned long long ph_qkv(const Frame& F0, int j) { const Frame F = phase_frame(F0); unsigned long long tq_ = 0;
    const bf16* Bt = F.W<bf16>(WS_WQKV + j * SZ_WQKV);
    const bool sfirst = SAMPLE_ALT && ((F.wg >> 3) & 1);
    if (sfirst) { LAS float* rs = sample_rs(F);
      SEpiQkv E{rs, F.W<float>(WS_CS), F.W<bf16>(WS_QKV), F.outp(), j};
      sample_gemm<8, true, D, SEpiQkv>(F, F.W<bf16>(WS_XB) + (size_t)MP * D, Bt, NQKV / 32, E); }
    { pg8::Gemm g{F.W<bf16>(WS_XB), Bt, MP, NQKV, D}; pg8::StaticOrder S; S.init(MP, NQKV, F.G, F.wg);
      static_assert(O_KV128P == 17186816 && O_KV512P == 18759680 && O_KV2048P == 23478272, "EpiQkv offsets");
      pg8::EpiQkv E{F.W<float>(WS_SS), F.W<float>(WS_CS), F.W<bf16>(WS_QKV), F.outp(), j, F.lds + EPI_STAGE_OFF};
      if (TPROBE_PH == 7) tq_ = pg8::gemm_phase<pg8::EpiQkv, pg8::StaticOrder, true, GEMM_SP2>(F.lds, g, S, E, F.tid); else (void)pg8::gemm_phase<pg8::EpiQkv, pg8::StaticOrder, true, GEMM_SP2>(F.lds, g, S, E, F.tid); }
    if (!sfirst) { LAS float* rs = sample_rs(F);
      SEpiQkv E{rs, F.W<float>(WS_CS), F.W<bf16>(WS_QKV), F.outp(), j};
      sample_gemm<8, true, D, SEpiQkv>(F, F.W<bf16>(WS_XB) + (size_t)MP * D, Bt, NQKV / 32, E); }
    return tq_;
}

__device__ __forceinline__ void ph_merge(const Frame& F0) { const Frame F = phase_frame(F0);
    const bf16* OG = F.W<bf16>(WS_OG); const float* LSE = F.W<float>(WS_LSE); bf16* OM = F.W<bf16>(WS_AOP);
    for (int idx = F.wg * NTHR + F.tid; idx < MT * 128; idx += F.G * NTHR) {
        const size_t row = idx >> 7; const int c8 = idx & 127, head = c8 >> 3; const size_t off = row * D + 8 * c8;
        const v4u a0 = *(const v4u*)(OG + off), a1 = *(const v4u*)(OG + (size_t)MT * D + off), a2 = *(const v4u*)(OG + 2 * (size_t)MT * D + off);
        const float l0 = LSE[row * 16 + head], l1 = LSE[((size_t)MT + row) * 16 + head], l2 = LSE[(2 * (size_t)MT + row) * 16 + head];
        const float mx = fmaxf(l0, fmaxf(l1, l2)); float w0 = __expf(l0 - mx), w1 = __expf(l1 - mx), w2 = __expf(l2 - mx); const float inv = 1.f / (w0 + w1 + w2); w0 *= inv; w1 *= inv; w2 *= inv;
        v4u o;
        o.x = pg8::cvt_pk_bf16(w0 * bflo(a0.x) + w1 * bflo(a1.x) + w2 * bflo(a2.x), w0 * bfhi(a0.x) + w1 * bfhi(a1.x) + w2 * bfhi(a2.x));
        o.y = pg8::cvt_pk_bf16(w0 * bflo(a0.y) + w1 * bflo(a1.y) + w2 * bflo(a2.y), w0 * bfhi(a0.y) + w1 * bfhi(a1.y) + w2 * bfhi(a2.y));
        o.z = pg8::cvt_pk_bf16(w0 * bflo(a0.z) + w1 * bflo(a1.z) + w2 * bflo(a2.z), w0 * bfhi(a0.z) + w1 * bfhi(a1.z) + w2 * bfhi(a2.z));
        o.w = pg8::cvt_pk_bf16(w0 * bflo(a0.w) + w1 * bflo(a1.w) + w2 * bflo(a2.w), w0 * bfhi(a0.w) + w1 * bfhi(a1.w) + w2 * bfhi(a2.w));
        *(v4u*)(OM + off) = o;
    }
}
__device__ __forceinline__ void ph_final(const Frame& F0) { const Frame F = phase_frame(F0);
    const bf16* Xb = F.W<bf16>(WS_XB); const float* SS = F.W<float>(WS_SS); const float* SSS = F.W<float>(WS_SSS); const float* gf = F.in(I_NFIN);
    const int gw = F.wg * NWAVES + F.wave, NGW = F.G * NWAVES, lane = F.lane;
    for (int m = gw; m < MT; m += NGW) {
        float s;
        if (m < MP) { const f32x4 v = *(const f32x4*)(SS + (size_t)m * 4); s = (v.x + v.y) + (v.z + v.w); }
        else { const float v = lane < 32 ? SSS[(size_t)(m - MP) * 32 + lane] : 0.f; s = wave_sum(v, lane); }
        const float rs = rsqrtf(s * (1.f / 1024.f) + 1e-6f);
#pragma unroll
        for (int jj = 0; jj < 4; ++jj) { const v2u xw = *((const v2u*)(Xb + (size_t)m * D) + lane + 64 * jj); const f32x4 v = (f32x4){bflo(xw.x), bfhi(xw.x), bflo(xw.y), bfhi(xw.y)}; const f32x4 gg = *((const f32x4*)gf + lane + 64 * jj);
            { const f32x4 yv = v * rs * gg; f32x4* yp = (f32x4*)(F.outp() + O_Y + (size_t)m * D) + lane + 64 * jj; if (NT_OUT) __builtin_nontemporal_store(yv, yp); else *yp = yv; } }
    }
}

constexpr int XP = 132, YP = 136;
constexpr int SC_XC = 0, SC_Y = 64 * XP * 4;
struct ScanW { bf16x8 wa[4], wx[4]; float ba, bx, m8sp; };
__device__ __forceinline__ float sigm(float x) { return __builtin_amdgcn_rcpf(1.f + __builtin_amdgcn_exp2f(-1.4426950408889634f * x)); }
__device__ __forceinline__ void scan_load_w(const Frame& F, int j, int blk, int w, int fr, int fq, ScanW& W) {
    const bf16* wa = F.W<bf16>(WS_WG + (size_t)((j * 2 + 0) * 8 + blk) * 32768) + (size_t)(16 * w + fr) * 128 + 8 * fq;
    const bf16* wx = F.W<bf16>(WS_WG + (size_t)((j * 2 + 1) * 8 + blk) * 32768) + (size_t)(16 * w + fr) * 128 + 8 * fq;
#pragma unroll
    for (int ks = 0; ks < 4; ++ks) { W.wa[ks] = *(const bf16x8*)(wa + 32 * ks); W.wx[ks] = *(const bf16x8*)(wx + 32 * ks); }
    const int ch = j * D + blk * 128 + 16 * w + fr;
    W.ba = F.in(I_BGA)[ch]; W.bx = F.in(I_BGX)[ch]; W.m8sp = -8.0f * 1.4426950408889634f * log1pf(expf(-F.in(I_LAM)[ch]));
}
__device__ __forceinline__ void scan_rowtile(const LAS float* xc, const LAS bf16* xb, const ScanW& W, int fr, int fq, int cl, float (&a)[4], float (&b)[4]) {
    f32x4 da = (f32x4){0.f, 0.f, 0.f, 0.f}, dx = da;
#pragma unroll
    for (int ks = 0; ks < 4; ++ks) {
        const bf16x8 af = *(const LAS bf16x8*)(xb + fr * YP + 32 * ks + 8 * fq);
        da = __builtin_amdgcn_mfma_f32_16x16x32_bf16(af, W.wa[ks], da, 0, 0, 0); dx = __builtin_amdgcn_mfma_f32_16x16x32_bf16(af, W.wx[ks], dx, 0, 0, 0);
    }
#pragma unroll
    for (int i = 0; i < 4; ++i) {
        const float xcv = xc[(4 * fq + i) * XP + cl]; const float ga = sigm(da[i] + W.ba), gx = sigm(dx[i] + W.bx);
        const float ai = __builtin_amdgcn_exp2f(W.m8sp * ga); a[i] = ai; b[i] = __builtin_amdgcn_sqrtf(fmaxf(1.f - ai * ai, 0.f)) * gx * xcv;
    }
}
constexpr int SC_P = SC_Y + 64 * YP * 2, SC_XB = SC_P + 64 * YP * 2;
__device__ __forceinline__ void ph_scan(const Frame& F0, int j) { const Frame F = phase_frame(F0);
    __syncthreads();
    const int wg = F.wg, b = wg >> 7, blk = (wg >> 4) & 7, span = wg & 15;
    const int lane = F.lane, fr = lane & 15, fq = lane >> 4, w = F.wave, cl = 16 * w + fr, ch = blk * 128 + cl;
    LAS float* xc = (LAS float*)(F.lds + SC_XC); LAS bf16* yt = (LAS bf16*)(F.lds + SC_Y); LAS bf16* pt = (LAS bf16*)(F.lds + SC_P); LAS bf16* xbt = (LAS bf16*)(F.lds + SC_XB);
    const bf16* XBR = F.W<bf16>(WS_XBR); bf16* YB = F.W<bf16>(WS_YB); bf16* HY = F.W<bf16>(WS_AOP);
    float2* CARRY = F.W<float2>(WS_CARRY);
    const int c4 = F.tid & 31, tq = F.tid >> 5;
    if (wg < 256) {
    ScanW W; scan_load_w(F, j, blk, w, fr, fq, W);
    f32x4 cw[4], cb;
#pragma unroll
    for (int k = 0; k < 4; ++k) cw[k] = *(const f32x4*)(F.in(I_WCONV) + (size_t)(j * 4 + k) * D + blk * 128 + 4 * c4);
    cb = *(const f32x4*)(F.in(I_BCONV) + (size_t)j * D + blk * 128 + 4 * c4);
    float h = 0.f, ptot = 1.f;
    const int t0 = span * 512; const size_t rowb = (size_t)b * SEQ + t0;
    v2u xr[7], yr[4];
#define SCAN_LOAD(k) do { _Pragma("unroll") for (int rr = 0; rr < 7; ++rr) { const int tt = t0 + 64 * (k) + 4 * tq - 3 + rr; \
        const v2u xl_ = *(const v2u*)(XBR + ((size_t)b * SEQ + (tt < 0 ? 0 : tt)) * D + blk * 128 + 4 * c4); xr[rr].x = tt >= 0 ? xl_.x : 0u; xr[rr].y = tt >= 0 ? xl_.y : 0u; } \
        _Pragma("unroll") for (int i = 0; i < 4; ++i) yr[i] = *(const v2u*)(YB + (rowb + 64 * (k) + 4 * tq + i) * D + blk * 128 + 4 * c4); } while (0)
    SCAN_LOAD(0);
    for (int k = 0; k < 8; ++k) {
#pragma unroll
        for (int i = 0; i < 4; ++i) { f32x4 o = cb;
#pragma unroll
            for (int kk = 0; kk < 4; ++kk) { const v2u x = xr[i + kk]; o += cw[kk] * (f32x4){bflo(x.x), bfhi(x.x), bflo(x.y), bfhi(x.y)}; }
            *(LAS f32x4*)(xc + (4 * tq + i) * XP + 4 * c4) = o; { v2u ob; ob.x = pk2(o.x, o.y); ob.y = pk2(o.z, o.w); *(LAS v2u*)(xbt + (4 * tq + i) * YP + 4 * c4) = ob; }
            *(LAS v2u*)(yt + (4 * tq + i) * YP + 4 * c4) = yr[i]; }
        __syncthreads();
        if (k + 1 < 8) SCAN_LOAD(k + 1);
        float a[4][4], bb[4][4], A4[4], B4[4];
#pragma unroll
        for (int rt = 0; rt < 4; ++rt) { scan_rowtile(xc + 16 * rt * XP, xbt + 16 * rt * YP, W, fr, fq, cl, a[rt], bb[rt]);
            A4[rt] = (a[rt][0] * a[rt][1]) * (a[rt][2] * a[rt][3]); B4[rt] = ((bb[rt][0] * a[rt][1] + bb[rt][1]) * a[rt][2] + bb[rt][2]) * a[rt][3] + bb[rt][3]; }
        float As[4][4], Bs[4][4];
#pragma unroll
        for (int rt = 0; rt < 4; ++rt)
#pragma unroll
            for (int q = 0; q < 4; ++q) { As[rt][q] = shfl_at(A4[rt], fr + 16 * q); Bs[rt][q] = shfl_at(B4[rt], fr + 16 * q); }
#pragma unroll
        for (int rt = 0; rt < 4; ++rt) {
            const float h1 = As[rt][0] * h + Bs[rt][0], h2 = As[rt][1] * h1 + Bs[rt][1], h3 = As[rt][2] * h2 + Bs[rt][2], h4 = As[rt][3] * h3 + Bs[rt][3];
            const float p1 = As[rt][0] * ptot, p2 = As[rt][1] * p1, p3 = As[rt][2] * p2, p4 = As[rt][3] * p3;
            float hh = fq == 0 ? h : (fq == 1 ? h1 : (fq == 2 ? h2 : h3)), pp = fq == 0 ? ptot : (fq == 1 ? p1 : (fq == 2 ? p2 : p3));
#pragma unroll
            for (int i = 0; i < 4; ++i) { hh = a[rt][i] * hh + bb[rt][i]; pp *= a[rt][i]; const int o = (16 * rt + 4 * fq + i) * YP + cl; const float yv = bf2f(yt[o]); yt[o] = (bf16)f2bf(hh * yv); pt[o] = (bf16)f2bf(pp * yv); }
            h = h4; ptot = p4;
        }
        __syncthreads();
        { const int r = F.tid >> 3, sg = F.tid & 7; const size_t go = (rowb + 64 * k + r) * D + blk * 128 + 16 * sg;
          const LAS v4u* s = (const LAS v4u*)(yt + r * YP + 16 * sg); v4u* d = (v4u*)(HY + go); d[0] = s[0]; d[1] = s[1];
          const LAS v4u* s2 = (const LAS v4u*)(pt + r * YP + 16 * sg); v4u* d2 = (v4u*)(YB + go); d2[0] = s2[0]; d2[1] = s2[1]; }
        __syncthreads();
    }
#undef SCAN_LOAD
    if (fq == 0) CARRY[(size_t)(b * 16 + span) * D + ch] = make_float2(ptot, h);
    if (span == 15 && F.tid < 384) { const int i = F.tid >> 7, c = F.tid & 127; F.outp()[O_CP + ((size_t)(j * 2 + b) * 3 + i) * D + blk * 128 + c] = bf2f(XBR[((size_t)b * SEQ + SEQ - 3 + i) * D + blk * 128 + c]); }
    }
    if (wg < 64) {
        __syncthreads();
        const int rt8 = wg >> 3, sblk = wg & 7, sch = sblk * 128 + cl;
        ScanW W; scan_load_w(F, j, sblk, w, fr, fq, W);
        { const int tok = tq, n = 4 * rt8 + (tok >> 2), t = tok & 3; f32x4 o = *(const f32x4*)(F.in(I_BCONV) + (size_t)j * D + sblk * 128 + 4 * c4);
#pragma unroll
          for (int kk = 0; kk < 4; ++kk) { const int tt = t + kk - 3; f32x4 xv;
              if (tt >= 0) { const v2u x = *(const v2u*)(XBR + ((size_t)MP + 4 * n + tt) * D + sblk * 128 + 4 * c4); xv = (f32x4){bflo(x.x), bfhi(x.x), bflo(x.y), bfhi(x.y)}; }
              else xv = *(const f32x4*)(F.in(I_STC) + ((size_t)(j * NSQ + n) * 3 + (tt + 3)) * D + sblk * 128 + 4 * c4);
              o += *(const f32x4*)(F.in(I_WCONV) + (size_t)(j * 4 + kk) * D + sblk * 128 + 4 * c4) * xv; }
          *(LAS f32x4*)(xc + tok * XP + 4 * c4) = o; { v2u ob; ob.x = pk2(o.x, o.y); ob.y = pk2(o.z, o.w); *(LAS v2u*)(xbt + tok * YP + 4 * c4) = ob; }
          *(LAS v2u*)(yt + tok * YP + 4 * c4) = *(const v2u*)(YB + ((size_t)MP + 4 * n + t) * D + sblk * 128 + 4 * c4); }
        __syncthreads();
        { float a[4], bb[4]; scan_rowtile(xc, xbt, W, fr, fq, cl, a, bb);
          const int n = 4 * rt8 + fq; float hh = F.in(I_STH)[(size_t)(j * NSQ + n) * D + sch];
#pragma unroll
          for (int i = 0; i < 4; ++i) { hh = a[i] * hh + bb[i]; LAS bf16* yp = yt + (4 * fq + i) * YP + cl; *yp = (bf16)f2bf(hh * bf2f(*yp)); }
          F.outp()[O_HS + (size_t)(j * NSQ + n) * D + sch] = hh; }
        __syncthreads();
        if (F.tid < 128) { const int r = F.tid >> 3, sg = F.tid & 7; const LAS v4u* s = (const LAS v4u*)(yt + r * YP + 16 * sg); v4u* d = (v4u*)(HY + ((size_t)MP + 16 * rt8 + r) * D + sblk * 128 + 16 * sg); d[0] = s[0]; d[1] = s[1]; }
        for (int e = F.tid; e < 4 * 3 * 128; e += NTHR) { const int c = e & 127, i = (e >> 7) % 3, sq = e / 384, n = 4 * rt8 + sq;
            F.outp()[O_CS + ((size_t)(j * NSQ + n) * 3 + i) * D + sblk * 128 + c] = bf2f(XBR[((size_t)MP + 4 * n + 1 + i) * D + sblk * 128 + c]); }
    }
}

__device__ __forceinline__ void ph_scan_fix(const Frame& F0, int j) { const Frame F = phase_frame(F0);
    __syncthreads();
    const int wg = F.wg, b = wg >> 7, blk = (wg >> 4) & 7, span = wg & 15;
    if (span == 0) return;
    LAS float* hin = (LAS float*)F.lds;
    const float2* CARRY = F.W<float2>(WS_CARRY); const bf16* PY = F.W<bf16>(WS_YB); bf16* HY = F.W<bf16>(WS_AOP);
    if (F.tid < 128) { const int ch = blk * 128 + F.tid; float h = 0.f;
        for (int s = 0; s < span; ++s) { const float2 cv = CARRY[(size_t)(b * 16 + s) * D + ch]; h = cv.x * h + cv.y; }
        hin[F.tid] = h;
        if (span == 15) { const float2 cv = CARRY[(size_t)(b * 16 + 15) * D + ch]; F.outp()[O_HP + (size_t)(j * 2 + b) * D + ch] = cv.x * h + cv.y; } }
    __syncthreads();
    const int c8 = F.tid & 15, r = F.tid >> 4; float hv[8];
#pragma unroll
    for (int e = 0; e < 8; ++e) hv[e] = hin[8 * c8 + e];
    const size_t rowb = (size_t)b * SEQ + span * 512;
#pragma unroll 4
    for (int it = 0; it < 16; ++it) { const size_t go = (rowb + 32 * it + r) * D + blk * 128 + 8 * c8;
        const v4u hl = *(const v4u*)(HY + go), pv = *(const v4u*)(PY + go); v4u o;
        o.x = pk2(bflo(hl.x) + bflo(pv.x) * hv[0], bfhi(hl.x) + bfhi(pv.x) * hv[1]); o.y = pk2(bflo(hl.y) + bflo(pv.y) * hv[2], bfhi(hl.y) + bfhi(pv.y) * hv[3]);
        o.z = pk2(bflo(hl.z) + bflo(pv.z) * hv[4], bfhi(hl.z) + bfhi(pv.z) * hv[5]); o.w = pk2(bflo(hl.w) + bflo(pv.w) * hv[6], bfhi(hl.w) + bfhi(pv.w) * hv[7]);
        *(v4u*)(HY + go) = o; }
}

constexpr int KP = 72;
constexpr int AT_HALF = 128 * KP * 2, AT_K = 0, AT_V = 2 * AT_HALF;
typedef short s16x4 __attribute__((ext_vector_type(4)));
typedef short v4i16_t __attribute__((ext_vector_type(4)));
__device__ __forceinline__ s16x4 vtr(const LAS unsigned char* p) { return __builtin_bit_cast(s16x4, __builtin_amdgcn_ds_read_tr16_b64_v4i16((LAS v4i16_t*)p)); }
__device__ __forceinline__ void attn_decode(int u, int& g, int& b, int& head, int& r, int& nb) { const int combo = u >> 6, idx = u & 63; g = combo >> 5; b = (combo >> 4) & 1; head = combo & 15; r = idx >> (6 - 2 * g); nb = idx & ((64 >> (2 * g)) - 1); }
template <bool LAST>
__device__ __forceinline__ void ph_attn(const Frame& F0, int j, int ulo, int uhi) { const Frame F = phase_frame(F0);
    if (ulo >= uhi) return;
    __syncthreads();
    const int lane = F.lane, fr = lane & 15, fq = lane >> 4, w = F.wave, tid = F.tid;
    const bf16* QKV = F.W<bf16>(WS_QKV); bf16* OG = F.W<bf16>(WS_OG); float* LSE = F.W<float>(WS_LSE); bf16* OM = F.W<bf16>(WS_AOP);
    LAS unsigned char* lds = F.lds;
    constexpr int UPW = LAST ? 8 : 16; const int ubase = LAST ? 4096 + F.wg * UPW : F.wg * UPW;
#define AT_GLOAD(dst, g_, b_, head_, r_, blk_) do { _Pragma("unroll") for (int i = 0; i < 4; ++i) { const int c = tid + 512 * i, wh = c >> 10, row = (c >> 3) & 127, sg = c & 7; \
        dst[i] = (blk_) < 0 ? (v4u){0u, 0u, 0u, 0u} : *(const v4u*)(QKV + ((((size_t)((g_) * 3 + 1 + wh) * 2 + (b_)) * 16 + (head_)) * 8192 + ((r_) << (13 - 2 * (g_))) + (blk_) * 128 + row) * 64 + 8 * sg); } } while (0)
#define AT_LSTORE(src, blk_) do { _Pragma("unroll") for (int i = 0; i < 4; ++i) { const int c = tid + 512 * i, wh = c >> 10, row = (c >> 3) & 127, sg = c & 7; \
        *(LAS v4u*)(lds + wh * AT_V + ((blk_) & 1) * AT_HALF + (row * KP + 8 * sg) * 2) = src[i]; } } while (0)
    v4u ncur[4], nprev[4]; bf16x8 qn[2];
#define AT_QLOAD(g_, b_, head_, r_, nb_) do { const bf16* qp_ = QKV + ((((size_t)((g_) * 3) * 2 + (b_)) * 16 + (head_)) * 8192 + ((r_) << (13 - 2 * (g_))) + (nb_) * 128 + 16 * w + fr) * 64 + 8 * fq; qn[0] = *(const bf16x8*)qp_; qn[1] = *(const bf16x8*)(qp_ + 32); } while (0)
    int g, b, head, r, nb; attn_decode(ubase + ulo, g, b, head, r, nb);
    AT_GLOAD(ncur, g, b, head, r, nb); AT_GLOAD(nprev, g, b, head, r, nb - 1); AT_QLOAD(g, b, head, r, nb);
    bool need_prev = true;
    for (int ui = ulo; ui < uhi; ++ui) {
        AT_LSTORE(ncur, nb); if (need_prev) AT_LSTORE(nprev, nb - 1);
        bf16x8 qf[2]; qf[0] = qn[0]; qf[1] = qn[1];
        __syncthreads();
        const size_t qrow = (size_t)b * SEQ + (((nb * 128 + 16 * w + fr) << (2 * g)) + r);
        int g2 = g, b2 = b, head2 = head, r2 = r, nb2 = nb; bool np2 = false;
        if (ui + 1 < uhi) { attn_decode(ubase + ui + 1, g2, b2, head2, r2, nb2); np2 = !(g2 == g && b2 == b && head2 == head && r2 == r && nb2 == nb + 1);
            AT_GLOAD(ncur, g2, b2, head2, r2, nb2); if (np2) AT_GLOAD(nprev, g2, b2, head2, r2, nb2 - 1); AT_QLOAD(g2, b2, head2, r2, nb2); }
        const int lr = lane >> 3, l8 = lane & 7;
        const size_t orow0 = (size_t)b * SEQ + (((nb * 128 + 16 * w + lr) << (2 * g)) + r), orow1 = orow0 + ((size_t)8 << (2 * g));
        v4u ma0[2], ma1[2]; float ml0[2] = {0.f, 0.f}, ml1[2] = {0.f, 0.f};
        if (LAST) { ma0[0] = *(const v4u*)(OG + orow0 * D + head * 64 + 8 * l8); ma0[1] = *(const v4u*)(OG + orow1 * D + head * 64 + 8 * l8);
            ma1[0] = *(const v4u*)(OG + ((size_t)MT + orow0) * D + head * 64 + 8 * l8); ma1[1] = *(const v4u*)(OG + ((size_t)MT + orow1) * D + head * 64 + 8 * l8);
            ml0[0] = LSE[orow0 * 16 + head]; ml0[1] = LSE[orow1 * 16 + head]; ml1[0] = LSE[((size_t)MT + orow0) * 16 + head]; ml1[1] = LSE[((size_t)MT + orow1) * 16 + head]; }
        f32x4 sacc[9];
        { bf16x8 kf[9][2];
#pragma unroll
          for (int jj = 0; jj < 9; ++jj) { const int kt = w + jj; const int blk = kt < 8 ? nb - 1 : nb;
              const LAS unsigned char* kp = lds + AT_K + (blk & 1) * AT_HALF + (((kt & 7) * 16 + fr) * KP + 8 * fq) * 2;
              kf[jj][0] = *(const LAS bf16x8*)kp; kf[jj][1] = *(const LAS bf16x8*)(kp + 64); }
          __builtin_amdgcn_sched_barrier(0);
#pragma unroll
          for (int jj = 0; jj < 9; ++jj) { f32x4 s = (f32x4){0.f, 0.f, 0.f, 0.f};
              s = __builtin_amdgcn_mfma_f32_16x16x32_bf16(kf[jj][0], qf[0], s, 0, 0, 0); s = __builtin_amdgcn_mfma_f32_16x16x32_bf16(kf[jj][1], qf[1], s, 0, 0, 0); sacc[jj] = s; } }
        const float NEG = -1e30f; float mx = NEG;
#pragma unroll
        for (int i = 0; i < 4; ++i) { if (4 * fq + i < fr) sacc[0][i] = NEG; if (4 * fq + i > fr) sacc[8][i] = NEG; }
        if (nb == 0) {
#pragma unroll
            for (int jj = 0; jj < 8; ++jj) if (w + jj < 8) sacc[jj] = (f32x4){NEG, NEG, NEG, NEG}; }
#pragma unroll
        for (int jj = 0; jj < 9; ++jj) mx = fmaxf(mx, fmaxf(fmaxf(sacc[jj][0], sacc[jj][1]), fmaxf(sacc[jj][2], sacc[jj][3])));
        mx = fmaxf(mx, shx(mx, lane, 16)); mx = fmaxf(mx, shx(mx, lane, 32));
        float sum = 0.f;
#pragma unroll
        for (int jj = 0; jj < 9; ++jj)
#pragma unroll
            for (int i = 0; i < 4; ++i) { const float p = __builtin_amdgcn_exp2f(sacc[jj][i] - mx); sacc[jj][i] = p; sum += p; }
        sum += shx(sum, lane, 16); sum += shx(sum, lane, 32);
        f32x4 oacc[4];
#pragma unroll
        for (int dt = 0; dt < 4; ++dt) oacc[dt] = (f32x4){0.f, 0.f, 0.f, 0.f};
#pragma unroll
        for (int hb = 0; hb < 2; ++hb) {
            bf16x8 vfr[3][4];
#pragma unroll
            for (int q3 = 0; q3 < 3; ++q3) { const int pp = 3 * hb + q3; if (pp < 5) { const int j0 = 2 * pp, j1 = pp < 4 ? 2 * pp + 1 : 2 * pp; const int kt0 = w + j0, kt1 = w + j1;
                const LAS unsigned char* v0p = lds + AT_V + (((kt0 < 8 ? nb - 1 : nb) & 1) * AT_HALF) + (((kt0 & 7) * 16 + 4 * fq + (fr >> 2)) * KP + 4 * (fr & 3)) * 2;
                const LAS unsigned char* v1p = lds + AT_V + (((kt1 < 8 ? nb - 1 : nb) & 1) * AT_HALF) + (((kt1 & 7) * 16 + 4 * fq + (fr >> 2)) * KP + 4 * (fr & 3)) * 2;
#pragma unroll
                for (int dt = 0; dt < 4; ++dt) { const s16x4 a = vtr(v0p + 32 * dt), c = vtr(v1p + 32 * dt); vfr[q3][dt] = (bf16x8){a[0], a[1], a[2], a[3], c[0], c[1], c[2], c[3]}; } } }
            __builtin_amdgcn_sched_barrier(0);
#pragma unroll
            for (int q3 = 0; q3 < 3; ++q3) { const int pp = 3 * hb + q3; if (pp < 5) { const int j0 = 2 * pp, j1 = pp < 4 ? 2 * pp + 1 : 2 * pp;
                const f32x4 p0 = sacc[j0], p1 = pp < 4 ? sacc[j1] : (f32x4){0.f, 0.f, 0.f, 0.f};
                const v4u pk = pg8::pack8(p0, p1); const bf16x8 pf = __builtin_bit_cast(bf16x8, pk);
#pragma unroll
                for (int dt = 0; dt < 4; ++dt) oacc[dt] = __builtin_amdgcn_mfma_f32_16x16x32_bf16(vfr[q3][dt], pf, oacc[dt], 0, 0, 0); } }
        }
        { LAS unsigned char* stg = lds + EPI_STAGE_OFF + w * 2304; const float inv = 1.f / sum;
#pragma unroll
          for (int dt = 0; dt < 4; ++dt) { const f32x4 o = oacc[dt] * inv; v2u pw; pw.x = pg8::cvt_pk_bf16(o.x, o.y); pw.y = pg8::cvt_pk_bf16(o.z, o.w); *(LAS v2u*)(stg + fr * 144 + (16 * dt + 4 * fq) * 2) = pw; }
          if (fq == 0) *(LAS float*)(stg + fr * 144 + 128) = mx + __builtin_amdgcn_logf(sum);
          asm volatile("s_waitcnt lgkmcnt(0)" ::: "memory");
#pragma unroll
          for (int h2 = 0; h2 < 2; ++h2) { const int row = lr + 8 * h2; const size_t orow = h2 ? orow1 : orow0;
              const v4u v = *(const LAS v4u*)(stg + row * 144 + 16 * l8); const float ml2 = *(const LAS float*)(stg + row * 144 + 128);
              if (!LAST) { *(v4u*)(OG + ((size_t)g * MT + orow) * D + head * 64 + 8 * l8) = v; if (l8 == 0) LSE[((size_t)g * MT + orow) * 16 + head] = ml2; }
              else { const float mm = fmaxf(ml0[h2], fmaxf(ml1[h2], ml2)); float w0 = __builtin_amdgcn_exp2f(ml0[h2] - mm), w1 = __builtin_amdgcn_exp2f(ml1[h2] - mm), w2 = __builtin_amdgcn_exp2f(ml2 - mm);
                  const float wi = 1.f / (w0 + w1 + w2); w0 *= wi; w1 *= wi; w2 *= wi; const v4u x0 = ma0[h2], x1 = ma1[h2]; v4u o;
                  o.x = pg8::cvt_pk_bf16(w0 * bflo(x0.x) + w1 * bflo(x1.x) + w2 * bflo(v.x), w0 * bfhi(x0.x) + w1 * bfhi(x1.x) + w2 * bfhi(v.x));
                  o.y = pg8::cvt_pk_bf16(w0 * bflo(x0.y) + w1 * bflo(x1.y) + w2 * bflo(v.y), w0 * bfhi(x0.y) + w1 * bfhi(x1.y) + w2 * bfhi(v.y));
                  o.z = pg8::cvt_pk_bf16(w0 * bflo(x0.z) + w1 * bflo(x1.z) + w2 * bflo(v.z), w0 * bfhi(x0.z) + w1 * bfhi(x1.z) + w2 * bfhi(v.z));
                  o.w = pg8::cvt_pk_bf16(w0 * bflo(x0.w) + w1 * bflo(x1.w) + w2 * bflo(v.w), w0 * bfhi(x0.w) + w1 * bfhi(x1.w) + w2 * bfhi(v.w));
                  *(v4u*)(OM + orow * D + head * 64 + 8 * l8) = o; } } }
        __syncthreads();
        g = g2; b = b2; head = head2; r = r2; nb = nb2; need_prev = np2;
    }
#undef AT_GLOAD
#undef AT_LSTORE
#undef AT_QLOAD
}
template <bool LAST>
__device__ __forceinline__ void ph_attn_sample(const Frame& F0, int j) { const Frame F = phase_frame(F0);
    const int lane = F.lane, w = F.wave;
    const bf16* QKV = F.W<bf16>(WS_QKV); bf16* OG = F.W<bf16>(WS_OG); float* LSE = F.W<float>(WS_LSE); bf16* OM = F.W<bf16>(WS_AOP);
    const float* c0 = F.in(I_C128); const float* c1 = F.in(I_C512); const float* c2 = F.in(I_C2048);
    for (int it3 = LAST ? 2 : 0; it3 < (LAST ? 3 : 2); ++it3) {
        const int vwg = (F.wg & 7) * 32 + (F.wg >> 3);
        const int id = it3 * 2048 + vwg * NWAVES + w;
        const int sg = id >> 11, srow = (id >> 4) & 127, shead = id & 15, n = srow >> 2, t = srow & 3, dil = 1 << (2 * sg), Wg = 128 << (2 * sg), ks = lane >> 4, d4 = lane & 15;
        const float* cache = (sg == 0 ? c0 : (sg == 1 ? c1 : c2)) + (size_t)(j * NSQ + n) * Wg * 2048 + shead * 64 + 4 * d4;
        const bf16* nk = QKV + (size_t)(MP + 4 * n) * NQKV + sg * 3072 + 1024 + shead * 64 + 4 * d4;
        f32x4 q4; { const v2u x = *(const v2u*)(QKV + (size_t)(MP + srow) * NQKV + sg * 3072 + shead * 64 + 4 * d4); q4 = (f32x4){bflo(x.x), bfhi(x.x), bflo(x.y), bfhi(x.y)}; }
        float sc[33];
#define AT_SKEY(it_, which_, dst_) do { const int k_ = 4 * (it_) + ks; const int p_ = SEQ + t - dil * k_; dst_ = (f32x4){0.f, 0.f, 0.f, 0.f}; \
            if (k_ <= 128) { if (p_ >= SEQ) { const v2u a_ = *(const v2u*)(nk + (size_t)(p_ - SEQ) * NQKV + (which_) * 1024); dst_ = (f32x4){bflo(a_.x), bfhi(a_.x), bflo(a_.y), bfhi(a_.y)}; } \
                             else { const f32x4* cp_ = (const f32x4*)(cache + (size_t)(p_ - (SEQ - Wg)) * 2048 + (which_) * 1024); dst_ = NT_CACHE && sg > 0 ? __builtin_nontemporal_load(cp_) : *cp_; } } } while (0)
#pragma unroll
        for (int c3 = 0; c3 < 3; ++c3) { f32x4 kk[11];
#pragma unroll
            for (int i = 0; i < 11; ++i) AT_SKEY(11 * c3 + i, 0, kk[i]);
#pragma unroll
            for (int i = 0; i < 11; ++i) { float s = (q4.x * kk[i].x + q4.y * kk[i].y) + (q4.z * kk[i].z + q4.w * kk[i].w);
                s += shx(s, lane, 1); s += shx(s, lane, 2); s += shx(s, lane, 4); s += shx(s, lane, 8); sc[11 * c3 + i] = (4 * (11 * c3 + i) + ks <= 128) ? s : -1e30f; } }
        float m = -1e30f;
#pragma unroll
        for (int i = 0; i < 33; ++i) m = fmaxf(m, sc[i]);
        float l = 0.f;
#pragma unroll
        for (int i = 0; i < 33; ++i) { sc[i] = __expf(sc[i] - m); l += sc[i]; }
        f32x4 o4 = (f32x4){0.f, 0.f, 0.f, 0.f};
#pragma unroll
        for (int c3 = 0; c3 < 3; ++c3) { f32x4 vv[11];
#pragma unroll
            for (int i = 0; i < 11; ++i) AT_SKEY(11 * c3 + i, 1, vv[i]);
#pragma unroll
            for (int i = 0; i < 11; ++i) o4 += vv[i] * sc[11 * c3 + i]; }
#undef AT_SKEY
#pragma unroll
        for (int off = 16; off <= 32; off <<= 1) {
            const float m2 = shx(m, lane, off), l2 = shx(l, lane, off); f32x4 o2; o2.x = shx(o4.x, lane, off); o2.y = shx(o4.y, lane, off); o2.z = shx(o4.z, lane, off); o2.w = shx(o4.w, lane, off);
            const float mn = fmaxf(m, m2), e1 = __expf(m - mn), e2 = __expf(m2 - mn); l = l * e1 + l2 * e2; o4 = o4 * e1 + o2 * e2; m = mn;
        }
        if (ks == 0) {
            if (!LAST) { const f32x4 o = o4 * (1.f / l); v2u pw; pw.x = pg8::cvt_pk_bf16(o.x, o.y); pw.y = pg8::cvt_pk_bf16(o.z, o.w); *(v2u*)(OG + ((size_t)sg * MT + MP + srow) * D + shead * 64 + 4 * d4) = pw; if (d4 == 0) LSE[((size_t)sg * MT + MP + srow) * 16 + shead] = m + __logf(l); }
            else { const size_t orow = (size_t)MP + srow; const v2u a0 = *(const v2u*)(OG + orow * D + shead * 64 + 4 * d4), a1 = *(const v2u*)(OG + ((size_t)MT + orow) * D + shead * 64 + 4 * d4);
                const float l0 = LSE[orow * 16 + shead], l1 = LSE[((size_t)MT + orow) * 16 + shead], l2 = m + __logf(l), mm = fmaxf(l0, fmaxf(l1, l2)); float w0 = __expf(l0 - mm), w1 = __expf(l1 - mm), w2 = __expf(l2 - mm);
                const float wi = 1.f / (w0 + w1 + w2); w0 *= wi; w1 *= wi; w2 *= wi / l; v2u pw;
                pw.x = pg8::cvt_pk_bf16(w0 * bflo(a0.x) + w1 * bflo(a1.x) + w2 * o4.x, w0 * bfhi(a0.x) + w1 * bfhi(a1.x) + w2 * o4.y); pw.y = pg8::cvt_pk_bf16(w0 * bflo(a0.y) + w1 * bflo(a1.y) + w2 * o4.z, w0 * bfhi(a0.y) + w1 * bfhi(a1.y) + w2 * o4.w);
                *(v2u*)(OM + orow * D + shead * 64 + 4 * d4) = pw; }
        }
    }
}

__global__ void __launch_bounds__(NTHR, 2) mega_fwd(Params p) {
    extern __shared__ __attribute__((aligned(16))) unsigned char lds_raw[];
    Frame F;
    F.lds = (LAS unsigned char*)lds_raw; F.tid = threadIdx.x; F.lane = F.tid & 63; F.wave = __builtin_amdgcn_readfirstlane(F.tid >> 6); F.wg = blockIdx.x; F.G = gridDim.x;
    F.out_g = (GAS float*)p.out; F.ws_g = (GAS unsigned char*)p.ws;
    for (int u = F.tid; u < (LDS_BYTES - RING_BYTES) / 4; u += NTHR) ((LAS unsigned*)(F.lds + RING_BYTES))[u] = 0u;
    __syncthreads();
    XcdBarrier bar = xcd_barrier_post((unsigned*)(p.ws + WS_CTL) + CW_BAR, (volatile LAS unsigned*)(F.lds + MISC_OFF) + 8);
#define GRID_BAR() do { XcdBarrier bb_ = bar; bb_.x = xb_xcc_id(); asm volatile("" : "+s"(bb_.bar), "+s"(bb_.x)); bb_.lead = (F.wave == 0) && (lane_now() == 0); xcd_barrier(bb_); } while (0)
    unsigned long long tacc = 0;
#define PHASE(id, ...) do { unsigned long long t0_ = 0; if (TPROBE == (id)) t0_ = __builtin_amdgcn_s_memrealtime(); __VA_ARGS__; if (TPROBE == (id)) tacc += __builtin_amdgcn_s_memrealtime() - t0_; } while (0)
    PHASE(0, ph_prologue(F); GRID_BAR());
    for (int l = 0; l < DEPTH; ++l) {
        const int j = l >> 1;
        for (int f = 0; f < 2; ++f) {
            PHASE(1, tacc += ph_up(F, l, f); GRID_BAR());
            PHASE(2, tacc += ph_res(F, F.W<bf16>(WS_HID), F.W<bf16>(WS_WDN + (size_t)(l * 2 + f) * SZ_WDN), DFF, nullptr, 0.5f); GRID_BAR());
            if (f == 0) {
                if ((l & 1) == 0) {
                    PHASE(3, ph_rin(F, j); GRID_BAR());
                    PHASE(4, ph_scan(F, j); GRID_BAR());
                    PHASE(5, ph_scan_fix(F, j); GRID_BAR());
                    PHASE(6, tacc += ph_res(F, F.W<bf16>(WS_AOP), F.W<bf16>(WS_WROUT + (size_t)j * SZ_WSQ), D, F.in(I_BROUT) + j * D, 1.0f); GRID_BAR());
                } else {
                    PHASE(7, tacc += ph_qkv(F, j); GRID_BAR());
                    { const int k4 = (F.wg >> 3) & 3, sa = ATT_SPLIT ? k4 * 5 + k4 / 3 : 0, sb = ATT_SPLIT ? k4 * 3 - k4 / 3 : 0;
                      PHASE(14, ph_attn<false>(F, j, 0, sa); ph_attn_sample<false>(F, j); ph_attn<false>(F, j, sa, 16); GRID_BAR());
                      PHASE(15, ph_attn<true>(F, j, 0, sb); ph_attn_sample<true>(F, j); ph_attn<true>(F, j, sb, 8); GRID_BAR()); }
                    PHASE(10, tacc += ph_res(F, F.W<bf16>(WS_AOP), F.W<bf16>(WS_WO + (size_t)j * SZ_WSQ), D, nullptr, 1.0f); GRID_BAR());
                }
            }
        }
    }
    PHASE(11, ph_final(F));
    if (TPROBE >= 0) { const unsigned long long tend = __builtin_amdgcn_s_memrealtime() + (unsigned long long)TAMP * tacc; while (__builtin_amdgcn_s_memrealtime() < tend) __builtin_amdgcn_s_sleep(64); }
}

extern "C" void kernel_launch(void* const* d_in, const int* in_sizes, int n_in, void* d_out, int out_size, void* d_ws, size_t ws_size, hipStream_t stream) {
    static int grid = 0;
    if (grid == 0) {
        if (n_in != N_IN || (size_t)out_size != O_END || ws_size < WS_END) { fprintf(stderr, "kernel_launch: unexpected shapes (n_in %d, out %d, ws %zu); nothing launched\n", n_in, out_size, ws_size); grid = -1; return; }
        int dev = 0, cus = 0, per_cu = 0;
        if (hipGetDevice(&dev) != hipSuccess || hipDeviceGetAttribute(&cus, hipDeviceAttributeMultiprocessorCount, dev) != hipSuccess) { grid = -1; return; }
        if (hipFuncSetAttribute((const void*)mega_fwd, hipFuncAttributeMaxDynamicSharedMemorySize, LDS_BYTES) != hipSuccess) { grid = -1; return; }
        if (hipOccupancyMaxActiveBlocksPerMultiprocessor(&per_cu, (const void*)mega_fwd, NTHR, LDS_BYTES) != hipSuccess || per_cu < 1) { fprintf(stderr, "kernel_launch: occupancy query says %d blocks per CU\n", per_cu); }
        (void)hipGetLastError();
        if (cus != 256) { fprintf(stderr, "kernel_launch: built for 256 CUs, device has %d; nothing launched\n", cus); grid = -1; return; }
        grid = cus;
    }
    if (grid < 0) return;
    if (hipMemsetAsync((char*)d_ws + WS_CTL, 0, CTL_ZERO_BYTES, stream) != hipSuccess) return;
    Params p{};
    for (int i = 0; i < N_IN; ++i) p.in[i] = (const float*)d_in[i];
    p.out = (float*)d_out; p.ws = (unsigned char*)d_ws;
    hipLaunchKernelGGL(mega_fwd, dim3(grid), dim3(NTHR), LDS_BYTES, stream, p);
}
```
